# Optimizing an MI355X kernel written in HIP

```python
import jax
import jax.numpy as jnp
from jax import lax
import numpy as np

D_MODEL = 1024
BATCH = 16
SEQ = 2048
DEPTH = 4

GRID_W = 64
CTX_LEN = 256
HEAD_DIM = 64
ROT_FREQS = HEAD_DIM // 4
ROPE_THETA = 10000.0
NORM_EPS = 1e-5

POOL_WINDOWS = (2, 4, 8, 16)
POOL_GROUP = 64
POOL_WIDTH = POOL_GROUP * len(POOL_WINDOWS)
ATT_HEADS = 12
ATT_KV_HEADS = 3
ATT_GROUP = ATT_HEADS // ATT_KV_HEADS
ATT_WINDOW = 128
ATT_BLOCK = 128
ATT_Q = ATT_HEADS * HEAD_DIM
ATT_KV = ATT_KV_HEADS * HEAD_DIM
OFF_K = POOL_WIDTH + ATT_Q
OFF_V = OFF_K + ATT_KV
EVEN_IN = OFF_V + ATT_KV
EVEN_MIX = POOL_WIDTH + ATT_Q

RWKV_HEADS = 12
RWKV_WIDTH = RWKV_HEADS * HEAD_DIM
DECAY_LORA = 64
ICLR_LORA = 64
GATE_LORA = 160
GN_EPS = 64e-5
STATE_LO = RWKV_WIDTH
STATE_HI = 3 * RWKV_WIDTH + 2 * DECAY_LORA + 2 * ICLR_LORA
RWKV_IN = STATE_HI + GATE_LORA
FNET_GROUPS = 4
FNET_GROUP = 64
FNET_WIDTH = FNET_GROUPS * FNET_GROUP
ODD_IN = RWKV_IN + FNET_WIDTH
ODD_MIX = RWKV_WIDTH + FNET_WIDTH

N_EXPERTS = 32
TOP_K = 4
D_EXPERT = D_MODEL
SWIGLU_LIMIT = 7.0
SWIGLU_ALPHA = 1.702
MOE_BLOCK = 256

kernel_name = 'hybrid_pool_swa_rwkv7_fnet_moe_dit'


def rms_norm(x, g):
    xf = x.astype(jnp.float32)
    xf = xf * lax.rsqrt(jnp.mean(xf * xf, axis=-1, keepdims=True) + NORM_EPS)
    return (xf * g.astype(jnp.float32)).astype(x.dtype)


def modulate(h, shift, scale):
    return h * (1 + scale[:, None, :]) + shift[:, None, :]


def axial_rope_tables(n_tokens):
    rows = n_tokens // GRID_W
    row = jnp.repeat(jnp.arange(rows, dtype=jnp.float32), GRID_W)
    col = jnp.tile(jnp.arange(GRID_W, dtype=jnp.float32), rows)
    inv_freq = ROPE_THETA ** (-jnp.arange(ROT_FREQS, dtype=jnp.float32) / ROT_FREQS)
    ang = jnp.stack([row[:, None] * inv_freq, col[:, None] * inv_freq], axis=1)
    return jnp.cos(ang), jnp.sin(ang)


def apply_axial_rope(x, cos, sin):
    xs = x.astype(jnp.float32).reshape(x.shape[:-1] + (2, 2, ROT_FREQS))
    x1, x2 = xs[..., 0, :], xs[..., 1, :]
    c, s = cos[:, None], sin[:, None]
    out = jnp.stack([x1 * c - x2 * s, x2 * c + x1 * s], axis=-2)
    return out.reshape(x.shape).astype(x.dtype)


def multiscale_pool(u, pool_w, pool_scale):
    B, T, _ = u.shape
    uf = u.astype(jnp.float32).reshape(B, T, len(POOL_WINDOWS), POOL_GROUP)
    cs = jnp.pad(lax.cumsum(uf, axis=1), ((0, 0), (1, 0), (0, 0), (0, 0)))
    t = jnp.arange(T)
    means = []
    for gi, w in enumerate(POOL_WINDOWS):
        lo = jnp.clip(t - w // 2, 0, T)
        hi = jnp.clip(t - w // 2 + w, 0, T)
        win = cs[:, hi, gi] - cs[:, lo, gi]
        means.append(win / (hi - lo).astype(jnp.float32)[None, :, None])
    pooled = (jnp.stack(means, axis=2) - uf).astype(u.dtype)
    mixed = jnp.einsum('btgc,gcd->btgd', pooled, pool_w)
    return mixed.reshape(B, T, POOL_WIDTH) * pool_scale


def sink_softmax(scores, sink):
    full = jnp.concatenate([scores, jnp.broadcast_to(sink, scores.shape[:-1] + (1,))], axis=-1)
    return jax.nn.softmax(full, axis=-1)[..., :-1]


def latent_window_attention(q, k, v, kc, vc, sink):
    B, S = q.shape[:2]
    nb = S // ATT_BLOCK
    span = ATT_BLOCK + 2 * ATT_WINDOW
    scale = HEAD_DIM ** -0.5
    qb = q.reshape(B, nb, ATT_BLOCK, ATT_KV_HEADS, ATT_GROUP, HEAD_DIM)
    pad = ((0, 0), (ATT_WINDOW, ATT_WINDOW), (0, 0), (0, 0))
    kp, vp = jnp.pad(k, pad), jnp.pad(v, pad)
    sink_b = sink.astype(jnp.float32).reshape(1, ATT_KV_HEADS, ATT_GROUP, 1, 1)
    rel = jnp.arange(span)[None, :] - jnp.arange(ATT_BLOCK)[:, None]
    band = (rel >= 0) & (rel <= 2 * ATT_WINDOW)

    def block(j):
        qj = lax.dynamic_index_in_dim(qb, j, axis=1, keepdims=False)
        kj = lax.dynamic_slice_in_dim(kp, j * ATT_BLOCK, span, axis=1)
        vj = lax.dynamic_slice_in_dim(vp, j * ATT_BLOCK, span, axis=1)
        key_pos = j * ATT_BLOCK - ATT_WINDOW + jnp.arange(span)
        mask = band & ((key_pos >= 0) & (key_pos < S))[None, :]
        s_loc = jnp.einsum('bqkgd,bskd->bkgqs', qj, kj).astype(jnp.float32) * scale
        s_loc = jnp.where(mask, s_loc, -jnp.inf)
        s_ctx = jnp.einsum('bqkgd,bckd->bkgqc', qj, kc).astype(jnp.float32) * scale
        p = sink_softmax(jnp.concatenate([s_loc, s_ctx], axis=-1), sink_b).astype(v.dtype)
        o = (jnp.einsum('bkgqs,bskd->bqkgd', p[..., :span], vj)
             + jnp.einsum('bkgqc,bckd->bqkgd', p[..., span:], vc))
        return o.reshape(B, ATT_BLOCK, ATT_Q)

    out = lax.map(block, jnp.arange(nb))
    return jnp.moveaxis(out, 0, 1).reshape(B, S, ATT_Q)


def context_attention(qc, kc, vc, sink):
    B, C = qc.shape[:2]
    qg = qc.reshape(B, C, ATT_KV_HEADS, ATT_GROUP, HEAD_DIM)
    s = jnp.einsum('bqkgd,bckd->bkgqc', qg, kc).astype(jnp.float32) * HEAD_DIM ** -0.5
    p = sink_softmax(s, sink.astype(jnp.float32).reshape(1, ATT_KV_HEADS, ATT_GROUP, 1, 1)).astype(vc.dtype)
    return jnp.einsum('bkgqc,bckd->bqkgd', p, vc).reshape(B, C, ATT_Q)


def even_mixer(hx, hc, w_in, w_out, pool_w, pool_scale, sink, cos, sin, ctx_out):
    B, S, _ = hx.shape
    C = hc.shape[1]
    px = hx @ w_in
    qx = apply_axial_rope(px[..., POOL_WIDTH:OFF_K].reshape(B, S, ATT_HEADS, HEAD_DIM), cos, sin)
    kx = apply_axial_rope(px[..., OFF_K:OFF_V].reshape(B, S, ATT_KV_HEADS, HEAD_DIM), cos, sin)
    vx = px[..., OFF_V:].reshape(B, S, ATT_KV_HEADS, HEAD_DIM)
    pc = hc @ w_in if ctx_out else hc @ w_in[:, OFF_K:]
    kc = pc[..., -2 * ATT_KV:-ATT_KV].reshape(B, C, ATT_KV_HEADS, HEAD_DIM)
    vc = pc[..., -ATT_KV:].reshape(B, C, ATT_KV_HEADS, HEAD_DIM)
    att_x = latent_window_attention(qx, kx, vx, kc, vc, sink)
    pool_x = multiscale_pool(px[..., :POOL_WIDTH], pool_w, pool_scale)
    yx = jnp.concatenate([pool_x, att_x], axis=-1) @ w_out
    if not ctx_out:
        return yx, None
    qc = pc[..., POOL_WIDTH:OFF_K].reshape(B, C, ATT_HEADS, HEAD_DIM)
    att_c = context_attention(qc, kc, vc, sink)
    pool_c = multiscale_pool(pc[..., :POOL_WIDTH], pool_w, pool_scale)
    yc = jnp.concatenate([pool_c, att_c], axis=-1) @ w_out
    return yx, yc


def token_shift(u, mu):
    prev = jnp.pad(u[:, :-1], ((0, 0), (1, 0), (0, 0)))
    nxt = jnp.pad(u[:, 1:], ((0, 0), (0, 1), (0, 0)))
    return u + mu[0] * (prev - u) + mu[1] * (nxt - u)


def to_heads_tm(z):
    B, T, _ = z.shape
    return jnp.moveaxis(z.astype(jnp.float32).reshape(B, T, RWKV_HEADS, HEAD_DIM), 1, 0)


def rwkv_scan_inputs(fs, w0, w2, a0, a2, k_k, k_a):
    B, T, _ = fs.shape
    W = RWKV_WIDTH
    k, v = fs[..., :W], fs[..., W:2 * W]
    o_w = 2 * W
    o_a = o_w + 2 * DECAY_LORA
    kk = (k * k_k).astype(jnp.float32).reshape(B, T, RWKV_HEADS, HEAD_DIM)
    kk = kk / jnp.maximum(jnp.sqrt(jnp.sum(kk * kk, axis=-1, keepdims=True)), 1e-12)
    kk = kk.reshape(B, T, W)
    kf = k.astype(jnp.float32)
    dirs = []
    for d in range(2):
        wd = fs[..., o_w + d * DECAY_LORA:o_w + (d + 1) * DECAY_LORA]
        ad = fs[..., o_a + d * ICLR_LORA:o_a + (d + 1) * ICLR_LORA]
        w_log = -jax.nn.softplus(-(w0[d] + jnp.tanh(wd) @ w2[d]).astype(jnp.float32)) - 0.5
        decay = jnp.exp(-jnp.exp(w_log))
        a = jax.nn.sigmoid((a0[d] + ad @ a2[d]).astype(jnp.float32))
        k_d = kf * (1.0 + (a - 1.0) * k_a.astype(jnp.float32))
        dirs.append((decay, k_d, kk * a))
    return v, kk, dirs


def wkv_scan(state0, scan_in, d, r, reverse):
    v, kk, dirs = scan_in
    decay, k_d, b = dirs[d]
    seq = tuple(to_heads_tm(z) for z in (decay, k_d, v, kk, b))
    if r is not None:
        seq = seq + (to_heads_tm(r),)

    def step(S, inp):
        w_t, k_t, v_t, kk_t, b_t = inp[:5]
        sa = jnp.einsum('bhij,bhj->bhi', S, kk_t)
        S = S * w_t[:, :, None, :] - sa[..., None] * b_t[:, :, None, :] + v_t[..., None] * k_t[:, :, None, :]
        y = jnp.einsum('bhij,bhj->bhi', S, inp[5]) if len(inp) == 6 else None
        return S, y

    return lax.scan(step, state0, seq, reverse=reverse)


def rwkv_readout(y_tm, r, scan_in, g_cols, g2, r_k, gn_g, gn_b):
    v, _, dirs = scan_in
    y = jnp.moveaxis(y_tm, 0, 1)
    B, T = y.shape[:2]
    mean = jnp.mean(y, axis=-1, keepdims=True)
    var = jnp.mean(jnp.square(y - mean), axis=-1, keepdims=True)
    yn = ((y - mean) * lax.rsqrt(var + GN_EPS)).reshape(B, T, RWKV_WIDTH) * gn_g + gn_b
    rh = r.astype(jnp.float32).reshape(B, T, RWKV_HEADS, HEAD_DIM)
    vh = v.astype(jnp.float32).reshape(B, T, RWKV_HEADS, HEAD_DIM)
    coef = sum(jnp.sum(rh * dd[1].reshape(B, T, RWKV_HEADS, HEAD_DIM) * r_k, axis=-1, keepdims=True)
               for dd in dirs)
    out = yn + (coef * vh).reshape(B, T, RWKV_WIDTH)
    g = jax.nn.sigmoid(g_cols) @ g2
    return out.astype(r.dtype) * g


def fourier_mix(u):
    B, T, _ = u.shape
    uf = u.astype(jnp.float32).reshape(B, T, FNET_GROUPS, FNET_GROUP)
    return jnp.fft.fft2(uf, axes=(1, 3), norm='ortho').real.reshape(B, T, FNET_WIDTH).astype(u.dtype)


def odd_mixer(hx, hc, w_in, w_out, mu, w0, w2, a0, a2, g2, k_k, k_a, r_k, gn_g, gn_b, ctx_out):
    B = hx.shape[0]
    dir_params = (w0, w2, a0, a2, k_k, k_a)
    px = hx @ w_in
    fx = token_shift(px[..., :RWKV_IN], mu)
    x_in = rwkv_scan_inputs(fx[..., STATE_LO:STATE_HI], *dir_params)
    if ctx_out:
        pc = hc @ w_in
        fc = token_shift(pc[..., :RWKV_IN], mu)
        c_in = rwkv_scan_inputs(fc[..., STATE_LO:STATE_HI], *dir_params)
        rc = fc[..., :RWKV_WIDTH]
    else:
        fcs = token_shift(hc @ w_in[:, STATE_LO:STATE_HI], mu[:, STATE_LO:STATE_HI])
        c_in = rwkv_scan_inputs(fcs, *dir_params)
        rc = None
    rx = fx[..., :RWKV_WIDTH]
    state0 = jnp.zeros((B, RWKV_HEADS, HEAD_DIM, HEAD_DIM), jnp.float32)
    ys_x, ys_c = [], []
    for d, rev in enumerate((False, True)):
        s_c, y_c = wkv_scan(state0, c_in, d, rc, rev)
        _, y_x = wkv_scan(s_c, x_in, d, rx, rev)
        ys_x.append(y_x)
        ys_c.append(y_c)
    o_x = rwkv_readout(ys_x[0] + ys_x[1], rx, x_in, fx[..., STATE_HI:], g2, r_k, gn_g, gn_b)
    yx = jnp.concatenate([o_x, fourier_mix(px[..., RWKV_IN:])], axis=-1) @ w_out
    if not ctx_out:
        return yx, None
    o_c = rwkv_readout(ys_c[0] + ys_c[1], rc, c_in, fc[..., STATE_HI:], g2, r_k, gn_g, gn_b)
    yc = jnp.concatenate([o_c, fourier_mix(pc[..., RWKV_IN:])], axis=-1) @ w_out
    return yx, yc


def clamped_swiglu(gu):
    glu, lin = gu[..., ::2], gu[..., 1::2]
    glu = jnp.minimum(glu, SWIGLU_LIMIT)
    lin = jnp.clip(lin, -SWIGLU_LIMIT, SWIGLU_LIMIT)
    return glu * jax.nn.sigmoid(SWIGLU_ALPHA * glu) * (lin + 1)


def moe_ffn(h, router_w, router_b, w_gu, b_gu, w_dn, b_dn):
    n_tok, D = h.shape
    logits = (h @ router_w).astype(jnp.float32) + router_b.astype(jnp.float32)
    top_val, top_idx = lax.top_k(logits, TOP_K)
    gates = jax.nn.softmax(top_val, axis=-1)
    n_assign = n_tok * TOP_K
    flat_e = top_idx.reshape(-1).astype(jnp.int32)
    flat_tok = jnp.repeat(jnp.arange(n_tok, dtype=jnp.int32), TOP_K)
    flat_gate = gates.reshape(-1)
    order = jnp.argsort(flat_e)
    sorted_e, sorted_tok, sorted_gate = flat_e[order], flat_tok[order], flat_gate[order]
    counts = jax.ops.segment_sum(jnp.ones_like(flat_e), flat_e, num_segments=N_EXPERTS)
    starts = jnp.cumsum(counts) - counts
    padded = (counts + MOE_BLOCK - 1) // MOE_BLOCK * MOE_BLOCK
    pends = jnp.cumsum(padded)
    pstarts = pends - padded
    dest = pstarts[sorted_e] + (jnp.arange(n_assign, dtype=jnp.int32) - starts[sorted_e])
    n_rows = (-(-n_assign // MOE_BLOCK) + N_EXPERTS) * MOE_BLOCK
    n_blocks = n_rows // MOE_BLOCK
    row_tok = jnp.full((n_rows,), n_tok, jnp.int32).at[dest].set(sorted_tok)
    row_gate = jnp.zeros((n_rows,), jnp.float32).at[dest].set(sorted_gate)
    block_e = jnp.minimum(jnp.searchsorted(pends, jnp.arange(n_blocks) * MOE_BLOCK, side='right'),
                          N_EXPERTS - 1)
    h_pad = jnp.concatenate([h, jnp.zeros((1, D), h.dtype)], axis=0)

    def run(args):
        e, toks, gw = args
        xb = h_pad[toks]
        gu = xb @ w_gu[e] + b_gu[e]
        yb = clamped_swiglu(gu) @ w_dn[e] + b_dn[e]
        return yb * gw[:, None].astype(yb.dtype)

    y = lax.map(run, (block_e, row_tok.reshape(n_blocks, MOE_BLOCK), row_gate.reshape(n_blocks, MOE_BLOCK)))
    return jax.ops.segment_sum(y.reshape(n_rows, D), row_tok, num_segments=n_tok + 1)[:n_tok]


def setup_inputs(seed: int = 0) -> dict:
    key = jax.random.key(seed)
    keys = iter(jax.random.split(key, 40))
    D = D_MODEL
    n_even = (DEPTH + 1) // 2
    n_odd = DEPTH // 2

    def nrm(shape, std):
        return std * jax.random.normal(next(keys), shape, jnp.float32)

    def uni(shape, lo, hi):
        return jax.random.uniform(next(keys), shape, jnp.float32, lo, hi)

    return {
        'x': nrm((BATCH, SEQ, D), 1.0),
        'c': nrm((BATCH, D), 1.0),
        'ctx': nrm((BATCH, CTX_LEN, D), 1.0),
        'c_ctx': nrm((D,), 1.0),
        'ada_w': nrm((DEPTH, D, 6 * D), 0.5 * D ** -0.5),
        'ada_b': nrm((DEPTH, 6 * D), 0.02),
        'norm_mix_g': 1.0 + nrm((DEPTH, D), 0.02),
        'norm_ffn_g': 1.0 + nrm((DEPTH, D), 0.02),
        'ev_w_in': nrm((n_even, D, EVEN_IN), D ** -0.5),
        'ev_w_out': nrm((n_even, EVEN_MIX, D), EVEN_MIX ** -0.5),
        'pool_w': nrm((n_even, len(POOL_WINDOWS), POOL_GROUP, POOL_GROUP), POOL_GROUP ** -0.5),
        'pool_scale': 1.0 + nrm((n_even, POOL_WIDTH), 0.1),
        'att_sink': nrm((n_even, ATT_HEADS), 0.5),
        'od_w_in': nrm((n_odd, D, ODD_IN), D ** -0.5),
        'od_w_out': nrm((n_odd, ODD_MIX, D), ODD_MIX ** -0.5),
        'rw_mu': uni((n_odd, 2, RWKV_IN), 0.0, 0.5),
        'rw_w0': uni((n_odd, 2, RWKV_WIDTH), -6.0, -1.0),
        'rw_w2': nrm((n_odd, 2, DECAY_LORA, RWKV_WIDTH), 0.1),
        'rw_a0': nrm((n_odd, 2, RWKV_WIDTH), 0.5),
        'rw_a2': nrm((n_odd, 2, ICLR_LORA, RWKV_WIDTH), 0.1),
        'rw_g2': nrm((n_odd, GATE_LORA, RWKV_WIDTH), GATE_LORA ** -0.5),
        'rw_k_k': 0.85 + nrm((n_odd, RWKV_WIDTH), 0.05),
        'rw_k_a': 1.0 + nrm((n_odd, RWKV_WIDTH), 0.05),
        'rw_r_k': nrm((n_odd, RWKV_HEADS, HEAD_DIM), 0.1),
        'rw_gn_g': 1.0 + nrm((n_odd, RWKV_WIDTH), 0.02),
        'rw_gn_b': nrm((n_odd, RWKV_WIDTH), 0.01),
        'router_w': nrm((DEPTH, D, N_EXPERTS), D ** -0.5),
        'router_b': nrm((DEPTH, N_EXPERTS), 0.01),
        'exp_w_gu': nrm((DEPTH, N_EXPERTS, D, 2 * D_EXPERT), D ** -0.5),
        'exp_b_gu': nrm((DEPTH, N_EXPERTS, 2 * D_EXPERT), 0.01),
        'exp_w_dn': nrm((DEPTH, N_EXPERTS, D_EXPERT, D), D_EXPERT ** -0.5),
        'exp_b_dn': nrm((DEPTH, N_EXPERTS, D), 0.01),
        'final_g': 1.0 + nrm((D,), 0.02),
    }


def reference(x, c, ctx, c_ctx, ada_w, ada_b, norm_mix_g, norm_ffn_g, ev_w_in, ev_w_out, pool_w,
              pool_scale, att_sink, od_w_in, od_w_out, rw_mu, rw_w0, rw_w2, rw_a0, rw_a2, rw_g2,
              rw_k_k, rw_k_a, rw_r_k, rw_gn_g, rw_gn_b, router_w, router_b, exp_w_gu, exp_b_gu,
              exp_w_dn, exp_b_dn, final_g):
    B, S, D = x.shape
    C = ctx.shape[1]
    cos, sin = axial_rope_tables(S)
    h, hc = x, ctx
    for i in range(DEPTH):
        last = i == DEPTH - 1
        j = i // 2
        mod_x = jax.nn.silu(c) @ ada_w[i] + ada_b[i]
        mod_c = (jax.nn.silu(c_ctx) @ ada_w[i] + ada_b[i])[None]
        sh_m, sc_m, g_m, sh_f, sc_f, g_f = jnp.split(mod_x, 6, axis=-1)
        csh_m, csc_m, cg_m, csh_f, csc_f, cg_f = jnp.split(mod_c, 6, axis=-1)
        ax = modulate(rms_norm(h, norm_mix_g[i]), sh_m, sc_m)
        ac = modulate(rms_norm(hc, norm_mix_g[i]), csh_m, csc_m)
        if i % 2 == 0:
            yx, yc = even_mixer(ax, ac, ev_w_in[j], ev_w_out[j], pool_w[j], pool_scale[j], att_sink[j],
                                cos, sin, not last)
        else:
            yx, yc = odd_mixer(ax, ac, od_w_in[j], od_w_out[j], rw_mu[j], rw_w0[j], rw_w2[j], rw_a0[j],
                               rw_a2[j], rw_g2[j], rw_k_k[j], rw_k_a[j], rw_r_k[j], rw_gn_g[j],
                               rw_gn_b[j], not last)
        h = h + g_m[:, None, :] * yx
        fx = modulate(rms_norm(h, norm_ffn_g[i]), sh_f, sc_f).reshape(B * S, D)
        if last:
            out = moe_ffn(fx, router_w[i], router_b[i], exp_w_gu[i], exp_b_gu[i], exp_w_dn[i], exp_b_dn[i])
            h = h + g_f[:, None, :] * out.reshape(B, S, D)
        else:
            hc = hc + cg_m[:, None, :] * yc
            fc = modulate(rms_norm(hc, norm_ffn_g[i]), csh_f, csc_f).reshape(B * C, D)
            out = moe_ffn(jnp.concatenate([fx, fc], axis=0), router_w[i], router_b[i], exp_w_gu[i],
                          exp_b_gu[i], exp_w_dn[i], exp_b_dn[i])
            h = h + g_f[:, None, :] * out[:B * S].reshape(B, S, D)
            hc = hc + cg_f[:, None, :] * out[B * S:].reshape(B, C, D)
    return rms_norm(h, final_g)
```

```cpp
#include <hip/hip_runtime.h>
#include <stdint.h>
#include <stdio.h>

namespace {
constexpr int D = 1024, NB = 16, SEQ = 2048, CTX = 256;
constexpr int NX = NB * SEQ, NC = NB * CTX, NT = NX + NC;
constexpr int EVEN_IN = 1408, ODD_IN = 2976;
constexpr int RW = 768;
constexpr int NEXP = 32, TOPK = 4;
constexpr int MOE_ROWS = ((NT * TOPK + 255) / 256 + NEXP) * 256;
constexpr int MOE_TILES = MOE_ROWS / 128;
constexpr int MODW = 6 * D;

__device__ __forceinline__ float wave_sum(float v) {
#pragma unroll
    for (int o = 32; o >= 1; o >>= 1) v += __shfl_xor(v, o);
    return v;
}
__device__ __forceinline__ float wave_max(float v) {
#pragma unroll
    for (int o = 32; o >= 1; o >>= 1) v = fmaxf(v, __shfl_xor(v, o));
    return v;
}
__device__ __forceinline__ int mod_row(int r) { return r < NX ? (r >> 11) : 16; }
__device__ __forceinline__ void seq_info(int r, int& s0, int& len, int& t) {
    if (r < NX) { s0 = r & ~2047; len = SEQ; t = r & 2047; }
    else { const int q = r - NX; s0 = NX + (q & ~255); len = CTX; t = q & 255; }
}
__device__ __forceinline__ float sigmoidf_(float x) { return 1.f / (1.f + expf(-x)); }

__global__ __launch_bounds__(256) void k_copy(const float* __restrict__ x, const float* __restrict__ ctx, float* __restrict__ h) {
    const size_t n4x = (size_t)NX * D / 4, n4 = (size_t)NT * D / 4;
    for (size_t i = (size_t)blockIdx.x * blockDim.x + threadIdx.x; i < n4; i += (size_t)gridDim.x * blockDim.x)
        ((float4*)h)[i] = i < n4x ? ((const float4*)x)[i] : ((const float4*)ctx)[i - n4x];
}

__global__ __launch_bounds__(512) void k_ada(const float* __restrict__ c, const float* __restrict__ c_ctx, const float* __restrict__ ada_w,
                                             const float* __restrict__ ada_b, float* __restrict__ mod) {
    extern __shared__ float lds[];
    float* sc = lds;
    float* part = lds + 17 * 1024;
    const int tid = threadIdx.x;
    for (int i = tid; i < 17 * 1024; i += 512) { const int r = i >> 10, k = i & 1023; const float v = r < 16 ? c[r * 1024 + k] : c_ctx[k]; sc[i] = v / (1.f + expf(-v)); }
    __syncthreads();
    for (int unit = blockIdx.x; unit < 4 * 96; unit += gridDim.x) {
        const int l = unit / 96, cb = unit % 96, cl = tid & 63, ks = tid >> 6;
        const float* W = ada_w + (size_t)l * 1024 * MODW + cb * 64 + cl;
        float acc[17];
#pragma unroll
        for (int r = 0; r < 17; ++r) acc[r] = 0.f;
        for (int k = ks * 128; k < ks * 128 + 128; ++k) {
            const float w = W[(size_t)k * MODW];
#pragma unroll
            for (int r = 0; r < 17; ++r) acc[r] += sc[r * 1024 + k] * w;
        }
#pragma unroll
        for (int r = 0; r < 17; ++r) part[(ks * 17 + r) * 64 + cl] = acc[r];
        __syncthreads();
        for (int i = tid; i < 17 * 64; i += 512) {
            const int r = i >> 6, cc = i & 63; float s = 0.f;
#pragma unroll
            for (int q = 0; q < 8; ++q) s += part[(q * 17 + r) * 64 + cc];
            mod[((size_t)l * 17 + r) * MODW + cb * 64 + cc] = s + ada_b[l * MODW + cb * 64 + cc];
        }
        __syncthreads();
    }
}

__global__ __launch_bounds__(256) void k_norm_mod(const float* __restrict__ h, const float* __restrict__ g, const float* __restrict__ modl,
                                                  int sh_off, int sc_off, float* __restrict__ out, int nrows) {
    const int lane = threadIdx.x & 63, wave = (blockIdx.x * blockDim.x + threadIdx.x) >> 6, nw = (gridDim.x * blockDim.x) >> 6;
    for (int r = wave; r < nrows; r += nw) {
        const float4* hp = (const float4*)(h + (size_t)r * D);
        float4 v[4]; float ss = 0.f;
#pragma unroll
        for (int i = 0; i < 4; ++i) { v[i] = hp[lane + 64 * i]; ss += v[i].x * v[i].x + v[i].y * v[i].y + v[i].z * v[i].z + v[i].w * v[i].w; }
        ss = wave_sum(ss);
        const float rs = rsqrtf(ss * (1.f / 1024.f) + 1e-5f);
        const float* mr = modl ? modl + (size_t)mod_row(r) * MODW : nullptr;
#pragma unroll
        for (int i = 0; i < 4; ++i) {
            const int col = (lane + 64 * i) * 4;
            const float4 gg = *(const float4*)(g + col);
            float4 o; o.x = v[i].x * rs * gg.x; o.y = v[i].y * rs * gg.y; o.z = v[i].z * rs * gg.z; o.w = v[i].w * rs * gg.w;
            if (mr) {
                const float4 sh = *(const float4*)(mr + sh_off + col), sc = *(const float4*)(mr + sc_off + col);
                o.x = o.x * (1.f + sc.x) + sh.x; o.y = o.y * (1.f + sc.y) + sh.y; o.z = o.z * (1.f + sc.z) + sh.z; o.w = o.w * (1.f + sc.w) + sh.w;
            }
            *(float4*)(out + (size_t)r * D + col) = o;
        }
    }
}

constexpr int GLDA = 132;
constexpr int GEMM_LDS_FLOATS = 16 * GLDA + 16 * 64;
template <class ARow, class EPI>
__device__ __forceinline__ void gemm_tile(float* lds, ARow arow, const float* __restrict__ B, int ldb, int N, int K, int m0, int n0, EPI epi) {
    float* As = lds; float* Bs = lds + 16 * GLDA;
    const int tid = threadIdx.x, ty = tid >> 4, tx = tid & 15;
    const int ar = tid >> 2, akq = (tid & 3) * 4;
    const float* ap = arow(m0 + ar);
    const int bk = (tid & 255) >> 4, bn = (tid & 15) * 4;
    const bool bload = tid < 256 && (n0 + bn) < N;
    float acc[4][4];
#pragma unroll
    for (int i = 0; i < 4; ++i)
#pragma unroll
        for (int j = 0; j < 4; ++j) acc[i][j] = 0.f;
    for (int k0 = 0; k0 < K; k0 += 16) {
        float4 av = make_float4(0.f, 0.f, 0.f, 0.f), bv = make_float4(0.f, 0.f, 0.f, 0.f);
        if (ap) av = *(const float4*)(ap + k0 + akq);
        if (bload) bv = *(const float4*)(B + (size_t)(k0 + bk) * ldb + n0 + bn);
        __syncthreads();
        As[(akq + 0) * GLDA + ar] = av.x; As[(akq + 1) * GLDA + ar] = av.y; As[(akq + 2) * GLDA + ar] = av.z; As[(akq + 3) * GLDA + ar] = av.w;
        if (tid < 256) *(float4*)&Bs[bk * 64 + bn] = bv;
        __syncthreads();
#pragma unroll
        for (int k = 0; k < 16; ++k) {
            const float4 a = *(const float4*)&As[k * GLDA + ty * 4];
            const float4 b = *(const float4*)&Bs[k * 64 + tx * 4];
            acc[0][0] += a.x * b.x; acc[0][1] += a.x * b.y; acc[0][2] += a.x * b.z; acc[0][3] += a.x * b.w;
            acc[1][0] += a.y * b.x; acc[1][1] += a.y * b.y; acc[1][2] += a.y * b.z; acc[1][3] += a.y * b.w;
            acc[2][0] += a.z * b.x; acc[2][1] += a.z * b.y; acc[2][2] += a.z * b.z; acc[2][3] += a.z * b.w;
            acc[3][0] += a.w * b.x; acc[3][1] += a.w * b.y; acc[3][2] += a.w * b.z; acc[3][3] += a.w * b.w;
        }
    }
    __syncthreads();
    const int col = n0 + tx * 4;
    if (col < N) {
#pragma unroll
        for (int i = 0; i < 4; ++i) epi(m0 + ty * 4 + i, col, make_float4(acc[i][0], acc[i][1], acc[i][2], acc[i][3]));
    }
}

__global__ __launch_bounds__(512) void k_gemm_plain(const float* __restrict__ A, int lda, const float* __restrict__ B, int ldb, float* __restrict__ C, int ldc, int M, int N, int K) {
    extern __shared__ float lds[];
    const int nct = (N + 63) / 64, nunits = (M / 128) * nct;
    for (int u = blockIdx.x; u < nunits; u += gridDim.x) {
        const int mt = u / nct, ct = u % nct;
        gemm_tile(lds, [&](int r) { return A + (size_t)r * lda; }, B, ldb, N, K, mt * 128, ct * 64,
                  [&](int row, int col, float4 v) { *(float4*)(C + (size_t)row * ldc + col) = v; });
    }
}
__global__ __launch_bounds__(512) void k_gemm_resid(const float* __restrict__ A, const float* __restrict__ B, float* __restrict__ h, const float* __restrict__ modl, int gate_off) {
    extern __shared__ float lds[];
    const int nct = D / 64, nunits = (NT / 128) * nct;
    for (int u = blockIdx.x; u < nunits; u += gridDim.x) {
        const int mt = u / nct, ct = u % nct;
        gemm_tile(lds, [&](int r) { return A + (size_t)r * D; }, B, D, D, D, mt * 128, ct * 64,
                  [&](int row, int col, float4 v) {
                      const float4 g = *(const float4*)(modl + (size_t)mod_row(row) * MODW + gate_off + col);
                      float4* hp = (float4*)(h + (size_t)row * D + col); float4 o = *hp;
                      o.x += g.x * v.x; o.y += g.y * v.y; o.z += g.z * v.z; o.w += g.w * v.w; *hp = o; });
    }
}

__global__ __launch_bounds__(256) void k_rope(float* __restrict__ px) {
    const size_t total = (size_t)NX * 480;
    for (size_t i = (size_t)blockIdx.x * blockDim.x + threadIdx.x; i < total; i += (size_t)gridDim.x * blockDim.x) {
        const int r = (int)(i / 480), p = (int)(i % 480), hh = p >> 5, q = p & 31, a = q >> 4, f = q & 15;
        const int t = r & 2047, pos = a ? (t & 63) : (t >> 6);
        const float inv = powf(10000.f, -(float)f / 16.f);
        const float ang = (float)pos * inv, cs = cosf(ang), sn = sinf(ang);
        float* base = px + (size_t)r * EVEN_IN + 256 + hh * 64 + a * 32 + f;
        const float x1 = base[0], x2 = base[16];
        base[0] = x1 * cs - x2 * sn; base[16] = x2 * cs + x1 * sn;
    }
}
__global__ __launch_bounds__(256) void k_pool(const float* __restrict__ px, const float* __restrict__ pool_w, const float* __restrict__ pool_scale, float* __restrict__ mix) {
    const int lane = threadIdx.x & 63, wave = (blockIdx.x * blockDim.x + threadIdx.x) >> 6, nw = (gridDim.x * blockDim.x) >> 6;
    for (int task = wave; task < NT * 4; task += nw) {
        const int r = task >> 2, gi = task & 3; int s0, len, t; seq_info(r, s0, len, t);
        const int w = 2 << gi; int lo = t - w / 2, hi = t - w / 2 + w; lo = lo < 0 ? 0 : lo; hi = hi > len ? len : hi;
        float s = 0.f;
        for (int tt = lo; tt < hi; ++tt) s += px[(size_t)(s0 + tt) * EVEN_IN + gi * 64 + lane];
        const float pooled = s / (float)(hi - lo) - px[(size_t)r * EVEN_IN + gi * 64 + lane];
        const float* pw = pool_w + (size_t)gi * 4096;
        float acc = 0.f;
        for (int c = 0; c < 64; ++c) acc += __shfl(pooled, c) * pw[c * 64 + lane];
        mix[(size_t)r * D + gi * 64 + lane] = acc * pool_scale[gi * 64 + lane];
    }
}
__global__ __launch_bounds__(256) void k_attn(const float* __restrict__ px, const float* __restrict__ sink, float* __restrict__ mix) {
    __shared__ float pbuf[4][576];
    const int lane = threadIdx.x & 63, wib = threadIdx.x >> 6, wave = (blockIdx.x * blockDim.x + threadIdx.x) >> 6, nw = (gridDim.x * blockDim.x) >> 6;
    float* pb = pbuf[wib];
    for (int task = wave; task < NT * 12; task += nw) {
        const int r = task / 12, hh = task % 12, kvh = hh >> 2;
        const bool lat = r < NX;
        const int b = lat ? (r >> 11) : ((r - NX) >> 8);
        int klo = 0, nloc = 0;
        if (lat) { const int t = r & 2047; klo = t - 128 < 0 ? 0 : t - 128; const int khi = t + 128 > 2047 ? 2047 : t + 128; nloc = khi - klo + 1; }
        const int nkeys = nloc + CTX;
        float q[64];
        const float* qp = px + (size_t)r * EVEN_IN + 256 + hh * 64;
#pragma unroll
        for (int d4 = 0; d4 < 16; ++d4) { const float4 v = *(const float4*)(qp + d4 * 4); q[d4 * 4] = v.x; q[d4 * 4 + 1] = v.y; q[d4 * 4 + 2] = v.z; q[d4 * 4 + 3] = v.w; }
        float mx = sink[hh];
        for (int kidx = lane; kidx < nkeys; kidx += 64) {
            const int krow = kidx < nloc ? (b * SEQ + klo + kidx) : (NX + b * CTX + (kidx - nloc));
            const float* kp = px + (size_t)krow * EVEN_IN + 1024 + kvh * 64;
            float s = 0.f;
#pragma unroll
            for (int d4 = 0; d4 < 16; ++d4) { const float4 v = *(const float4*)(kp + d4 * 4); s += q[d4 * 4] * v.x + q[d4 * 4 + 1] * v.y + q[d4 * 4 + 2] * v.z + q[d4 * 4 + 3] * v.w; }
            s *= 0.125f;
            pb[kidx] = s; mx = fmaxf(mx, s);
        }
        mx = wave_max(mx);
        float den = 0.f;
        for (int kidx = lane; kidx < nkeys; kidx += 64) { const float e = expf(pb[kidx] - mx); pb[kidx] = e; den += e; }
        den = wave_sum(den) + expf(sink[hh] - mx);
        __builtin_amdgcn_wave_barrier();
        float acc = 0.f;
        for (int kidx = 0; kidx < nkeys; ++kidx) {
            const int krow = kidx < nloc ? (b * SEQ + klo + kidx) : (NX + b * CTX + (kidx - nloc));
            acc += pb[kidx] * px[(size_t)krow * EVEN_IN + 1216 + kvh * 64 + lane];
        }
        mix[(size_t)r * D + 256 + hh * 64 + lane] = acc / den;
        __builtin_amdgcn_wave_barrier();
    }
}

struct ScanArrays { float *R, *V, *KK, *G, *W[2], *KD[2], *BB[2], *Y[2]; };
struct OddW { const float *mu, *w0, *w2, *a0, *a2, *g2, *k_k, *k_a, *r_k, *gn_g, *gn_b; };

__global__ __launch_bounds__(256) void k_scanprep(const float* __restrict__ px, OddW w, ScanArrays sa) {
    __shared__ float fl[2720];
    __shared__ float hs[12];
    const int tid = threadIdx.x, lane = tid & 63, wv = tid >> 6;
    for (int r = blockIdx.x; r < NT; r += gridDim.x) {
        int s0, len, t; seq_info(r, s0, len, t);
        const float* pr = px + (size_t)r * ODD_IN;
        for (int col = tid; col < 2720; col += 256) {
            const float u = pr[col], p = t > 0 ? pr[col - ODD_IN] : 0.f, n = t < len - 1 ? pr[col + ODD_IN] : 0.f;
            float f = u + w.mu[col] * (p - u) + w.mu[2720 + col] * (n - u);
            if (col >= 2304 && col < 2432) f = tanhf(f);
            if (col >= 2560) f = sigmoidf_(f);
            fl[col] = f;
        }
        __syncthreads();
        float kkr[3];
#pragma unroll
        for (int i = 0; i < 3; ++i) { const int c = tid + 256 * i; kkr[i] = fl[768 + c] * w.k_k[c]; const float ss = wave_sum(kkr[i] * kkr[i]); if (lane == 0) hs[4 * i + wv] = ss; }
        __syncthreads();
#pragma unroll
        for (int i = 0; i < 3; ++i) {
            const int c = tid + 256 * i, head = c >> 6;
            float lw0 = w.w0[c], lw1 = w.w0[768 + c], la0 = w.a0[c], la1 = w.a0[768 + c], gg = 0.f;
            for (int j = 0; j < 64; ++j) {
                lw0 += fl[2304 + j] * w.w2[(size_t)j * 768 + c];
                lw1 += fl[2368 + j] * w.w2[(size_t)(64 + j) * 768 + c];
                la0 += fl[2432 + j] * w.a2[(size_t)j * 768 + c];
                la1 += fl[2496 + j] * w.a2[(size_t)(64 + j) * 768 + c];
            }
            for (int j = 0; j < 160; ++j) gg += fl[2560 + j] * w.g2[(size_t)j * 768 + c];
            const float kk = kkr[i] / fmaxf(sqrtf(hs[head]), 1e-12f);
            const float k = fl[768 + c], v = fl[1536 + c], rr = fl[c], ka = w.k_a[c];
            const size_t o = (size_t)r * RW + c;
            sa.R[o] = rr; sa.V[o] = v; sa.KK[o] = kk; sa.G[o] = gg;
            {
                const float z0 = -lw0, sp0 = fmaxf(z0, 0.f) + log1pf(expf(-fabsf(z0))); const float wl0 = -sp0 - 0.5f;
                const float z1 = -lw1, sp1 = fmaxf(z1, 0.f) + log1pf(expf(-fabsf(z1))); const float wl1 = -sp1 - 0.5f;
                sa.W[0][o] = expf(-expf(wl0)); sa.W[1][o] = expf(-expf(wl1));
            }
            const float a_0 = sigmoidf_(la0), a_1 = sigmoidf_(la1);
            sa.KD[0][o] = k * (1.f + (a_0 - 1.f) * ka); sa.KD[1][o] = k * (1.f + (a_1 - 1.f) * ka);
            sa.BB[0][o] = kk * a_0; sa.BB[1][o] = kk * a_1;
        }
        __syncthreads();
    }
}

__global__ __launch_bounds__(64) void k_scan(ScanArrays sa) {
    __shared__ float sh[5][64];
    const int lane = threadIdx.x;
    const int chain = blockIdx.x, dir = chain & 1, bh = chain >> 1, b = bh / 12, hh = bh % 12;
    const float* Wd = sa.W[dir]; const float* KD = sa.KD[dir]; const float* BB = sa.BB[dir]; float* Y = sa.Y[dir];
    float S[64];
#pragma unroll
    for (int j = 0; j < 64; ++j) S[j] = 0.f;
    for (int s = 0; s < CTX + SEQ; ++s) {
        int tok;
        if (s < CTX) { const int tt = dir ? CTX - 1 - s : s; tok = NX + b * CTX + tt; }
        else { int tt = s - CTX; tt = dir ? SEQ - 1 - tt : tt; tok = b * SEQ + tt; }
        const size_t off = (size_t)tok * RW + hh * 64 + lane;
        const float v = sa.V[off];
        __builtin_amdgcn_wave_barrier();
        sh[0][lane] = Wd[off]; sh[1][lane] = KD[off]; sh[2][lane] = BB[off]; sh[3][lane] = sa.KK[off]; sh[4][lane] = sa.R[off];
        __builtin_amdgcn_wave_barrier();
        float sacc = 0.f;
#pragma unroll
        for (int j = 0; j < 64; ++j) sacc += S[j] * sh[3][j];
#pragma unroll
        for (int j = 0; j < 64; ++j) S[j] = S[j] * sh[0][j] + (v * sh[1][j] - sacc * sh[2][j]);
        float y = 0.f;
#pragma unroll
        for (int j = 0; j < 64; ++j) y += S[j] * sh[4][j];
        Y[off] = y;
    }
}

__global__ __launch_bounds__(256) void k_readout(ScanArrays sa, OddW w, float* __restrict__ mix) {
    const int lane = threadIdx.x & 63, wave = (blockIdx.x * blockDim.x + threadIdx.x) >> 6, nw = (gridDim.x * blockDim.x) >> 6;
    for (int task = wave; task < NT * 12; task += nw) {
        const int r = task / 12, hh = task % 12, c = hh * 64 + lane;
        const size_t o = (size_t)r * RW + c;
        const float y = sa.Y[0][o] + sa.Y[1][o];
        const float mean = wave_sum(y) * (1.f / 64.f), d = y - mean, var = wave_sum(d * d) * (1.f / 64.f);
        const float yn = d * rsqrtf(var + 64e-5f) * w.gn_g[c] + w.gn_b[c];
        const float coef = wave_sum(sa.R[o] * (sa.KD[0][o] + sa.KD[1][o]) * w.r_k[c]);
        mix[(size_t)r * D + c] = (yn + coef * sa.V[o]) * sa.G[o];
    }
}

__global__ __launch_bounds__(256) void k_fft_prep(const float* __restrict__ px, float* __restrict__ bm_lat, float* __restrict__ bm_ctx) {
    __shared__ float cs[64], sn[64];
    if (threadIdx.x < 64) { const float a = 6.283185307179586f * (float)threadIdx.x / 64.f; cs[threadIdx.x] = cosf(a); sn[threadIdx.x] = sinf(a); }
    __syncthreads();
    const int lane = threadIdx.x & 63, wave = (blockIdx.x * blockDim.x + threadIdx.x) >> 6, nw = (gridDim.x * blockDim.x) >> 6;
    for (int task = wave; task < NT * 4; task += nw) {
        const int r = task >> 2, g = task & 3;
        const float u = px[(size_t)r * ODD_IN + 2720 + g * 64 + lane];
        float u1 = 0.f, u2 = 0.f;
        for (int c = 0; c < 64; ++c) { const float uc = __shfl(u, c); const int m = (lane * c) & 63; u1 += uc * cs[m]; u2 += uc * sn[m]; }
        if (r < NX) { const int b = r >> 11, t = r & 2047; float* base = bm_lat + ((size_t)(b * 4 + g) * 4096) * 64; base[(size_t)t * 64 + lane] = u1; base[(size_t)(2048 + t) * 64 + lane] = u2; }
        else { const int q = r - NX, b = q >> 8, t = q & 255; float* base = bm_ctx + ((size_t)(b * 4 + g) * 512) * 64; base[(size_t)t * 64 + lane] = u1; base[(size_t)(256 + t) * 64 + lane] = u2; }
    }
}
__global__ __launch_bounds__(256) void k_twiddle(float* __restrict__ tw, int T) {
    const size_t total = (size_t)T * T;
    for (size_t i = (size_t)blockIdx.x * blockDim.x + threadIdx.x; i < total; i += (size_t)gridDim.x * blockDim.x) {
        const int k1 = (int)(i / T), t = (int)(i % T); const int m = (int)(((long long)k1 * t) % T);
        const float a = 6.283185307179586f * (float)m / (float)T;
        tw[(size_t)k1 * 2 * T + t] = cosf(a); tw[(size_t)k1 * 2 * T + T + t] = -sinf(a);
    }
}
__global__ __launch_bounds__(512) void k_fft_gemm(const float* __restrict__ tw, const float* __restrict__ bm, float* __restrict__ mix, int T, int row0) {
    extern __shared__ float lds[];
    const int mt_n = T / 128, nunits = 64 * mt_n; const float scale = rsqrtf((float)T * 64.f);
    for (int u = blockIdx.x; u < nunits; u += gridDim.x) {
        const int bg = u / mt_n, mt = u % mt_n, b = bg >> 2, g = bg & 3;
        gemm_tile(lds, [&](int r) { return tw + (size_t)r * 2 * T; }, bm + (size_t)bg * 2 * T * 64, 64, 64, 2 * T, mt * 128, 0,
                  [&](int row, int col, float4 v) { float4 o = make_float4(v.x * scale, v.y * scale, v.z * scale, v.w * scale);
                      *(float4*)(mix + (size_t)(row0 + b * T + row) * D + 768 + g * 64 + col) = o; });
    }
}

struct MoeBufs { int* tok_e; int* tok_pos; float* tok_gate; int* cnt; int* pstart; int* tile_e; int* row_tok; float* Hp; float* Yp; };

__global__ __launch_bounds__(256) void k_moe_init(MoeBufs m) {
    const int i = blockIdx.x * blockDim.x + threadIdx.x;
    if (i < NEXP) m.cnt[i] = 0;
    for (int j = i; j < MOE_ROWS; j += gridDim.x * blockDim.x) m.row_tok[j] = -1;
}
__global__ __launch_bounds__(256) void k_router(const float* __restrict__ fx, const float* __restrict__ rw, const float* __restrict__ rb, MoeBufs m, int nrows) {
    const int lane = threadIdx.x & 63, wave = (blockIdx.x * blockDim.x + threadIdx.x) >> 6, nw = (gridDim.x * blockDim.x) >> 6;
    const int e = lane & 31, half = lane >> 5;
    for (int r = wave; r < nrows; r += nw) {
        const float* xr = fx + (size_t)r * D;
        float acc = 0.f;
        for (int d = half; d < D; d += 2) acc += xr[d] * rw[d * NEXP + e];
        acc += __shfl_xor(acc, 32);
        float logit = acc + rb[e];
        float tv[4]; int ti[4];
#pragma unroll
        for (int k = 0; k < 4; ++k) {
            const float mx = wave_max(logit);
            const unsigned long long bal = __ballot(logit == mx);
            const int sel = (__ffsll((long long)bal) - 1) & 31;
            tv[k] = mx; ti[k] = sel;
            if (e == sel) logit = -INFINITY;
        }
        const float e1 = expf(tv[1] - tv[0]), e2 = expf(tv[2] - tv[0]), e3 = expf(tv[3] - tv[0]);
        const float inv = 1.f / (1.f + e1 + e2 + e3);
        if (lane < 4) {
            const float gk = lane == 0 ? inv : lane == 1 ? e1 * inv : lane == 2 ? e2 * inv : e3 * inv;
            const int ek = lane == 0 ? ti[0] : lane == 1 ? ti[1] : lane == 2 ? ti[2] : ti[3];
            const int pos = atomicAdd(&m.cnt[ek], 1);
            m.tok_e[r * 4 + lane] = ek; m.tok_pos[r * 4 + lane] = pos; m.tok_gate[r * 4 + lane] = gk;
        }
    }
}
__global__ __launch_bounds__(256) void k_moe_offsets(MoeBufs m) {
    __shared__ int ps[NEXP + 1];
    if (threadIdx.x == 0) { int s = 0; for (int e = 0; e < NEXP; ++e) { ps[e] = s; s += (m.cnt[e] + 255) / 256 * 256; } ps[NEXP] = s; }
    __syncthreads();
    if (threadIdx.x <= NEXP) m.pstart[threadIdx.x] = ps[threadIdx.x];
    for (int t = threadIdx.x; t < MOE_TILES; t += blockDim.x) {
        const int row = t * 128; int e = -1;
        for (int q = 0; q < NEXP; ++q) if (row >= ps[q] && row < ps[q + 1]) e = q;
        m.tile_e[t] = e;
    }
}
__global__ __launch_bounds__(256) void k_moe_scatter(MoeBufs m, int nrows) {
    for (int i = blockIdx.x * blockDim.x + threadIdx.x; i < nrows * 4; i += gridDim.x * blockDim.x)
        m.row_tok[m.pstart[m.tok_e[i]] + m.tok_pos[i]] = i >> 2;
}
__device__ __forceinline__ float swiglu1(float glu, float lin) {
    glu = fminf(glu, 7.f); lin = fminf(fmaxf(lin, -7.f), 7.f);
    return glu * (1.f / (1.f + expf(-1.702f * glu))) * (lin + 1.f);
}
__global__ __launch_bounds__(512) void k_moe_gu(const float* __restrict__ fx, const float* __restrict__ wgu, const float* __restrict__ bgu, MoeBufs m) {
    extern __shared__ float lds[];
    const int nct = 2048 / 64, nunits = MOE_TILES * nct;
    for (int u = blockIdx.x; u < nunits; u += gridDim.x) {
        const int mt = u / nct, ct = u % nct, e = m.tile_e[mt];
        if (e < 0) continue;
        const float* bias = bgu + (size_t)e * 2048;
        gemm_tile(lds, [&](int r) { const int t = m.row_tok[r]; return t >= 0 ? fx + (size_t)t * D : (const float*)nullptr; },
                  wgu + (size_t)e * 1024 * 2048, 2048, 2048, 1024, mt * 128, ct * 64,
                  [&](int row, int col, float4 v) { const float4 bb = *(const float4*)(bias + col);
                      float2 o; o.x = swiglu1(v.x + bb.x, v.y + bb.y); o.y = swiglu1(v.z + bb.z, v.w + bb.w);
                      *(float2*)(m.Hp + (size_t)row * 1024 + (col >> 1)) = o; });
    }
}
__global__ __launch_bounds__(512) void k_moe_dn(const float* __restrict__ wdn, const float* __restrict__ bdn, MoeBufs m) {
    extern __shared__ float lds[];
    const int nct = 1024 / 64, nunits = MOE_TILES * nct;
    for (int u = blockIdx.x; u < nunits; u += gridDim.x) {
        const int mt = u / nct, ct = u % nct, e = m.tile_e[mt];
        if (e < 0) continue;
        const float* bias = bdn + (size_t)e * 1024;
        gemm_tile(lds, [&](int r) { return m.Hp + (size_t)r * 1024; }, wdn + (size_t)e * 1024 * 1024, 1024, 1024, 1024, mt * 128, ct * 64,
                  [&](int row, int col, float4 v) { const float4 bb = *(const float4*)(bias + col);
                      *(float4*)(m.Yp + (size_t)row * 1024 + col) = make_float4(v.x + bb.x, v.y + bb.y, v.z + bb.z, v.w + bb.w); });
    }
}
__global__ __launch_bounds__(256) void k_moe_combine(float* __restrict__ h, const float* __restrict__ modl, int gate_off, MoeBufs m, int nrows) {
    const int lane = threadIdx.x & 63, wave = (blockIdx.x * blockDim.x + threadIdx.x) >> 6, nw = (gridDim.x * blockDim.x) >> 6;
    for (int r = wave; r < nrows; r += nw) {
        int dest[4]; float gk[4];
#pragma unroll
        for (int k = 0; k < 4; ++k) { dest[k] = m.pstart[m.tok_e[r * 4 + k]] + m.tok_pos[r * 4 + k]; gk[k] = m.tok_gate[r * 4 + k]; }
        const float* mr = modl + (size_t)mod_row(r) * MODW + gate_off;
#pragma unroll
        for (int i = 0; i < 4; ++i) {
            const int col = (lane + 64 * i) * 4;
            float4 s = make_float4(0.f, 0.f, 0.f, 0.f);
#pragma unroll
            for (int k = 0; k < 4; ++k) { const float4 y = *(const float4*)(m.Yp + (size_t)dest[k] * 1024 + col); s.x += gk[k] * y.x; s.y += gk[k] * y.y; s.z += gk[k] * y.z; s.w += gk[k] * y.w; }
            const float4 g = *(const float4*)(mr + col);
            float4* hp = (float4*)(h + (size_t)r * D + col); float4 o = *hp;
            o.x += g.x * s.x; o.y += g.y * s.y; o.z += g.z * s.z; o.w += g.w * s.w; *hp = o;
        }
    }
}
}

extern "C" void kernel_launch(void* const* d_in, const int* in_sizes, int n_in, void* d_out, int out_size, void* d_ws, size_t ws_size, hipStream_t stream) {
    const float* x = (const float*)d_in[0];        const float* c = (const float*)d_in[1];
    const float* ctx = (const float*)d_in[2];      const float* c_ctx = (const float*)d_in[3];
    const float* ada_w = (const float*)d_in[4];    const float* ada_b = (const float*)d_in[5];
    const float* norm_mix_g = (const float*)d_in[6]; const float* norm_ffn_g = (const float*)d_in[7];
    const float* ev_w_in = (const float*)d_in[8];  const float* ev_w_out = (const float*)d_in[9];
    const float* pool_w = (const float*)d_in[10];  const float* pool_scale = (const float*)d_in[11];
    const float* att_sink = (const float*)d_in[12];
    const float* od_w_in = (const float*)d_in[13]; const float* od_w_out = (const float*)d_in[14];
    const float* rw_mu = (const float*)d_in[15];   const float* rw_w0 = (const float*)d_in[16];
    const float* rw_w2 = (const float*)d_in[17];   const float* rw_a0 = (const float*)d_in[18];
    const float* rw_a2 = (const float*)d_in[19];   const float* rw_g2 = (const float*)d_in[20];
    const float* rw_k_k = (const float*)d_in[21];  const float* rw_k_a = (const float*)d_in[22];
    const float* rw_r_k = (const float*)d_in[23];  const float* rw_gn_g = (const float*)d_in[24];
    const float* rw_gn_b = (const float*)d_in[25];
    const float* router_w = (const float*)d_in[26]; const float* router_b = (const float*)d_in[27];
    const float* exp_w_gu = (const float*)d_in[28]; const float* exp_b_gu = (const float*)d_in[29];
    const float* exp_w_dn = (const float*)d_in[30]; const float* exp_b_dn = (const float*)d_in[31];
    const float* final_g = (const float*)d_in[32];
    float* out = (float*)d_out;

    float* ws = (float*)d_ws; size_t off = 0;
    auto take = [&](size_t n) { float* p = ws + off; off += (n + 63) & ~(size_t)63; return p; };
    float* mod = take((size_t)4 * 17 * MODW);
    float* h = take((size_t)NT * D);
    float* a = take((size_t)NT * D);
    float* mix = take((size_t)NT * D);
    float* tw_lat = take((size_t)2048 * 4096);
    float* tw_ctx = take((size_t)256 * 512);
    MoeBufs mb;
    mb.tok_e = (int*)take((size_t)NT * 4); mb.tok_pos = (int*)take((size_t)NT * 4); mb.tok_gate = take((size_t)NT * 4);
    mb.cnt = (int*)take(64); mb.pstart = (int*)take(64); mb.tile_e = (int*)take(MOE_TILES); mb.row_tok = (int*)take(MOE_ROWS);
    const size_t scratch0 = off;
    float* px = take((size_t)NT * ODD_IN);
    ScanArrays sa;
    sa.R = take((size_t)NT * RW); sa.V = take((size_t)NT * RW); sa.KK = take((size_t)NT * RW); sa.G = take((size_t)NT * RW);
    for (int d = 0; d < 2; ++d) { sa.W[d] = take((size_t)NT * RW); sa.KD[d] = take((size_t)NT * RW); sa.BB[d] = take((size_t)NT * RW); sa.Y[d] = take((size_t)NT * RW); }
    float* bm_lat = take((size_t)64 * 4096 * 64);
    float* bm_ctx = take((size_t)64 * 512 * 64);
    const size_t mixer_end = off;
    off = scratch0;
    mb.Hp = take((size_t)MOE_ROWS * 1024); mb.Yp = take((size_t)MOE_ROWS * 1024);
    const size_t total = (off > mixer_end ? off : mixer_end) * sizeof(float);
    if (total > ws_size) { fprintf(stderr, "kernel_launch: workspace too small: need %zu have %zu\n", total, ws_size); return; }

    static bool attr_done = false;
    const int ADA_LDS = (17 * 1024 + 8 * 17 * 64) * 4, G_LDS = GEMM_LDS_FLOATS * 4;
    if (!attr_done) { hipFuncSetAttribute((const void*)k_ada, hipFuncAttributeMaxDynamicSharedMemorySize, ADA_LDS); attr_done = true; }

    k_copy<<<2048, 256, 0, stream>>>(x, ctx, h);
    k_ada<<<384, 512, ADA_LDS, stream>>>(c, c_ctx, ada_w, ada_b, mod);
    k_twiddle<<<2048, 256, 0, stream>>>(tw_lat, 2048);
    k_twiddle<<<256, 256, 0, stream>>>(tw_ctx, 256);

    for (int i = 0; i < 4; ++i) {
        const int j = i / 2; const bool last = (i == 3);
        const float* modl = mod + (size_t)i * 17 * MODW;
        k_norm_mod<<<2048, 256, 0, stream>>>(h, norm_mix_g + i * D, modl, 0, 1024, a, NT);
        if (i % 2 == 0) {
            k_gemm_plain<<<2048, 512, G_LDS, stream>>>(a, D, ev_w_in + (size_t)j * D * EVEN_IN, EVEN_IN, px, EVEN_IN, NT, EVEN_IN, D);
            k_rope<<<4096, 256, 0, stream>>>(px);
            k_pool<<<4096, 256, 0, stream>>>(px, pool_w + (size_t)j * 4 * 4096, pool_scale + j * 256, mix);
            k_attn<<<8192, 256, 0, stream>>>(px, att_sink + j * 12, mix);
            k_gemm_resid<<<2048, 512, G_LDS, stream>>>(mix, ev_w_out + (size_t)j * D * D, h, modl, 2048);
        } else {
            k_gemm_plain<<<2048, 512, G_LDS, stream>>>(a, D, od_w_in + (size_t)j * D * ODD_IN, ODD_IN, px, ODD_IN, NT, ODD_IN, D);
            OddW w;
            w.mu = rw_mu + (size_t)j * 2 * 2720; w.w0 = rw_w0 + (size_t)j * 2 * 768; w.w2 = rw_w2 + (size_t)j * 2 * 64 * 768;
            w.a0 = rw_a0 + (size_t)j * 2 * 768; w.a2 = rw_a2 + (size_t)j * 2 * 64 * 768; w.g2 = rw_g2 + (size_t)j * 160 * 768;
            w.k_k = rw_k_k + j * 768; w.k_a = rw_k_a + j * 768; w.r_k = rw_r_k + j * 768; w.gn_g = rw_gn_g + j * 768; w.gn_b = rw_gn_b + j * 768;
            k_scanprep<<<4096, 256, 0, stream>>>(px, w, sa);
            k_scan<<<NB * 12 * 2, 64, 0, stream>>>(sa);
            k_readout<<<4096, 256, 0, stream>>>(sa, w, mix);
            k_fft_prep<<<4096, 256, 0, stream>>>(px, bm_lat, bm_ctx);
            k_fft_gemm<<<1024, 512, G_LDS, stream>>>(tw_lat, bm_lat, mix, 2048, 0);
            k_fft_gemm<<<128, 512, G_LDS, stream>>>(tw_ctx, bm_ctx, mix, 256, NX);
            k_gemm_resid<<<2048, 512, G_LDS, stream>>>(mix, od_w_out + (size_t)j * D * D, h, modl, 2048);
        }
        const int nrows = last ? NX : NT;
        k_moe_init<<<256, 256, 0, stream>>>(mb);
        k_norm_mod<<<2048, 256, 0, stream>>>(h, norm_ffn_g + i * D, modl, 3072, 4096, a, nrows);
        k_router<<<2048, 256, 0, stream>>>(a, router_w + (size_t)i * D * NEXP, router_b + i * NEXP, mb, nrows);
        k_moe_offsets<<<1, 256, 0, stream>>>(mb);
        k_moe_scatter<<<1024, 256, 0, stream>>>(mb, nrows);
        k_moe_gu<<<4096, 512, G_LDS, stream>>>(a, exp_w_gu + (size_t)i * NEXP * 1024 * 2048, exp_b_gu + (size_t)i * NEXP * 2048, mb);
        k_moe_dn<<<4096, 512, G_LDS, stream>>>(exp_w_dn + (size_t)i * NEXP * 1024 * 1024, exp_b_dn + (size_t)i * NEXP * 1024, mb);
        k_moe_combine<<<2048, 256, 0, stream>>>(h, modl, 5120, mb, nrows);
    }
    k_norm_mod<<<2048, 256, 0, stream>>>(h, final_g, nullptr, 0, 0, out, NX);
}
```

```cpp
#include <hip/hip_runtime.h>
#include <stdint.h>
#include <stdio.h>
#include <string.h>

namespace {
constexpr int D = 1024, NB = 16, SEQ = 2048, CTX = 256;
constexpr int NX = NB * SEQ, NC = NB * CTX, NT = NX + NC;
constexpr int EVEN_IN = 1408, ODD_IN = 2976;
constexpr int RW = 768;
constexpr int NEXP = 32, TOPK = 4;
constexpr int MOE_ROWS = ((NT * TOPK + 255) / 256 + NEXP) * 256;
constexpr int MOE_TILES = MOE_ROWS / 128;
constexpr int MODW = 6 * D;
constexpr int NTHR = 512, NWAVE = 8;
constexpr int LDS_BYTES = 132 * 1024;

#define XB_TMO      128
#define XB_XCNT(j)  (256  + 64 * (j))
#define XB_XSUB(j)  (1280 + 64 * (j))
#define XB_XGEN(j)  (2304 + 64 * (j))
#define XB_TOP      3328
#define XB_TOPGEN   3392
#define XCD_BAR_WORDS 3456
#define XB_SPIN_CAP (1u << 22)
#define LAS __attribute__((address_space(3)))

__device__ __forceinline__ unsigned xb_ld(unsigned* p)              { return __hip_atomic_load(p, __ATOMIC_RELAXED, __HIP_MEMORY_SCOPE_AGENT); }
__device__ __forceinline__ unsigned xb_add(unsigned* p, unsigned v) { return __hip_atomic_fetch_add(p, v, __ATOMIC_RELAXED, __HIP_MEMORY_SCOPE_AGENT); }
__device__ __forceinline__ unsigned xb_xcc_id() { return (unsigned)__builtin_amdgcn_s_getreg((3 << 11) | 20) & 0xFu; }
#define XB_SPIN(cond, bar) do { unsigned _sp = 0; while (cond) { __builtin_amdgcn_s_sleep(1); \
    if ((++_sp & 255u) == 0u) { if (xb_ld(&(bar)[XB_TMO])) break; if (_sp > XB_SPIN_CAP) { atomicAdd(&(bar)[XB_TMO], 1u); break; } } } } while (0)

struct XcdBarrier { unsigned* bar; unsigned x; volatile LAS unsigned* st; };

__device__ __forceinline__ XcdBarrier xcd_barrier_post(unsigned* bar, volatile LAS unsigned* st) {
    XcdBarrier b; b.bar = bar; b.x = xb_xcc_id(); b.st = st;
    if (threadIdx.x == 0) (void)xb_add(&bar[XB_XCNT(b.x)], 1u);
    return b;
}
__device__ __forceinline__ void xcd_barrier_complete(unsigned* bar, unsigned x, unsigned& nloc, unsigned& nx) {
    const unsigned G = gridDim.x * gridDim.y * gridDim.z;
    unsigned sum, cnt, mine, sp = 0u;
    for (;;) {
        sum = 0u; cnt = 0u; mine = 0u;
#pragma unroll
        for (unsigned j = 0; j < 16; ++j) { const unsigned c = xb_ld(&bar[XB_XCNT(j)]); sum += c; cnt += (c > 0u) ? 1u : 0u; mine = (j == x) ? c : mine; }
        if (sum == G) break;
        __builtin_amdgcn_s_sleep(1);
        if ((++sp & 255u) == 0u) { if (xb_ld(&bar[XB_TMO])) break; if (sp > XB_SPIN_CAP) { atomicAdd(&bar[XB_TMO], 1u); break; } }
    }
    nloc = mine > 0u ? mine : 1u; nx = cnt > 0u ? cnt : 1u;
}
__device__ __forceinline__ void xcd_barrier(const XcdBarrier& b) {
    asm volatile("s_waitcnt vmcnt(0)" ::: "memory");
    __syncthreads();
    if (threadIdx.x == 0) {
        unsigned* bar = b.bar;
        __builtin_amdgcn_s_waitcnt(0);
        unsigned nloc = b.st[0], nx = b.st[1];
        if (nloc == 0u) { xcd_barrier_complete(bar, b.x, nloc, nx); b.st[0] = nloc; b.st[1] = nx; }
        const unsigned old = xb_add(&bar[XB_XSUB(b.x)], 1u);
        const unsigned gen = old / nloc;
        if (old + 1u == (gen + 1u) * nloc) {
            __builtin_amdgcn_fence(__ATOMIC_RELEASE, "agent");
            asm volatile("s_waitcnt vmcnt(0)" ::: "memory");
            const unsigned og = xb_add(&bar[XB_TOP], 1u);
            const unsigned tg = og / nx;
            if (og + 1u == (tg + 1u) * nx) xb_add(&bar[XB_TOPGEN], 1u);
            else XB_SPIN(xb_ld(&bar[XB_TOPGEN]) == tg, bar);
            __builtin_amdgcn_fence(__ATOMIC_ACQUIRE, "agent");
            xb_add(&bar[XB_XGEN(b.x)], 1u);
            asm volatile("s_waitcnt vmcnt(0)" ::: "memory");
        } else {
            XB_SPIN(xb_ld(&bar[XB_XGEN(b.x)]) == gen, bar);
            __builtin_amdgcn_fence(__ATOMIC_ACQUIRE, "agent");
            asm volatile("s_waitcnt vmcnt(0)" ::: "memory");
        }
    }
    __syncthreads();
}

#define PH __device__ __forceinline__
PH float wave_sum(float v) {
#pragma unroll
    for (int o = 32; o >= 1; o >>= 1) v += __shfl_xor(v, o);
    return v;
}
PH float wave_max(float v) {
#pragma unroll
    for (int o = 32; o >= 1; o >>= 1) v = fmaxf(v, __shfl_xor(v, o));
    return v;
}
PH int mod_row(int r) { return r < NX ? (r >> 11) : 16; }
PH void seq_info(int r, int& s0, int& len, int& t) {
    if (r < NX) { s0 = r & ~2047; len = SEQ; t = r & 2047; }
    else { const int q = r - NX; s0 = NX + (q & ~255); len = CTX; t = q & 255; }
}
PH float sigmoidf_(float x) { return 1.f / (1.f + expf(-x)); }

struct ScanArrays { float *R, *V, *KK, *G, *W[2], *KD[2], *BB[2], *Y[2]; };
struct OddW { const float *mu, *w0, *w2, *a0, *a2, *g2, *k_k, *k_a, *r_k, *gn_g, *gn_b; };
struct MoeBufs { int* tok_e; int* tok_pos; float* tok_gate; int* cnt; int* row_tok; float* Hp; float* Yp; };

struct Params {
    const float *x, *c, *ctx, *c_ctx, *ada_w, *ada_b, *norm_mix_g, *norm_ffn_g, *ev_w_in, *ev_w_out, *pool_w, *pool_scale, *att_sink;
    const float *od_w_in, *od_w_out, *rw_mu, *rw_w0, *rw_w2, *rw_a0, *rw_a2, *rw_g2, *rw_k_k, *rw_k_a, *rw_r_k, *rw_gn_g, *rw_gn_b;
    const float *router_w, *router_b, *exp_w_gu, *exp_b_gu, *exp_w_dn, *exp_b_dn, *final_g;
    float* out; unsigned* bar;
    float *mod, *h, *a, *mix, *tw_lat, *tw_ctx, *px, *bm_lat, *bm_ctx;
    ScanArrays sa; MoeBufs mb;
};

PH int TID() { int t = threadIdx.x; asm volatile("" : "+v"(t)); return t; }
PH int BID() { int t = blockIdx.x; asm volatile("" : "+s"(t)); return t; }
PH void ph_copy(const Params& p) {
    const size_t n4x = (size_t)NX * D / 4, n4 = (size_t)NT * D / 4;
    for (size_t i = (size_t)BID() * NTHR + TID(); i < n4; i += (size_t)gridDim.x * NTHR)
        ((float4*)p.h)[i] = i < n4x ? ((const float4*)p.x)[i] : ((const float4*)p.ctx)[i - n4x];
}
PH void ph_ada(const Params& p, float* lds) {
    float* sc = lds;
    float* part = lds + 17 * 1024;
    const int tid = TID();
    for (int i = tid; i < 17 * 1024; i += NTHR) { const int r = i >> 10, k = i & 1023; const float v = r < 16 ? p.c[r * 1024 + k] : p.c_ctx[k]; sc[i] = v / (1.f + expf(-v)); }
    __syncthreads();
    for (int unit = BID(); unit < 4 * 96; unit += gridDim.x) {
        const int l = unit / 96, cb = unit % 96, cl = tid & 63, ks = tid >> 6;
        const float* W = p.ada_w + (size_t)l * 1024 * MODW + cb * 64 + cl;
        float acc[17];
#pragma unroll
        for (int r = 0; r < 17; ++r) acc[r] = 0.f;
        for (int k = ks * 128; k < ks * 128 + 128; ++k) {
            const float w = W[(size_t)k * MODW];
#pragma unroll
            for (int r = 0; r < 17; ++r) acc[r] += sc[r * 1024 + k] * w;
        }
#pragma unroll
        for (int r = 0; r < 17; ++r) part[(ks * 17 + r) * 64 + cl] = acc[r];
        __syncthreads();
        for (int i = tid; i < 17 * 64; i += NTHR) {
            const int r = i >> 6, cc = i & 63; float s = 0.f;
#pragma unroll
            for (int q = 0; q < 8; ++q) s += part[(q * 17 + r) * 64 + cc];
            p.mod[((size_t)l * 17 + r) * MODW + cb * 64 + cc] = s + p.ada_b[l * MODW + cb * 64 + cc];
        }
        __syncthreads();
    }
}
PH void ph_twiddle(float* tw, int T) {
    const size_t total = (size_t)T * T;
    for (size_t i = (size_t)BID() * NTHR + TID(); i < total; i += (size_t)gridDim.x * NTHR) {
        const int k1 = (int)(i / T), t = (int)(i % T); const int m = (int)(((long long)k1 * t) % T);
        const float a = 6.283185307179586f * (float)m / (float)T;
        tw[(size_t)k1 * 2 * T + t] = cosf(a); tw[(size_t)k1 * 2 * T + T + t] = -sinf(a);
    }
}
PH void ph_norm_mod(const float* h, const float* g, const float* modl, int sh_off, int sc_off, float* out, int nrows) {
    const int lane = TID() & 63, wave = (BID() * NTHR + TID()) >> 6, nw = gridDim.x * NWAVE;
    for (int r = wave; r < nrows; r += nw) {
        const float4* hp = (const float4*)(h + (size_t)r * D);
        float4 v[4]; float ss = 0.f;
#pragma unroll
        for (int i = 0; i < 4; ++i) { v[i] = hp[lane + 64 * i]; ss += v[i].x * v[i].x + v[i].y * v[i].y + v[i].z * v[i].z + v[i].w * v[i].w; }
        ss = wave_sum(ss);
        const float rs = rsqrtf(ss * (1.f / 1024.f) + 1e-5f);
        const float* mr = modl ? modl + (size_t)mod_row(r) * MODW : nullptr;
#pragma unroll
        for (int i = 0; i < 4; ++i) {
            const int col = (lane + 64 * i) * 4;
            const float4 gg = *(const float4*)(g + col);
            float4 o; o.x = v[i].x * rs * gg.x; o.y = v[i].y * rs * gg.y; o.z = v[i].z * rs * gg.z; o.w = v[i].w * rs * gg.w;
            if (mr) {
                const float4 sh = *(const float4*)(mr + sh_off + col), sc = *(const float4*)(mr + sc_off + col);
                o.x = o.x * (1.f + sc.x) + sh.x; o.y = o.y * (1.f + sc.y) + sh.y; o.z = o.z * (1.f + sc.z) + sh.z; o.w = o.w * (1.f + sc.w) + sh.w;
            }
            *(float4*)(out + (size_t)r * D + col) = o;
        }
    }
}

constexpr int GLDA = 132;
template <class ARow, class EPI>
PH void gemm_tile(float* lds, ARow arow, const float* __restrict__ B, int ldb, int N, int K, int m0, int n0, EPI epi) {
    float* As = lds; float* Bs = lds + 16 * GLDA;
    const int tid = TID(), ty = tid >> 4, tx = tid & 15;
    const int ar = tid >> 2, akq = (tid & 3) * 4;
    const float* ap = arow(m0 + ar);
    const int bk = (tid & 255) >> 4, bn = (tid & 15) * 4;
    const bool bload = tid < 256 && (n0 + bn) < N;
    float acc[4][4];
#pragma unroll
    for (int i = 0; i < 4; ++i)
#pragma unroll
        for (int j = 0; j < 4; ++j) acc[i][j] = 0.f;
    for (int k0 = 0; k0 < K; k0 += 16) {
        float4 av = make_float4(0.f, 0.f, 0.f, 0.f), bv = make_float4(0.f, 0.f, 0.f, 0.f);
        if (ap) av = *(const float4*)(ap + k0 + akq);
        if (bload) bv = *(const float4*)(B + (size_t)(k0 + bk) * ldb + n0 + bn);
        __syncthreads();
        As[(akq + 0) * GLDA + ar] = av.x; As[(akq + 1) * GLDA + ar] = av.y; As[(akq + 2) * GLDA + ar] = av.z; As[(akq + 3) * GLDA + ar] = av.w;
        if (tid < 256) *(float4*)&Bs[bk * 64 + bn] = bv;
        __syncthreads();
#pragma unroll
        for (int k = 0; k < 16; ++k) {
            const float4 a = *(const float4*)&As[k * GLDA + ty * 4];
            const float4 b = *(const float4*)&Bs[k * 64 + tx * 4];
            acc[0][0] += a.x * b.x; acc[0][1] += a.x * b.y; acc[0][2] += a.x * b.z; acc[0][3] += a.x * b.w;
            acc[1][0] += a.y * b.x; acc[1][1] += a.y * b.y; acc[1][2] += a.y * b.z; acc[1][3] += a.y * b.w;
            acc[2][0] += a.z * b.x; acc[2][1] += a.z * b.y; acc[2][2] += a.z * b.z; acc[2][3] += a.z * b.w;
            acc[3][0] += a.w * b.x; acc[3][1] += a.w * b.y; acc[3][2] += a.w * b.z; acc[3][3] += a.w * b.w;
        }
    }
    __syncthreads();
    const int col = n0 + tx * 4;
    if (col < N) {
#pragma unroll
        for (int i = 0; i < 4; ++i) epi(m0 + ty * 4 + i, col, make_float4(acc[i][0], acc[i][1], acc[i][2], acc[i][3]));
    }
}
PH void ph_gemm_plain(float* lds, const float* A, int lda, const float* B, int ldb, float* C, int ldc, int M, int N, int K) {
    const int nct = (N + 63) / 64, nunits = (M / 128) * nct;
    for (int u = BID(); u < nunits; u += gridDim.x) {
        const int mt = u / nct, ct = u % nct;
        gemm_tile(lds, [&](int r) { return A + (size_t)r * lda; }, B, ldb, N, K, mt * 128, ct * 64,
                  [&](int row, int col, float4 v) { *(float4*)(C + (size_t)row * ldc + col) = v; });
    }
}
PH void ph_gemm_resid(float* lds, const float* A, const float* B, float* h, const float* modl, int gate_off) {
    const int nct = D / 64, nunits = (NT / 128) * nct;
    for (int u = BID(); u < nunits; u += gridDim.x) {
        const int mt = u / nct, ct = u % nct;
        gemm_tile(lds, [&](int r) { return A + (size_t)r * D; }, B, D, D, D, mt * 128, ct * 64,
                  [&](int row, int col, float4 v) {
                      const float4 g = *(const float4*)(modl + (size_t)mod_row(row) * MODW + gate_off + col);
                      float4* hp = (float4*)(h + (size_t)row * D + col); float4 o = *hp;
                      o.x += g.x * v.x; o.y += g.y * v.y; o.z += g.z * v.z; o.w += g.w * v.w; *hp = o; });
    }
}

PH void ph_rope(float* px) {
    const size_t total = (size_t)NX * 480;
    for (size_t i = (size_t)BID() * NTHR + TID(); i < total; i += (size_t)gridDim.x * NTHR) {
        const int r = (int)(i / 480), q5 = (int)(i % 480), hh = q5 >> 5, q = q5 & 31, a = q >> 4, f = q & 15;
        const int t = r & 2047, pos = a ? (t & 63) : (t >> 6);
        const float inv = powf(10000.f, -(float)f / 16.f);
        const float ang = (float)pos * inv, cs = cosf(ang), sn = sinf(ang);
        float* base = px + (size_t)r * EVEN_IN + 256 + hh * 64 + a * 32 + f;
        const float x1 = base[0], x2 = base[16];
        base[0] = x1 * cs - x2 * sn; base[16] = x2 * cs + x1 * sn;
    }
}
PH void ph_pool(const float* px, const float* pool_w, const float* pool_scale, float* mix) {
    const int lane = TID() & 63, wave = (BID() * NTHR + TID()) >> 6, nw = gridDim.x * NWAVE;
    for (int task = wave; task < NT * 4; task += nw) {
        const int r = task >> 2, gi = task & 3; int s0, len, t; seq_info(r, s0, len, t);
        const int w = 2 << gi; int lo = t - w / 2, hi = t - w / 2 + w; lo = lo < 0 ? 0 : lo; hi = hi > len ? len : hi;
        float s = 0.f;
        for (int tt = lo; tt < hi; ++tt) s += px[(size_t)(s0 + tt) * EVEN_IN + gi * 64 + lane];
        const float pooled = s / (float)(hi - lo) - px[(size_t)r * EVEN_IN + gi * 64 + lane];
        const float* pw = pool_w + (size_t)gi * 4096;
        float acc = 0.f;
#pragma unroll 8
        for (int c = 0; c < 64; ++c) acc += __shfl(pooled, c) * pw[c * 64 + lane];
        mix[(size_t)r * D + gi * 64 + lane] = acc * pool_scale[gi * 64 + lane];
    }
}
PH void ph_attn(float* lds, const float* px, const float* sink, float* mix) {
    const int lane = TID() & 63, wib = TID() >> 6, wave = (BID() * NTHR + TID()) >> 6, nw = gridDim.x * NWAVE;
    float* pb = lds + wib * 576;
    for (int task = wave; task < NT * 12; task += nw) {
        const int r = task / 12, hh = task % 12, kvh = hh >> 2;
        const bool lat = r < NX;
        const int b = lat ? (r >> 11) : ((r - NX) >> 8);
        int klo = 0, nloc = 0;
        if (lat) { const int t = r & 2047; klo = t - 128 < 0 ? 0 : t - 128; const int khi = t + 128 > 2047 ? 2047 : t + 128; nloc = khi - klo + 1; }
        const int nkeys = nloc + CTX;
        float q[64];
        const float* qp = px + (size_t)r * EVEN_IN + 256 + hh * 64;
#pragma unroll
        for (int d4 = 0; d4 < 16; ++d4) { const float4 v = *(const float4*)(qp + d4 * 4); q[d4 * 4] = v.x; q[d4 * 4 + 1] = v.y; q[d4 * 4 + 2] = v.z; q[d4 * 4 + 3] = v.w; }
        float mx = sink[hh];
        for (int kidx = lane; kidx < nkeys; kidx += 64) {
            const int krow = kidx < nloc ? (b * SEQ + klo + kidx) : (NX + b * CTX + (kidx - nloc));
            const float* kp = px + (size_t)krow * EVEN_IN + 1024 + kvh * 64;
            float s = 0.f;
#pragma unroll
            for (int d4 = 0; d4 < 16; ++d4) { const float4 v = *(const float4*)(kp + d4 * 4); s += q[d4 * 4] * v.x + q[d4 * 4 + 1] * v.y + q[d4 * 4 + 2] * v.z + q[d4 * 4 + 3] * v.w; }
            s *= 0.125f;
            pb[kidx] = s; mx = fmaxf(mx, s);
        }
        mx = wave_max(mx);
        float den = 0.f;
        for (int kidx = lane; kidx < nkeys; kidx += 64) { const float e = expf(pb[kidx] - mx); pb[kidx] = e; den += e; }
        den = wave_sum(den) + expf(sink[hh] - mx);
        __builtin_amdgcn_wave_barrier();
        float acc = 0.f;
        for (int kidx = 0; kidx < nkeys; ++kidx) {
            const int krow = kidx < nloc ? (b * SEQ + klo + kidx) : (NX + b * CTX + (kidx - nloc));
            acc += pb[kidx] * px[(size_t)krow * EVEN_IN + 1216 + kvh * 64 + lane];
        }
        mix[(size_t)r * D + 256 + hh * 64 + lane] = acc / den;
        __builtin_amdgcn_wave_barrier();
    }
}

PH void ph_scanprep(float* lds, const float* px, const OddW& w, const ScanArrays& sa) {
    float* fl = lds;
    float* hs = lds + 2720;
    const int tid = TID(), lane = tid & 63, wv = tid >> 6;
    for (int r = BID(); r < NT; r += gridDim.x) {
        int s0, len, t; seq_info(r, s0, len, t);
        const float* pr = px + (size_t)r * ODD_IN;
        for (int col = tid; col < 2720; col += NTHR) {
            const float u = pr[col], pv = t > 0 ? pr[col - ODD_IN] : 0.f, nx = t < len - 1 ? pr[col + ODD_IN] : 0.f;
            float f = u + w.mu[col] * (pv - u) + w.mu[2720 + col] * (nx - u);
            if (col >= 2304 && col < 2432) f = tanhf(f);
            if (col >= 2560) f = sigmoidf_(f);
            fl[col] = f;
        }
        __syncthreads();
        float kkr[2] = {0.f, 0.f};
#pragma unroll
        for (int i = 0; i < 2; ++i) { const int c = tid + NTHR * i; if (c < RW) { kkr[i] = fl[768 + c] * w.k_k[c]; const float ss = wave_sum(kkr[i] * kkr[i]); if (lane == 0) hs[8 * i + wv] = ss; } }
        __syncthreads();
#pragma unroll
        for (int i = 0; i < 2; ++i) {
            const int c = tid + NTHR * i;
            if (c < RW) {
                const int head = c >> 6;
                float lw0 = w.w0[c], lw1 = w.w0[768 + c], la0 = w.a0[c], la1 = w.a0[768 + c], gg = 0.f;
                for (int j = 0; j < 64; ++j) {
                    lw0 += fl[2304 + j] * w.w2[(size_t)j * 768 + c];
                    lw1 += fl[2368 + j] * w.w2[(size_t)(64 + j) * 768 + c];
                    la0 += fl[2432 + j] * w.a2[(size_t)j * 768 + c];
                    la1 += fl[2496 + j] * w.a2[(size_t)(64 + j) * 768 + c];
                }
                for (int j = 0; j < 160; ++j) gg += fl[2560 + j] * w.g2[(size_t)j * 768 + c];
                const float kk = kkr[i] / fmaxf(sqrtf(hs[head]), 1e-12f);
                const float k = fl[768 + c], v = fl[1536 + c], rr = fl[c], ka = w.k_a[c];
                const size_t o = (size_t)r * RW + c;
                sa.R[o] = rr; sa.V[o] = v; sa.KK[o] = kk; sa.G[o] = gg;
                const float z0 = -lw0, sp0 = fmaxf(z0, 0.f) + log1pf(expf(-fabsf(z0))); const float wl0 = -sp0 - 0.5f;
                const float z1 = -lw1, sp1 = fmaxf(z1, 0.f) + log1pf(expf(-fabsf(z1))); const float wl1 = -sp1 - 0.5f;
                sa.W[0][o] = expf(-expf(wl0)); sa.W[1][o] = expf(-expf(wl1));
                const float a_0 = sigmoidf_(la0), a_1 = sigmoidf_(la1);
                sa.KD[0][o] = k * (1.f + (a_0 - 1.f) * ka); sa.KD[1][o] = k * (1.f + (a_1 - 1.f) * ka);
                sa.BB[0][o] = kk * a_0; sa.BB[1][o] = kk * a_1;
            }
        }
        __syncthreads();
    }
}
PH void ph_scan(float* lds, const ScanArrays& sa) {
    const int lane = TID() & 63, wib = TID() >> 6;
    const int chain = BID() * NWAVE + wib;
    if (chain >= NB * 12 * 2) return;
    float* sh = lds + wib * 320;
    const int dir = chain & 1, bh = chain >> 1, b = bh / 12, hh = bh % 12;
    const float* Wd = sa.W[dir]; const float* KD = sa.KD[dir]; const float* BB = sa.BB[dir]; float* Y = sa.Y[dir];
    float S[64];
#pragma unroll
    for (int j = 0; j < 64; ++j) S[j] = 0.f;
    for (int s = 0; s < CTX + SEQ; ++s) {
        int tok;
        if (s < CTX) { const int tt = dir ? CTX - 1 - s : s; tok = NX + b * CTX + tt; }
        else { int tt = s - CTX; tt = dir ? SEQ - 1 - tt : tt; tok = b * SEQ + tt; }
        const size_t off = (size_t)tok * RW + hh * 64 + lane;
        const float v = sa.V[off];
        __builtin_amdgcn_wave_barrier();
        sh[lane] = Wd[off]; sh[64 + lane] = KD[off]; sh[128 + lane] = BB[off]; sh[192 + lane] = sa.KK[off]; sh[256 + lane] = sa.R[off];
        __builtin_amdgcn_wave_barrier();
        float sacc = 0.f;
#pragma unroll
        for (int j = 0; j < 64; ++j) sacc += S[j] * sh[192 + j];
#pragma unroll
        for (int j = 0; j < 64; ++j) S[j] = S[j] * sh[j] + (v * sh[64 + j] - sacc * sh[128 + j]);
        float y = 0.f;
#pragma unroll
        for (int j = 0; j < 64; ++j) y += S[j] * sh[256 + j];
        Y[off] = y;
    }
}
PH void ph_readout(const ScanArrays& sa, const OddW& w, float* mix) {
    const int lane = TID() & 63, wave = (BID() * NTHR + TID()) >> 6, nw = gridDim.x * NWAVE;
    for (int task = wave; task < NT * 12; task += nw) {
        const int r = task / 12, hh = task % 12, c = hh * 64 + lane;
        const size_t o = (size_t)r * RW + c;
        const float y = sa.Y[0][o] + sa.Y[1][o];
        const float mean = wave_sum(y) * (1.f / 64.f), d = y - mean, var = wave_sum(d * d) * (1.f / 64.f);
        const float yn = d * rsqrtf(var + 64e-5f) * w.gn_g[c] + w.gn_b[c];
        const float coef = wave_sum(sa.R[o] * (sa.KD[0][o] + sa.KD[1][o]) * w.r_k[c]);
        mix[(size_t)r * D + c] = (yn + coef * sa.V[o]) * sa.G[o];
    }
}
PH void ph_fft_prep(float* lds, const float* px, float* bm_lat, float* bm_ctx) {
    float* cs = lds; float* sn = lds + 64;
    if (TID() < 64) { const float a = 6.283185307179586f * (float)TID() / 64.f; cs[TID()] = cosf(a); sn[TID()] = sinf(a); }
    __syncthreads();
    const int lane = TID() & 63, wave = (BID() * NTHR + TID()) >> 6, nw = gridDim.x * NWAVE;
    for (int task = wave; task < NT * 4; task += nw) {
        const int r = task >> 2, g = task & 3;
        const float u = px[(size_t)r * ODD_IN + 2720 + g * 64 + lane];
        float u1 = 0.f, u2 = 0.f;
#pragma unroll 8
        for (int c = 0; c < 64; ++c) { const float uc = __shfl(u, c); const int m = (lane * c) & 63; u1 += uc * cs[m]; u2 += uc * sn[m]; }
        if (r < NX) { const int b = r >> 11, t = r & 2047; float* base = bm_lat + ((size_t)(b * 4 + g) * 4096) * 64; base[(size_t)t * 64 + lane] = u1; base[(size_t)(2048 + t) * 64 + lane] = u2; }
        else { const int q = r - NX, b = q >> 8, t = q & 255; float* base = bm_ctx + ((size_t)(b * 4 + g) * 512) * 64; base[(size_t)t * 64 + lane] = u1; base[(size_t)(256 + t) * 64 + lane] = u2; }
    }
    __syncthreads();
}
PH void ph_fft_gemm(float* lds, const float* tw, const float* bm, float* mix, int T, int row0, int blk, int nblk) {
    const int mt_n = T / 128, nunits = 64 * mt_n; const float scale = rsqrtf((float)T * 64.f);
    for (int u = blk; u < nunits; u += nblk) {
        const int bg = u / mt_n, mt = u % mt_n, b = bg >> 2, g = bg & 3;
        gemm_tile(lds, [&](int r) { return tw + (size_t)r * 2 * T; }, bm + (size_t)bg * 2 * T * 64, 64, 64, 2 * T, mt * 128, 0,
                  [&](int row, int col, float4 v) { float4 o = make_float4(v.x * scale, v.y * scale, v.z * scale, v.w * scale);
                      *(float4*)(mix + (size_t)(row0 + b * T + row) * D + 768 + g * 64 + col) = o; });
    }
}

PH void ph_moe_init(const MoeBufs& m) {
    const int i = BID() * NTHR + TID();
    if (i < NEXP) m.cnt[i] = 0;
    for (int j = i; j < MOE_ROWS; j += gridDim.x * NTHR) m.row_tok[j] = -1;
}
PH void ph_router(const float* fx, const float* rw, const float* rb, const MoeBufs& m, int nrows) {
    const int lane = TID() & 63, wave = (BID() * NTHR + TID()) >> 6, nw = gridDim.x * NWAVE;
    const int e = lane & 31, half = lane >> 5;
    for (int r = wave; r < nrows; r += nw) {
        const float* xr = fx + (size_t)r * D;
        float acc = 0.f;
        for (int d = half; d < D; d += 2) acc += xr[d] * rw[d * NEXP + e];
        acc += __shfl_xor(acc, 32);
        float logit = acc + rb[e];
        float tv[4]; int ti[4];
#pragma unroll
        for (int k = 0; k < 4; ++k) {
            const float mx = wave_max(logit);
            const unsigned long long bal = __ballot(logit == mx);
            const int sel = (__ffsll((long long)bal) - 1) & 31;
            tv[k] = mx; ti[k] = sel;
            if (e == sel) logit = -INFINITY;
        }
        const float e1 = expf(tv[1] - tv[0]), e2 = expf(tv[2] - tv[0]), e3 = expf(tv[3] - tv[0]);
        const float inv = 1.f / (1.f + e1 + e2 + e3);
        if (lane < 4) {
            const float gk = lane == 0 ? inv : lane == 1 ? e1 * inv : lane == 2 ? e2 * inv : e3 * inv;
            const int ek = lane == 0 ? ti[0] : lane == 1 ? ti[1] : lane == 2 ? ti[2] : ti[3];
            const int pos = atomicAdd(&m.cnt[ek], 1);
            m.tok_e[r * 4 + lane] = ek; m.tok_pos[r * 4 + lane] = pos; m.tok_gate[r * 4 + lane] = gk;
        }
    }
}
PH void moe_offsets(int* ps, const MoeBufs& m) {
    __syncthreads();
    if (TID() == 0) { int s = 0; for (int e = 0; e < NEXP; ++e) { ps[e] = s; s += (m.cnt[e] + 255) / 256 * 256; } ps[NEXP] = s; }
    __syncthreads();
}
PH int moe_tile_expert(const int* ps, int row) { int e = -1; for (int q = 0; q < NEXP; ++q) if (row >= ps[q] && row < ps[q + 1]) e = q; return e; }
PH void ph_moe_scatter(int* ps, const MoeBufs& m, int nrows) {
    moe_offsets(ps, m);
    for (int i = BID() * NTHR + TID(); i < nrows * 4; i += gridDim.x * NTHR)
        m.row_tok[ps[m.tok_e[i]] + m.tok_pos[i]] = i >> 2;
}
PH float swiglu1(float glu, float lin) {
    glu = fminf(glu, 7.f); lin = fminf(fmaxf(lin, -7.f), 7.f);
    return glu * (1.f / (1.f + expf(-1.702f * glu))) * (lin + 1.f);
}
PH void ph_moe_gu(float* lds, const float* fx, const float* wgu, const float* bgu, const MoeBufs& m) {
    int* ps = (int*)(lds + 4096);
    moe_offsets(ps, m);
    const int nct = 2048 / 64, nunits = (ps[NEXP] / 128) * nct;
    for (int u = BID(); u < nunits; u += gridDim.x) {
        const int mt = u / nct, ct = u % nct, e = moe_tile_expert(ps, mt * 128);
        const float* bias = bgu + (size_t)e * 2048;
        gemm_tile(lds, [&](int r) { const int t = m.row_tok[r]; return t >= 0 ? fx + (size_t)t * D : (const float*)nullptr; },
                  wgu + (size_t)e * 1024 * 2048, 2048, 2048, 1024, mt * 128, ct * 64,
                  [&](int row, int col, float4 v) { const float4 bb = *(const float4*)(bias + col);
                      float2 o; o.x = swiglu1(v.x + bb.x, v.y + bb.y); o.y = swiglu1(v.z + bb.z, v.w + bb.w);
                      *(float2*)(m.Hp + (size_t)row * 1024 + (col >> 1)) = o; });
    }
}
PH void ph_moe_dn(float* lds, const float* wdn, const float* bdn, const MoeBufs& m) {
    int* ps = (int*)(lds + 4096);
    moe_offsets(ps, m);
    const int nct = 1024 / 64, nunits = (ps[NEXP] / 128) * nct;
    for (int u = BID(); u < nunits; u += gridDim.x) {
        const int mt = u / nct, ct = u % nct, e = moe_tile_expert(ps, mt * 128);
        const float* bias = bdn + (size_t)e * 1024;
        gemm_tile(lds, [&](int r) { return m.Hp + (size_t)r * 1024; }, wdn + (size_t)e * 1024 * 1024, 1024, 1024, 1024, mt * 128, ct * 64,
                  [&](int row, int col, float4 v) { const float4 bb = *(const float4*)(bias + col);
                      *(float4*)(m.Yp + (size_t)row * 1024 + col) = make_float4(v.x + bb.x, v.y + bb.y, v.z + bb.z, v.w + bb.w); });
    }
}
PH void ph_moe_combine(int* ps, float* h, const float* modl, int gate_off, const MoeBufs& m, int nrows) {
    moe_offsets(ps, m);
    const int lane = TID() & 63, wave = (BID() * NTHR + TID()) >> 6, nw = gridDim.x * NWAVE;
    for (int r = wave; r < nrows; r += nw) {
        int dest[4]; float gk[4];
#pragma unroll
        for (int k = 0; k < 4; ++k) { dest[k] = ps[m.tok_e[r * 4 + k]] + m.tok_pos[r * 4 + k]; gk[k] = m.tok_gate[r * 4 + k]; }
        const float* mr = modl + (size_t)mod_row(r) * MODW + gate_off;
#pragma unroll
        for (int i = 0; i < 4; ++i) {
            const int col = (lane + 64 * i) * 4;
            float4 s = make_float4(0.f, 0.f, 0.f, 0.f);
#pragma unroll
            for (int k = 0; k < 4; ++k) { const float4 y = *(const float4*)(m.Yp + (size_t)dest[k] * 1024 + col); s.x += gk[k] * y.x; s.y += gk[k] * y.y; s.z += gk[k] * y.z; s.w += gk[k] * y.w; }
            const float4 g = *(const float4*)(mr + col);
            float4* hp = (float4*)(h + (size_t)r * D + col); float4 o = *hp;
            o.x += g.x * s.x; o.y += g.y * s.y; o.z += g.z * s.z; o.w += g.w * s.w; *hp = o;
        }
    }
}

__global__ __launch_bounds__(NTHR, 2) void mega(Params p) {
    extern __shared__ __attribute__((aligned(16))) unsigned char smem[];
    float* lds = (float*)(smem + 16);
    if (threadIdx.x == 0) *(uint4*)smem = make_uint4(0u, 0u, 0u, 0u);
    __syncthreads();
    XcdBarrier bar = xcd_barrier_post(p.bar, (volatile LAS unsigned*)smem);
#define GRID_SYNC() xcd_barrier(bar)

    ph_copy(p);
    ph_ada(p, lds);
    ph_twiddle(p.tw_lat, 2048);
    ph_twiddle(p.tw_ctx, 256);
    ph_moe_init(p.mb);
    GRID_SYNC();

    for (int i = 0; i < 4; ++i) {
        const int j = i >> 1; const bool last = (i == 3);
        const float* modl = p.mod + (size_t)i * 17 * MODW;
        ph_norm_mod(p.h, p.norm_mix_g + i * D, modl, 0, 1024, p.a, NT);
        GRID_SYNC();
        if ((i & 1) == 0) {
            ph_gemm_plain(lds, p.a, D, p.ev_w_in + (size_t)j * D * EVEN_IN, EVEN_IN, p.px, EVEN_IN, NT, EVEN_IN, D);
            GRID_SYNC();
            ph_rope(p.px);
            GRID_SYNC();
            ph_pool(p.px, p.pool_w + (size_t)j * 4 * 4096, p.pool_scale + j * 256, p.mix);
            ph_attn(lds, p.px, p.att_sink + j * 12, p.mix);
            GRID_SYNC();
            ph_gemm_resid(lds, p.mix, p.ev_w_out + (size_t)j * D * D, p.h, modl, 2048);
        } else {
            ph_gemm_plain(lds, p.a, D, p.od_w_in + (size_t)j * D * ODD_IN, ODD_IN, p.px, ODD_IN, NT, ODD_IN, D);
            GRID_SYNC();
            OddW w;
            w.mu = p.rw_mu + (size_t)j * 2 * 2720; w.w0 = p.rw_w0 + (size_t)j * 2 * 768; w.w2 = p.rw_w2 + (size_t)j * 2 * 64 * 768;
            w.a0 = p.rw_a0 + (size_t)j * 2 * 768; w.a2 = p.rw_a2 + (size_t)j * 2 * 64 * 768; w.g2 = p.rw_g2 + (size_t)j * 160 * 768;
            w.k_k = p.rw_k_k + j * 768; w.k_a = p.rw_k_a + j * 768; w.r_k = p.rw_r_k + j * 768; w.gn_g = p.rw_gn_g + j * 768; w.gn_b = p.rw_gn_b + j * 768;
            ph_scanprep(lds, p.px, w, p.sa);
            ph_fft_prep(lds, p.px, p.bm_lat, p.bm_ctx);
            GRID_SYNC();
            if (blockIdx.x < 48) ph_scan(lds, p.sa);
            else { ph_fft_gemm(lds, p.tw_lat, p.bm_lat, p.mix, 2048, 0, blockIdx.x - 48, gridDim.x - 48);
                   ph_fft_gemm(lds, p.tw_ctx, p.bm_ctx, p.mix, 256, NX, blockIdx.x - 48, gridDim.x - 48); }
            GRID_SYNC();
            ph_readout(p.sa, w, p.mix);
            GRID_SYNC();
            ph_gemm_resid(lds, p.mix, p.od_w_out + (size_t)j * D * D, p.h, modl, 2048);
        }
        GRID_SYNC();
        const int nrows = last ? NX : NT;
        ph_norm_mod(p.h, p.norm_ffn_g + i * D, modl, 3072, 4096, p.a, nrows);
        __syncthreads();
        asm volatile("s_waitcnt vmcnt(0)" ::: "memory");
        GRID_SYNC();
        ph_router(p.a, p.router_w + (size_t)i * D * NEXP, p.router_b + i * NEXP, p.mb, nrows);
        GRID_SYNC();
        ph_moe_scatter((int*)lds, p.mb, nrows);
        GRID_SYNC();
        ph_moe_gu(lds, p.a, p.exp_w_gu + (size_t)i * NEXP * 1024 * 2048, p.exp_b_gu + (size_t)i * NEXP * 2048, p.mb);
        GRID_SYNC();
        ph_moe_dn(lds, p.exp_w_dn + (size_t)i * NEXP * 1024 * 1024, p.exp_b_dn + (size_t)i * NEXP * 1024, p.mb);
        GRID_SYNC();
        ph_moe_combine((int*)lds, p.h, modl, 5120, p.mb, nrows);
        GRID_SYNC();
        ph_moe_init(p.mb);
    }
    GRID_SYNC();
    ph_norm_mod(p.h, p.final_g, nullptr, 0, 0, p.out, NX);
}
}

extern "C" void kernel_launch(void* const* d_in, const int* in_sizes, int n_in, void* d_out, int out_size, void* d_ws, size_t ws_size, hipStream_t stream) {
    Params p; memset(&p, 0, sizeof(p));
    p.x = (const float*)d_in[0]; p.c = (const float*)d_in[1]; p.ctx = (const float*)d_in[2]; p.c_ctx = (const float*)d_in[3];
    p.ada_w = (const float*)d_in[4]; p.ada_b = (const float*)d_in[5]; p.norm_mix_g = (const float*)d_in[6]; p.norm_ffn_g = (const float*)d_in[7];
    p.ev_w_in = (const float*)d_in[8]; p.ev_w_out = (const float*)d_in[9]; p.pool_w = (const float*)d_in[10]; p.pool_scale = (const float*)d_in[11];
    p.att_sink = (const float*)d_in[12]; p.od_w_in = (const float*)d_in[13]; p.od_w_out = (const float*)d_in[14];
    p.rw_mu = (const float*)d_in[15]; p.rw_w0 = (const float*)d_in[16]; p.rw_w2 = (const float*)d_in[17]; p.rw_a0 = (const float*)d_in[18];
    p.rw_a2 = (const float*)d_in[19]; p.rw_g2 = (const float*)d_in[20]; p.rw_k_k = (const float*)d_in[21]; p.rw_k_a = (const float*)d_in[22];
    p.rw_r_k = (const float*)d_in[23]; p.rw_gn_g = (const float*)d_in[24]; p.rw_gn_b = (const float*)d_in[25];
    p.router_w = (const float*)d_in[26]; p.router_b = (const float*)d_in[27]; p.exp_w_gu = (const float*)d_in[28]; p.exp_b_gu = (const float*)d_in[29];
    p.exp_w_dn = (const float*)d_in[30]; p.exp_b_dn = (const float*)d_in[31]; p.final_g = (const float*)d_in[32];
    p.out = (float*)d_out;

    float* ws = (float*)d_ws; size_t off = 0;
    auto take = [&](size_t n) { float* q = ws + off; off += (n + 63) & ~(size_t)63; return q; };
    p.bar = (unsigned*)take(XCD_BAR_WORDS);
    p.mod = take((size_t)4 * 17 * MODW);
    p.h = take((size_t)NT * D);
    p.a = take((size_t)NT * D);
    p.mix = take((size_t)NT * D);
    p.tw_lat = take((size_t)2048 * 4096);
    p.tw_ctx = take((size_t)256 * 512);
    p.mb.tok_e = (int*)take((size_t)NT * 4); p.mb.tok_pos = (int*)take((size_t)NT * 4); p.mb.tok_gate = take((size_t)NT * 4);
    p.mb.cnt = (int*)take(64); p.mb.row_tok = (int*)take(MOE_ROWS);
    const size_t scratch0 = off;
    p.px = take((size_t)NT * ODD_IN);
    p.sa.R = take((size_t)NT * RW); p.sa.V = take((size_t)NT * RW); p.sa.KK = take((size_t)NT * RW); p.sa.G = take((size_t)NT * RW);
    for (int d = 0; d < 2; ++d) { p.sa.W[d] = take((size_t)NT * RW); p.sa.KD[d] = take((size_t)NT * RW); p.sa.BB[d] = take((size_t)NT * RW); p.sa.Y[d] = take((size_t)NT * RW); }
    p.bm_lat = take((size_t)64 * 4096 * 64);
    p.bm_ctx = take((size_t)64 * 512 * 64);
    const size_t mixer_end = off;
    off = scratch0;
    p.mb.Hp = take((size_t)MOE_ROWS * 1024); p.mb.Yp = take((size_t)MOE_ROWS * 1024);
    const size_t total = (off > mixer_end ? off : mixer_end) * sizeof(float);
    if (total > ws_size) { fprintf(stderr, "kernel_launch: workspace too small: need %zu have %zu\n", total, ws_size); return; }

    static int grid = 0;
    if (!grid) {
        int dev = 0, cus = 0, per_cu = 0;
        if (hipGetDevice(&dev) != hipSuccess || hipDeviceGetAttribute(&cus, hipDeviceAttributeMultiprocessorCount, dev) != hipSuccess) { fprintf(stderr, "kernel_launch: device query failed\n"); return; }
        if (hipFuncSetAttribute((const void*)mega, hipFuncAttributeMaxDynamicSharedMemorySize, LDS_BYTES) != hipSuccess) { fprintf(stderr, "kernel_launch: hipFuncSetAttribute failed\n"); return; }
        if (hipOccupancyMaxActiveBlocksPerMultiprocessor(&per_cu, (const void*)mega, NTHR, LDS_BYTES) != hipSuccess || per_cu < 1) { fprintf(stderr, "kernel_launch: occupancy query says %d\n", per_cu); return; }
        grid = cus;
    }
    if (hipMemsetAsync(p.bar, 0, XCD_BAR_WORDS * sizeof(unsigned), stream) != hipSuccess) { fprintf(stderr, "kernel_launch: memset failed\n"); return; }
    hipLaunchKernelGGL(mega, dim3(grid), dim3(NTHR), LDS_BYTES, stream, p);
}
```

```cpp
#include <hip/hip_runtime.h>
#include <stdint.h>
#include <stdio.h>
#include <string.h>

#define PROBE 0
#define PROBE_A 4
#define PROBE_B 8
namespace {
constexpr int D = 1024, NB = 16, SEQ = 2048, CTX = 256;
constexpr int NX = NB * SEQ, NC = NB * CTX, NT = NX + NC;
constexpr int EVEN_IN = 1408, ODD_IN = 2976;
constexpr int RW = 768;
constexpr int NEXP = 32, TOPK = 4;
constexpr int MOE_ROWS = ((NT * TOPK + 255) / 256 + NEXP) * 256;
constexpr int MOE_TILES = MOE_ROWS / 128;
constexpr int MODW = 6 * D;
constexpr int NTHR = 512, NWAVE = 8;
constexpr int LDS_BYTES = 132 * 1024;
constexpr int MISC_OFF = 16, STAGE_OFF = 1024;

#define XB_TMO      128
#define XB_XCNT(j)  (256  + 64 * (j))
#define XB_XSUB(j)  (1280 + 64 * (j))
#define XB_XGEN(j)  (2304 + 64 * (j))
#define XB_TOP      3328
#define XB_TOPGEN   3392
#define XCD_BAR_WORDS 3456
#define XB_SPIN_CAP (1u << 22)
#define LAS __attribute__((address_space(3)))

__device__ __forceinline__ unsigned xb_ld(unsigned* p)              { return __hip_atomic_load(p, __ATOMIC_RELAXED, __HIP_MEMORY_SCOPE_AGENT); }
__device__ __forceinline__ unsigned xb_add(unsigned* p, unsigned v) { return __hip_atomic_fetch_add(p, v, __ATOMIC_RELAXED, __HIP_MEMORY_SCOPE_AGENT); }
__device__ __forceinline__ unsigned xb_xcc_id() { return (unsigned)__builtin_amdgcn_s_getreg((3 << 11) | 20) & 0xFu; }
#define XB_SPIN(cond, bar) do { unsigned _sp = 0; while (cond) { __builtin_amdgcn_s_sleep(1); \
    if ((++_sp & 255u) == 0u) { if (xb_ld(&(bar)[XB_TMO])) break; if (_sp > XB_SPIN_CAP) { atomicAdd(&(bar)[XB_TMO], 1u); break; } } } } while (0)

struct XcdBarrier { unsigned* bar; unsigned x; volatile LAS unsigned* st; };

__device__ __forceinline__ XcdBarrier xcd_barrier_post(unsigned* bar, volatile LAS unsigned* st) {
    XcdBarrier b; b.bar = bar; b.x = xb_xcc_id(); b.st = st;
    if (threadIdx.x == 0) (void)xb_add(&bar[XB_XCNT(b.x)], 1u);
    return b;
}
__device__ __forceinline__ void xcd_barrier_complete(unsigned* bar, unsigned x, unsigned& nloc, unsigned& nx) {
    const unsigned G = gridDim.x * gridDim.y * gridDim.z;
    unsigned sum, cnt, mine, sp = 0u;
    for (;;) {
        sum = 0u; cnt = 0u; mine = 0u;
#pragma unroll
        for (unsigned j = 0; j < 16; ++j) { const unsigned c = xb_ld(&bar[XB_XCNT(j)]); sum += c; cnt += (c > 0u) ? 1u : 0u; mine = (j == x) ? c : mine; }
        if (sum == G) break;
        __builtin_amdgcn_s_sleep(1);
        if ((++sp & 255u) == 0u) { if (xb_ld(&bar[XB_TMO])) break; if (sp > XB_SPIN_CAP) { atomicAdd(&bar[XB_TMO], 1u); break; } }
    }
    nloc = mine > 0u ? mine : 1u; nx = cnt > 0u ? cnt : 1u;
}
__device__ __forceinline__ void xcd_barrier(const XcdBarrier& b) {
    asm volatile("s_waitcnt vmcnt(0)" ::: "memory");
    __syncthreads();
    if (threadIdx.x == 0) {
        unsigned* bar = b.bar; unsigned bx = b.x;
        asm volatile("" : "+s"(bar), "+s"(bx));
        __builtin_amdgcn_s_waitcnt(0);
        unsigned nloc = b.st[0], nx = b.st[1];
        if (nloc == 0u) { xcd_barrier_complete(bar, bx, nloc, nx); b.st[0] = nloc; b.st[1] = nx; }
        const unsigned old = xb_add(&bar[XB_XSUB(bx)], 1u);
        const unsigned gen = old / nloc;
        if (old + 1u == (gen + 1u) * nloc) {
            __builtin_amdgcn_fence(__ATOMIC_RELEASE, "agent");
            asm volatile("s_waitcnt vmcnt(0)" ::: "memory");
            const unsigned og = xb_add(&bar[XB_TOP], 1u);
            const unsigned tg = og / nx;
            if (og + 1u == (tg + 1u) * nx) xb_add(&bar[XB_TOPGEN], 1u);
            else XB_SPIN(xb_ld(&bar[XB_TOPGEN]) == tg, bar);
            __builtin_amdgcn_fence(__ATOMIC_ACQUIRE, "agent");
            xb_add(&bar[XB_XGEN(bx)], 1u);
            asm volatile("s_waitcnt vmcnt(0)" ::: "memory");
        } else {
            XB_SPIN(xb_ld(&bar[XB_XGEN(bx)]) == gen, bar);
            __builtin_amdgcn_fence(__ATOMIC_ACQUIRE, "agent");
            asm volatile("s_waitcnt vmcnt(0)" ::: "memory");
        }
    }
    __syncthreads();
}

#define PH __device__ __forceinline__
PH float wave_sum(float v) {
#pragma unroll
    for (int o = 32; o >= 1; o >>= 1) v += __shfl_xor(v, o);
    return v;
}
PH float wave_max(float v) {
#pragma unroll
    for (int o = 32; o >= 1; o >>= 1) v = fmaxf(v, __shfl_xor(v, o));
    return v;
}
PH int mod_row(int r) { return r < NX ? (r >> 11) : 16; }
PH void seq_info(int r, int& s0, int& len, int& t) {
    if (r < NX) { s0 = r & ~2047; len = SEQ; t = r & 2047; }
    else { const int q = r - NX; s0 = NX + (q & ~255); len = CTX; t = q & 255; }
}
PH float sigmoidf_(float x) { return 1.f / (1.f + expf(-x)); }
PH int TID() { int t = threadIdx.x; asm volatile("" : "+v"(t)); return t; }
PH int BID() { int t = blockIdx.x; asm volatile("" : "+s"(t)); return t; }
PH int GDIM() {
    int t = __builtin_amdgcn_readfirstlane((int)(((const __attribute__((address_space(4))) unsigned*)__builtin_amdgcn_dispatch_ptr())[3] >> 9)); asm volatile("" : "+s"(t)); return t; }
static_assert(NTHR == 512, "GDIM shift");

typedef unsigned short bf16_t;
#if PROBE
#define SUBSTAMP_L(lsm_, id) do { __syncthreads(); if (threadIdx.x == 0) { volatile LAS unsigned long long* tl_ = (volatile LAS unsigned long long*)((LAS unsigned char*)(lsm_) + 512); \
        const unsigned long long now_ = wall_clock64(); tl_[id] += now_ - tl_[31]; tl_[31] = now_; } } while (0)
#else
#define SUBSTAMP_L(lsm_, id) do { } while (0)
#endif
struct ScanArrays { float *R, *V, *KK, *G, *W[2], *KD[2], *BB[2], *Y[2]; };
struct ScanIn { bf16_t *R, *K, *KK, *V, *G, *X[2], *A[2]; float* Y[2]; };
struct OddW { const float *mu, *w0, *w2, *a0, *a2, *g2, *k_k, *k_a, *r_k, *gn_g, *gn_b; };
struct MoeBufs { int* tok_e; int* tok_pos; float* tok_gate; int* cnt; bf16_t* Xp; bf16_t* Hp; bf16_t* Yp; };

struct Params {
    const float *x, *c, *ctx, *c_ctx, *ada_w, *ada_b, *norm_mix_g, *norm_ffn_g, *ev_w_in, *ev_w_out, *pool_w, *pool_scale, *att_sink;
    const float *od_w_in, *od_w_out, *rw_mu, *rw_w0, *rw_w2, *rw_a0, *rw_a2, *rw_g2, *rw_k_k, *rw_k_a, *rw_r_k, *rw_gn_g, *rw_gn_b;
    const float *router_w, *router_b, *exp_w_gu, *exp_b_gu, *exp_w_dn, *exp_b_dn, *final_g;
    float* out; unsigned* bar; unsigned* qctr; unsigned long long* probe;
    unsigned char* crec;
    float *st_init, *st_p, *st_b;
    float *mod, *h, *a, *mix, *tw_lat, *tw_ctx, *px, *bm_lat, *bm_ctx;
    bf16_t *px16; float *rope_c, *rope_s;
    bf16_t *a16, *wgu16, *wdn16, *mix16, *ewin16, *owin16, *ewout16, *owout16, *tw16_lat, *tw16_ctx, *bt16_lat, *bt16_ctx;
    ScanArrays sa; MoeBufs mb; ScanIn si;
    bf16_t *fft_tabT, *pool_wt;
    bf16_t *rwt_hi, *rwt_lo;
    bf16_t *w2t, *a2t, *g2t;
};


namespace pg8 {
#define PG8_LAS __attribute__((address_space(3)))
typedef unsigned short bf16_t;
typedef short bf16x8 __attribute__((ext_vector_type(8)));
typedef float f32x4 __attribute__((ext_vector_type(4)));
typedef unsigned u32x4 __attribute__((ext_vector_type(4)));
typedef unsigned u32x2 __attribute__((ext_vector_type(2)));
constexpr int BM = 256, BK = 64, HALF = 128, HTB = HALF * BK * 2, STAGE_BYTES = 8 * HTB, NXCD = 8, WGM = 8;

__host__ __device__ __forceinline__ int lds_byte(int r, int c) { const int st = (r >> 4) * 2 + (c >> 5), rr = r & 15, cc = c & 31, ob = rr * 64 + cc * 2; return st * 1024 + (ob ^ (((ob >> 9) & 1) << 5)); }
__host__ __device__ __forceinline__ void stage_rc(int b, int& R, int& C) { const int st = b / 1024, sb = b % 1024, swz = sb ^ (((sb >> 9) & 1) << 5); R = (st >> 1) * 16 + swz / 64; C = (st & 1) * 32 + (swz % 64) / 2; }
__host__ __device__ __forceinline__ int perm32(int rho) { const int n = rho >> 4, i = rho & 15; return 8 * (i >> 2) + 4 * n + (i & 3); }

struct Unit { int pm, pn, e; };
struct Gemm { const bf16_t* A; const bf16_t* Bt; int M, N, K; size_t bgstride; };

typedef float cvt_f32x2 __attribute__((ext_vector_type(2)));
typedef __bf16 cvt_bf16x2 __attribute__((ext_vector_type(2)));
__device__ __forceinline__ unsigned cvt_pk_bf16(float lo, float hi) { const cvt_f32x2 v = {lo, hi}; const cvt_bf16x2 b = __builtin_convertvector(v, cvt_bf16x2); return __builtin_bit_cast(unsigned, b); }

struct TileOrder {
    int nM, nN, nwg, G, c;
    __device__ void init(int nM_, int nN_, int G_, int c_) { nM = nM_; nN = nN_; nwg = nM * nN; G = G_; c = c_; }
    __device__ bool tile(int i, int& pm, int& pn) const {
        const long L = (long)i * G + c; if (L >= nwg) return false;
        int wgid = (int)L; { const int q = nwg / NXCD, r = nwg % NXCD, xcd = wgid % NXCD, off = wgid / NXCD; wgid = (xcd < r ? xcd * (q + 1) : r * (q + 1) + (xcd - r) * q) + off; }
        const int nig = WGM * nN, gid = wgid / nig, fm = gid * WGM, gsz = (nM - fm) < WGM ? (nM - fm) : WGM;
        pm = fm + ((wgid % nig) % gsz); pn = (wgid % nig) / gsz; return true;
    }
};

template <class Epi, class Sched>
__device__ __forceinline__ void gemm_phase(PG8_LAS unsigned char* lds, const Gemm g, const Sched& S, const Epi& E) {
    const int tid = TID(), wid = __builtin_amdgcn_readfirstlane(tid >> 6), lane = tid & 63, wr = wid >> 2, wc = wid & 3, fr = lane & 15, fq = lane >> 4;
    const int K = g.K, nt = K / BK;
    unsigned voffA[2], voffB[2];
#pragma unroll
    for (int i = 0; i < 2; ++i) { int R, C; stage_rc(tid * 16 + i * 8192, R, C); const int Rb = Epi::PERM ? ((R & ~31) + perm32(R & 31)) : R;
        voffA[i] = (unsigned)(R * K + C) * 2u; voffB[i] = (unsigned)(Rb * K + C) * 2u; }
    const size_t kstep = (size_t)(BK * 2);
    const size_t hstep = (size_t)HALF * K * 2;
    const size_t tstep = 2 * hstep;
    const unsigned ldsw = (unsigned)wid * 1024u;
    const int aoff = lds_byte(wr * 64 + fr, fq * 8), boff = lds_byte(wc * 32 + fr, fq * 8);
#define PG8_SA(b, h) (((b) * 2 + (h)) * HTB)
#define PG8_SB(b, h) ((4 + (b) * 2 + (h)) * HTB)
#define PG8_STAGE(bufoff, gbase, voff) do { _Pragma("unroll") for (int _i = 0; _i < 2; ++_i) \
        __builtin_amdgcn_global_load_lds((const unsigned*)((const char*)(gbase) + (voff)[_i]), (PG8_LAS unsigned*)(lds + (bufoff) + ldsw + _i * 8192), 16, 0, 0); } while (0)
#define PG8_LDA(dst, b, h) do { _Pragma("unroll") for (int m = 0; m < 4; ++m) _Pragma("unroll") for (int k = 0; k < 2; ++k) dst[m][k] = *(const PG8_LAS bf16x8*)(lds + PG8_SA(b, h) + aoff + m * 2048 + k * 1024); } while (0)
#define PG8_LDB(dst, b, h) do { _Pragma("unroll") for (int n = 0; n < 2; ++n) _Pragma("unroll") for (int k = 0; k < 2; ++k) dst[n][k] = *(const PG8_LAS bf16x8*)(lds + PG8_SB(b, h) + boff + n * 2048 + k * 1024); } while (0)
#define PG8_MMA(ai, bj, At, Bt) do { __builtin_amdgcn_s_setprio(1); _Pragma("unroll") for (int m = 0; m < 4; ++m) _Pragma("unroll") for (int n = 0; n < 2; ++n) _Pragma("unroll") for (int k = 0; k < 2; ++k) \
        acc[ai][bj][m][n] = __builtin_amdgcn_mfma_f32_16x16x32_bf16(Bt[n][k], At[m][k], acc[ai][bj][m][n], 0, 0, 0); __builtin_amdgcn_s_setprio(0); } while (0)
#define PG8_WAIT_V(n) asm volatile("s_waitcnt vmcnt(" #n ")" ::: "memory")
#define PG8_WAIT_L(n) asm volatile("s_waitcnt lgkmcnt(" #n ")" ::: "memory")
#define PG8_BAR __builtin_amdgcn_s_barrier()
#define PG8_SCHED __builtin_amdgcn_sched_barrier(0)
    Unit cur, nxt; int ui = 0;
    if (!S.next(0, cur)) return;
    typename Epi::Pre pre;
    f32x4 acc[2][2][4][2];
#pragma unroll
    for (int a = 0; a < 2; ++a)
#pragma unroll
        for (int b = 0; b < 2; ++b)
#pragma unroll
            for (int m = 0; m < 4; ++m)
#pragma unroll
                for (int n = 0; n < 2; ++n) acc[a][b][m][n] = (f32x4){0.f, 0.f, 0.f, 0.f};
    bf16x8 At[4][2], B0[2][2], B1[2][2];
    const char* cA = (const char*)g.A + (size_t)cur.pm * tstep; const char* cB = (const char*)g.Bt + (size_t)cur.e * g.bgstride + (size_t)cur.pn * tstep;
    PG8_STAGE(PG8_SB(0, 0), cB, voffB); PG8_STAGE(PG8_SA(0, 0), cA, voffA); PG8_STAGE(PG8_SB(0, 1), cB + hstep, voffB); PG8_STAGE(PG8_SA(0, 1), cA + hstep, voffA);
    if (wr == 1) PG8_BAR;
    PG8_WAIT_V(4); PG8_BAR;
    PG8_STAGE(PG8_SB(1, 0), cB + kstep, voffB); PG8_STAGE(PG8_SA(1, 0), cA + kstep, voffA); PG8_STAGE(PG8_SB(1, 1), cB + hstep + kstep, voffB);
    PG8_WAIT_V(6); PG8_BAR;
    for (;;) {
        const bool has_next = S.next(ui + 1, nxt);
        const char* nA = has_next ? (const char*)g.A + (size_t)nxt.pm * tstep : cA; const char* nB = has_next ? (const char*)g.Bt + (size_t)nxt.e * g.bgstride + (size_t)nxt.pn * tstep : cB;
        for (int t = 0; t < nt; t += 2) {
            const bool last = (t == nt - 2);
            if (last) pre = E.prefetch(cur, wc, fq);
            const char* a1 = cA + (size_t)(t + 1) * kstep;
            const char* a2 = last ? nA : cA + (size_t)(t + 2) * kstep; const char* b2 = last ? nB : cB + (size_t)(t + 2) * kstep;
            const char* a3 = a2 + kstep; const char* b3 = b2 + kstep;
            PG8_LDB(B0, 0, 0); PG8_SCHED; PG8_LDA(At, 0, 0); PG8_STAGE(PG8_SA(1, 1), a1 + hstep, voffA);
            PG8_WAIT_L(8); PG8_BAR; PG8_WAIT_L(0); PG8_MMA(0, 0, At, B0); PG8_BAR; PG8_SCHED;
            PG8_LDB(B1, 0, 1); PG8_STAGE(PG8_SB(0, 0), b2, voffB);
            PG8_BAR; PG8_WAIT_L(0); PG8_MMA(0, 1, At, B1); PG8_BAR;
            PG8_LDA(At, 0, 1); PG8_STAGE(PG8_SA(0, 0), a2, voffA);
            PG8_BAR; PG8_WAIT_L(0); PG8_MMA(1, 0, At, B0); PG8_BAR; PG8_SCHED;
            PG8_STAGE(PG8_SB(0, 1), b2 + hstep, voffB);
            PG8_WAIT_V(6); PG8_BAR; PG8_MMA(1, 1, At, B1); PG8_BAR;
            PG8_LDB(B0, 1, 0); PG8_SCHED; PG8_LDA(At, 1, 0); PG8_STAGE(PG8_SA(0, 1), a2 + hstep, voffA);
            PG8_WAIT_L(8); PG8_BAR; PG8_WAIT_L(0); PG8_MMA(0, 0, At, B0); PG8_BAR; PG8_SCHED;
            PG8_LDB(B1, 1, 1); PG8_STAGE(PG8_SB(1, 0), b3, voffB);
            PG8_BAR; PG8_WAIT_L(0); PG8_MMA(0, 1, At, B1); PG8_BAR;
            PG8_LDA(At, 1, 1); PG8_STAGE(PG8_SA(1, 0), a3, voffA);
            PG8_BAR; PG8_WAIT_L(0); PG8_MMA(1, 0, At, B0); PG8_BAR; PG8_SCHED;
            PG8_STAGE(PG8_SB(1, 1), b3 + hstep, voffB);
            PG8_WAIT_V(6); PG8_BAR; PG8_MMA(1, 1, At, B1); PG8_BAR;
        }
        E(acc, cur, wr, wc, fr, fq, pre);
        if (!has_next) break;
#pragma unroll
        for (int a = 0; a < 2; ++a)
#pragma unroll
            for (int b = 0; b < 2; ++b)
#pragma unroll
                for (int m = 0; m < 4; ++m)
#pragma unroll
                    for (int n = 0; n < 2; ++n) acc[a][b][m][n] = (f32x4){0.f, 0.f, 0.f, 0.f};
        cur = nxt; cA = nA; cB = nB; ++ui;
    }
    PG8_WAIT_V(0);
    if (wr == 0) PG8_BAR;
    PG8_BAR;
#undef PG8_SA
#undef PG8_SB
#undef PG8_STAGE
#undef PG8_LDA
#undef PG8_LDB
#undef PG8_MMA
#undef PG8_WAIT_V
#undef PG8_WAIT_L
#undef PG8_BAR
#undef PG8_SCHED
}
}
PH unsigned short f2bf(float f) { unsigned u = __float_as_uint(f); u += 0x7fffu + ((u >> 16) & 1u); return (unsigned short)(u >> 16); }
PH float bf2f(unsigned short h) { return __uint_as_float((unsigned)h << 16); }
PH float bflo(unsigned w) { return __uint_as_float(w << 16); }
PH float bfhi(unsigned w) { return __uint_as_float(w & 0xffff0000u); }

PH void ph_copy(const Params& p) {
    const int n4x = NX * D / 4, n4 = NT * D / 4, st = GDIM() * NTHR;
    const float4* x4 = (const float4*)p.x; const float4* c4 = (const float4*)p.ctx; pg8::u32x2* h2 = (pg8::u32x2*)p.h;
    for (int i = BID() * NTHR + TID(); i < n4; i += 2 * st) {
        int j = i + st; const bool h1 = j < n4; j = h1 ? j : i;
        const float4 a = *(i < n4x ? x4 + i : c4 + (i - n4x)), b = *(j < n4x ? x4 + j : c4 + (j - n4x));
        pg8::u32x2 wa, wb; wa.x = pg8::cvt_pk_bf16(a.x, a.y); wa.y = pg8::cvt_pk_bf16(a.z, a.w); wb.x = pg8::cvt_pk_bf16(b.x, b.y); wb.y = pg8::cvt_pk_bf16(b.z, b.w);
        h2[i] = wa; if (h1) h2[j] = wb;
    }
}
PH void ph_ada(const Params& p, float* lds) {
    float* sc = lds;
    float* part = lds + 17 * 1024;
    const int tid = TID();
    for (int i = tid; i < 17 * 1024; i += NTHR) { const int r = i >> 10, k = i & 1023; const float v = r < 16 ? p.c[r * 1024 + k] : p.c_ctx[k]; sc[i] = v / (1.f + expf(-v)); }
    __syncthreads();
    for (int unit = BID(); unit < 4 * 96; unit += GDIM()) {
        const int l = unit / 96, cb = unit % 96, cl = tid & 63, ks = tid >> 6;
        const float* W = p.ada_w + (size_t)l * 1024 * MODW + cb * 64 + cl;
        float acc[17];
#pragma unroll
        for (int r = 0; r < 17; ++r) acc[r] = 0.f;
#pragma unroll 1
        for (int k = ks * 128; k < ks * 128 + 128; k += 16) {
            float w[16];
#pragma unroll
            for (int q = 0; q < 16; ++q) w[q] = W[(size_t)(k + q) * MODW];
#pragma unroll
            for (int q4 = 0; q4 < 4; ++q4)
#pragma unroll
                for (int r = 0; r < 17; ++r) { const float4 s4 = *(const float4*)(sc + r * 1024 + k + 4 * q4);
                    acc[r] += s4.x * w[4 * q4] + s4.y * w[4 * q4 + 1] + s4.z * w[4 * q4 + 2] + s4.w * w[4 * q4 + 3]; }
        }
#pragma unroll
        for (int r = 0; r < 17; ++r) part[(ks * 17 + r) * 64 + cl] = acc[r];
        __syncthreads();
        for (int i = tid; i < 17 * 64; i += NTHR) {
            const int r = i >> 6, cc = i & 63; float s = 0.f;
#pragma unroll
            for (int q = 0; q < 8; ++q) s += part[(q * 17 + r) * 64 + cc];
            p.mod[((size_t)l * 17 + r) * MODW + cb * 64 + cc] = s + p.ada_b[l * MODW + cb * 64 + cc];
        }
        __syncthreads();
    }
}
PH void ph_norm_mod(const bf16_t* h, const float* g, const float* modl, int sh_off, int sc_off, float* out, bf16_t* out16, int nrows) {
    const int lane = TID() & 63, wave = (BID() * NTHR + TID()) >> 6, nw = GDIM() * NWAVE;
    for (int r0 = wave; r0 < nrows; r0 += 2 * nw) {
        const int r1 = r0 + nw; const bool has1 = r1 < nrows;
        const pg8::u32x2* hp0 = (const pg8::u32x2*)(h + (size_t)r0 * D); const pg8::u32x2* hp1 = (const pg8::u32x2*)(h + (size_t)(has1 ? r1 : r0) * D);
        float4 v0[4], v1[4]; float ss0 = 0.f, ss1 = 0.f;
#pragma unroll
        for (int i = 0; i < 4; ++i) { const pg8::u32x2 a = hp0[lane + 64 * i], b = hp1[lane + 64 * i];
            v0[i] = make_float4(bflo(a.x), bfhi(a.x), bflo(a.y), bfhi(a.y)); v1[i] = make_float4(bflo(b.x), bfhi(b.x), bflo(b.y), bfhi(b.y)); }
#pragma unroll
        for (int i = 0; i < 4; ++i) { ss0 += v0[i].x * v0[i].x + v0[i].y * v0[i].y + v0[i].z * v0[i].z + v0[i].w * v0[i].w; ss1 += v1[i].x * v1[i].x + v1[i].y * v1[i].y + v1[i].z * v1[i].z + v1[i].w * v1[i].w; }
        ss0 = wave_sum(ss0); ss1 = wave_sum(ss1);
        const float* mra = modl + (size_t)mod_row(r0) * MODW; const float* mrb = modl + (size_t)mod_row(has1 ? r1 : r0) * MODW;
        float4 gq[4], sha[4], sca[4], shb[4], scb[4];
#pragma unroll
        for (int i = 0; i < 4; ++i) { const int col = (lane + 64 * i) * 4; gq[i] = *(const float4*)(g + col);
            sha[i] = *(const float4*)(mra + sh_off + col); sca[i] = *(const float4*)(mra + sc_off + col); shb[i] = *(const float4*)(mrb + sh_off + col); scb[i] = *(const float4*)(mrb + sc_off + col); }
#pragma unroll
        for (int rr = 0; rr < 2; ++rr) {
            if (rr == 1 && !has1) break;
            const int r = rr ? r1 : r0; const float rs = rsqrtf((rr ? ss1 : ss0) * (1.f / 1024.f) + 1e-5f);
#pragma unroll
            for (int i = 0; i < 4; ++i) {
                const int col = (lane + 64 * i) * 4; const float4 vv = rr ? v1[i] : v0[i];
                const float4 gg = gq[i];
                float4 o; o.x = vv.x * rs * gg.x; o.y = vv.y * rs * gg.y; o.z = vv.z * rs * gg.z; o.w = vv.w * rs * gg.w;
                {
                    const float4 sh = rr ? shb[i] : sha[i], sc = rr ? scb[i] : sca[i];
                    o.x = o.x * (1.f + sc.x) + sh.x; o.y = o.y * (1.f + sc.y) + sh.y; o.z = o.z * (1.f + sc.z) + sh.z; o.w = o.w * (1.f + sc.w) + sh.w;
                }
                if (out) *(float4*)(out + (size_t)r * D + col) = o;
                if (out16) { pg8::u32x2 w; w.x = pg8::cvt_pk_bf16(o.x, o.y); w.y = pg8::cvt_pk_bf16(o.z, o.w); *(pg8::u32x2*)(out16 + (size_t)r * D + col) = w; }
            }
        }
    }
}

PH void ph_resid_norm(bf16_t* h, const bf16_t* yx, const float* gate, const float* g, const float* modl, int sh_off, int sc_off, bf16_t* out16, int nrows) {
    const int lane = TID() & 63, wave = (BID() * NTHR + TID()) >> 6, nw = GDIM() * NWAVE;
    for (int r0 = wave; r0 < nrows; r0 += 2 * nw) {
        const int r1 = r0 + nw; const bool has1 = r1 < nrows; const int rb = has1 ? r1 : r0;
        float4 v0[4], v1[4]; pg8::u32x2 y0[4], y1[4];
#pragma unroll
        for (int i = 0; i < 4; ++i) { const pg8::u32x2 ha = ((const pg8::u32x2*)(h + (size_t)r0 * D))[lane + 64 * i], hb = ((const pg8::u32x2*)(h + (size_t)rb * D))[lane + 64 * i];
            v0[i] = make_float4(bflo(ha.x), bfhi(ha.x), bflo(ha.y), bfhi(ha.y)); v1[i] = make_float4(bflo(hb.x), bfhi(hb.x), bflo(hb.y), bfhi(hb.y));
            y0[i] = ((const pg8::u32x2*)(yx + (size_t)r0 * D))[lane + 64 * i]; y1[i] = ((const pg8::u32x2*)(yx + (size_t)rb * D))[lane + 64 * i]; }
        const float* g0p = gate + (size_t)mod_row(r0) * MODW; const float* g1p = gate + (size_t)mod_row(rb) * MODW;
        float4 ga[4], gb[4];
#pragma unroll
        for (int i = 0; i < 4; ++i) { const int col = (lane + 64 * i) * 4; ga[i] = *(const float4*)(g0p + col); gb[i] = *(const float4*)(g1p + col); }
        const float* mr0 = modl + (size_t)mod_row(r0) * MODW; const float* mr1 = modl + (size_t)mod_row(rb) * MODW;
        float4 gg[4], sh0[4], sc0[4], sh1[4], sc1[4];
#pragma unroll
        for (int i = 0; i < 4; ++i) { const int col = (lane + 64 * i) * 4; gg[i] = *(const float4*)(g + col);
            sh0[i] = *(const float4*)(mr0 + sh_off + col); sc0[i] = *(const float4*)(mr0 + sc_off + col); sh1[i] = *(const float4*)(mr1 + sh_off + col); sc1[i] = *(const float4*)(mr1 + sc_off + col); }
        float ss0 = 0.f, ss1 = 0.f;
#pragma unroll
        for (int i = 0; i < 4; ++i) {
            v0[i].x += ga[i].x * bflo(y0[i].x); v0[i].y += ga[i].y * bfhi(y0[i].x); v0[i].z += ga[i].z * bflo(y0[i].y); v0[i].w += ga[i].w * bfhi(y0[i].y);
            v1[i].x += gb[i].x * bflo(y1[i].x); v1[i].y += gb[i].y * bfhi(y1[i].x); v1[i].z += gb[i].z * bflo(y1[i].y); v1[i].w += gb[i].w * bfhi(y1[i].y);
            ss0 += v0[i].x * v0[i].x + v0[i].y * v0[i].y + v0[i].z * v0[i].z + v0[i].w * v0[i].w; ss1 += v1[i].x * v1[i].x + v1[i].y * v1[i].y + v1[i].z * v1[i].z + v1[i].w * v1[i].w; }
#pragma unroll
        for (int i = 0; i < 4; ++i) { pg8::u32x2 wa, wb; wa.x = pg8::cvt_pk_bf16(v0[i].x, v0[i].y); wa.y = pg8::cvt_pk_bf16(v0[i].z, v0[i].w); wb.x = pg8::cvt_pk_bf16(v1[i].x, v1[i].y); wb.y = pg8::cvt_pk_bf16(v1[i].z, v1[i].w);
            ((pg8::u32x2*)(h + (size_t)r0 * D))[lane + 64 * i] = wa; if (has1) ((pg8::u32x2*)(h + (size_t)r1 * D))[lane + 64 * i] = wb; }
        ss0 = wave_sum(ss0); ss1 = wave_sum(ss1);
#pragma unroll
        for (int rr = 0; rr < 2; ++rr) {
            if (rr == 1 && !has1) break;
            const int r = rr ? r1 : r0; const float rs = rsqrtf((rr ? ss1 : ss0) * (1.f / 1024.f) + 1e-5f);
#pragma unroll
            for (int i = 0; i < 4; ++i) {
                const int col = (lane + 64 * i) * 4; const float4 vv = rr ? v1[i] : v0[i]; const float4 sh = rr ? sh1[i] : sh0[i], sc = rr ? sc1[i] : sc0[i];
                float4 o; o.x = vv.x * rs * gg[i].x * (1.f + sc.x) + sh.x; o.y = vv.y * rs * gg[i].y * (1.f + sc.y) + sh.y; o.z = vv.z * rs * gg[i].z * (1.f + sc.z) + sh.z; o.w = vv.w * rs * gg[i].w * (1.f + sc.w) + sh.w;
                pg8::u32x2 w; w.x = pg8::cvt_pk_bf16(o.x, o.y); w.y = pg8::cvt_pk_bf16(o.z, o.w); *(pg8::u32x2*)(out16 + (size_t)r * D + col) = w;
            }
        }
    }
}

constexpr int GLDA = 132;
template <class ARow, class EPI>
PH void gemm_tile(float* lds, ARow arow, const float* __restrict__ B, int ldb, int N, int K, int m0, int n0, EPI epi) {
    float* As = lds; float* Bs = lds + 16 * GLDA;
    const int tid = TID(), ty = tid >> 4, tx = tid & 15;
    const int ar = tid >> 2, akq = (tid & 3) * 4;
    const float* ap = arow(m0 + ar);
    const int bk = (tid & 255) >> 4, bn = (tid & 15) * 4;
    const bool bload = tid < 256 && (n0 + bn) < N;
    float acc[4][4];
#pragma unroll
    for (int i = 0; i < 4; ++i)
#pragma unroll
        for (int j = 0; j < 4; ++j) acc[i][j] = 0.f;
    for (int k0 = 0; k0 < K; k0 += 16) {
        float4 av = make_float4(0.f, 0.f, 0.f, 0.f), bv = make_float4(0.f, 0.f, 0.f, 0.f);
        if (ap) av = *(const float4*)(ap + k0 + akq);
        if (bload) bv = *(const float4*)(B + (size_t)(k0 + bk) * ldb + n0 + bn);
        __syncthreads();
        As[(akq + 0) * GLDA + ar] = av.x; As[(akq + 1) * GLDA + ar] = av.y; As[(akq + 2) * GLDA + ar] = av.z; As[(akq + 3) * GLDA + ar] = av.w;
        if (tid < 256) *(float4*)&Bs[bk * 64 + bn] = bv;
        __syncthreads();
#pragma unroll
        for (int k = 0; k < 16; ++k) {
            const float4 a = *(const float4*)&As[k * GLDA + ty * 4];
            const float4 b = *(const float4*)&Bs[k * 64 + tx * 4];
            acc[0][0] += a.x * b.x; acc[0][1] += a.x * b.y; acc[0][2] += a.x * b.z; acc[0][3] += a.x * b.w;
            acc[1][0] += a.y * b.x; acc[1][1] += a.y * b.y; acc[1][2] += a.y * b.z; acc[1][3] += a.y * b.w;
            acc[2][0] += a.z * b.x; acc[2][1] += a.z * b.y; acc[2][2] += a.z * b.z; acc[2][3] += a.z * b.w;
            acc[3][0] += a.w * b.x; acc[3][1] += a.w * b.y; acc[3][2] += a.w * b.z; acc[3][3] += a.w * b.w;
        }
    }
    __syncthreads();
    const int col = n0 + tx * 4;
    if (col < N) {
#pragma unroll
        for (int i = 0; i < 4; ++i) epi(m0 + ty * 4 + i, col, make_float4(acc[i][0], acc[i][1], acc[i][2], acc[i][3]));
    }
}
PH void ph_gemm_plain(float* lds, const float* A, int lda, const float* B, int ldb, float* C, int ldc, int M, int N, int K) {
    const int nct = (N + 63) / 64, nunits = (M / 128) * nct;
    for (int u = BID(); u < nunits; u += GDIM()) {
        const int mt = u / nct, ct = u % nct;
        gemm_tile(lds, [&](int r) { return A + (size_t)r * lda; }, B, ldb, N, K, mt * 128, ct * 64,
                  [&](int row, int col, float4 v) { *(float4*)(C + (size_t)row * ldc + col) = v; });
    }
}
PH void ph_gemm_resid(float* lds, const float* A, const float* B, float* h, const float* modl, int gate_off) {
    const int nct = D / 64, nunits = (NT / 128) * nct;
    for (int u = BID(); u < nunits; u += GDIM()) {
        const int mt = u / nct, ct = u % nct;
        gemm_tile(lds, [&](int r) { return A + (size_t)r * D; }, B, D, D, D, mt * 128, ct * 64,
                  [&](int row, int col, float4 v) {
                      const float4 g = *(const float4*)(modl + (size_t)mod_row(row) * MODW + gate_off + col);
                      float4* hp = (float4*)(h + (size_t)row * D + col); float4 o = *hp;
                      o.x += g.x * v.x; o.y += g.y * v.y; o.z += g.z * v.z; o.w += g.w * v.w; *hp = o; });
    }
}

PH void ph_rope(float* px) {
    const size_t total = (size_t)NX * 480;
    for (size_t i = (size_t)BID() * NTHR + TID(); i < total; i += (size_t)GDIM() * NTHR) {
        const int r = (int)(i / 480), q5 = (int)(i % 480), hh = q5 >> 5, q = q5 & 31, a = q >> 4, f = q & 15;
        const int t = r & 2047, pos = a ? (t & 63) : (t >> 6);
        const float inv = powf(10000.f, -(float)f / 16.f);
        const float ang = (float)pos * inv, cs = cosf(ang), sn = sinf(ang);
        float* base = px + (size_t)r * EVEN_IN + 256 + hh * 64 + a * 32 + f;
        const float x1 = base[0], x2 = base[16];
        base[0] = x1 * cs - x2 * sn; base[16] = x2 * cs + x1 * sn;
    }
}
PH void ph_pool(const float* px, const float* pool_w, const float* pool_scale, bf16_t* mix) {
    const int lane = TID() & 63, wave = (BID() * NTHR + TID()) >> 6, nw = GDIM() * NWAVE;
    for (int task = wave; task < NT * 4; task += nw) {
        const int r = task >> 2, gi = task & 3; int s0, len, t; seq_info(r, s0, len, t);
        const int w = 2 << gi; int lo = t - w / 2, hi = t - w / 2 + w; lo = lo < 0 ? 0 : lo; hi = hi > len ? len : hi;
        float s = 0.f;
        for (int tt = lo; tt < hi; ++tt) s += px[(size_t)(s0 + tt) * EVEN_IN + gi * 64 + lane];
        const float pooled = s / (float)(hi - lo) - px[(size_t)r * EVEN_IN + gi * 64 + lane];
        const float* pw = pool_w + (size_t)gi * 4096;
        float acc = 0.f;
#pragma unroll 8
        for (int c = 0; c < 64; ++c) acc += __shfl(pooled, c) * pw[c * 64 + lane];
        mix[(size_t)r * D + gi * 64 + lane] = f2bf(acc * pool_scale[gi * 64 + lane]);
    }
}
PH void ph_attn(float* lds, const float* px, const float* sink, bf16_t* mix) {
    const int lane = TID() & 63, wib = TID() >> 6, wave = (BID() * NTHR + TID()) >> 6, nw = GDIM() * NWAVE;
    float* pb = lds + wib * 576;
    for (int task = wave; task < NT * 12; task += nw) {
        const int r = task / 12, hh = task % 12, kvh = hh >> 2;
        const bool lat = r < NX;
        const int b = lat ? (r >> 11) : ((r - NX) >> 8);
        int klo = 0, nloc = 0;
        if (lat) { const int t = r & 2047; klo = t - 128 < 0 ? 0 : t - 128; const int khi = t + 128 > 2047 ? 2047 : t + 128; nloc = khi - klo + 1; }
        const int nkeys = nloc + CTX;
        float q[64];
        const float* qp = px + (size_t)r * EVEN_IN + 256 + hh * 64;
#pragma unroll
        for (int d4 = 0; d4 < 16; ++d4) { const float4 v = *(const float4*)(qp + d4 * 4); q[d4 * 4] = v.x; q[d4 * 4 + 1] = v.y; q[d4 * 4 + 2] = v.z; q[d4 * 4 + 3] = v.w; }
        float mx = sink[hh];
        for (int kidx = lane; kidx < nkeys; kidx += 64) {
            const int krow = kidx < nloc ? (b * SEQ + klo + kidx) : (NX + b * CTX + (kidx - nloc));
            const float* kp = px + (size_t)krow * EVEN_IN + 1024 + kvh * 64;
            float s = 0.f;
#pragma unroll
            for (int d4 = 0; d4 < 16; ++d4) { const float4 v = *(const float4*)(kp + d4 * 4); s += q[d4 * 4] * v.x + q[d4 * 4 + 1] * v.y + q[d4 * 4 + 2] * v.z + q[d4 * 4 + 3] * v.w; }
            s *= 0.125f;
            pb[kidx] = s; mx = fmaxf(mx, s);
        }
        mx = wave_max(mx);
        float den = 0.f;
        for (int kidx = lane; kidx < nkeys; kidx += 64) { const float e = expf(pb[kidx] - mx); pb[kidx] = e; den += e; }
        den = wave_sum(den) + expf(sink[hh] - mx);
        __builtin_amdgcn_wave_barrier();
        float acc = 0.f;
        for (int kidx = 0; kidx < nkeys; ++kidx) {
            const int krow = kidx < nloc ? (b * SEQ + klo + kidx) : (NX + b * CTX + (kidx - nloc));
            acc += pb[kidx] * px[(size_t)krow * EVEN_IN + 1216 + kvh * 64 + lane];
        }
        mix[(size_t)r * D + 256 + hh * 64 + lane] = f2bf(acc / den);
        __builtin_amdgcn_wave_barrier();
    }
}


PH void ph_rope_tab(float* rc, float* rs) {
    const int i = BID() * NTHR + TID();
    if (i < 1024) { const int pos = i >> 4, f = i & 15; const float inv = powf(10000.f, -(float)f / 16.f), ang = (float)pos * inv; rc[i] = cosf(ang); rs[i] = sinf(ang); }
}
struct EpiRopeBf16 {
    static constexpr bool PERM = true;
    bf16_t* O; int ldc; const float* ct; const float* st;
    struct Pre {}; __device__ __forceinline__ Pre prefetch(const pg8::Unit&, int, int) const { return Pre{}; }
    __device__ __forceinline__ void operator()(const pg8::f32x4 (&acc)[2][2][4][2], const pg8::Unit& u, int wr, int wc, int fr, int fq, const Pre&) const {
        const int row0 = u.pm * 256 + wr * 64 + fr; const bool lat = u.pm * 256 < NX;
        const float sgn = fq < 2 ? -1.f : 1.f; const int f0 = 8 * (fq & 1);
#pragma unroll
        for (int ai = 0; ai < 2; ++ai)
#pragma unroll
            for (int m = 0; m < 4; ++m) { const int row = row0 + ai * 128 + m * 16, t = row & 2047;
#pragma unroll
                for (int bj = 0; bj < 2; ++bj) { const int cbase = u.pn * 256 + bj * 128 + wc * 32;
                    const pg8::f32x4 zz = (pg8::f32x4){0.f, 0.f, 0.f, 0.f};
                    pg8::f32x4 v0 = acc[ai][bj][m][0] + zz, v1 = acc[ai][bj][m][1] + zz;
                    if (lat && cbase >= 256 && cbase < 1216) {
                        const int pos = ((cbase >> 5) & 1) ? (t & 63) : (t >> 6);
                        const pg8::f32x4 c0 = *(const pg8::f32x4*)(ct + pos * 16 + f0), c1 = *(const pg8::f32x4*)(ct + pos * 16 + f0 + 4);
                        const pg8::f32x4 s0 = *(const pg8::f32x4*)(st + pos * 16 + f0) * sgn, s1 = *(const pg8::f32x4*)(st + pos * 16 + f0 + 4) * sgn;
                        pg8::f32x4 o0, o1;
#pragma unroll
                        for (int q = 0; q < 4; ++q) { o0[q] = __shfl_xor(v0[q], 32); o1[q] = __shfl_xor(v1[q], 32); }
                        v0 = v0 * c0 + o0 * s0; v1 = v1 * c1 + o1 * s1;
                    }
                    pg8::u32x4 w; w.x = pg8::cvt_pk_bf16(v0[0], v0[1]); w.y = pg8::cvt_pk_bf16(v0[2], v0[3]); w.z = pg8::cvt_pk_bf16(v1[0], v1[1]); w.w = pg8::cvt_pk_bf16(v1[2], v1[3]);
                    *(pg8::u32x4*)(O + (size_t)row * ldc + cbase + 8 * fq) = w; } }
    }
};
PH void ph_pool_prep(const float* pw, bf16_t* pwt) {
    for (int i = BID() * NTHR + TID(); i < 2 * 4 * 64 * 64; i += GDIM() * NTHR) { const int m = i >> 12, d = (i >> 6) & 63, c = i & 63; pwt[i] = f2bf(pw[(m << 12) + c * 64 + d]); }
}
template <int HALF>
PH void pool_window(const bf16_t* col, int t0, int len, LAS unsigned char* Pt, int lane) {
    float v[64 + 2 * HALF];
#pragma unroll
    for (int j = 0; j < 64 + 2 * HALF; ++j) { const int t = t0 - HALF + j; const bool in = t >= 0 && t < len; const float x = bf2f(col[(size_t)(in ? t : t0) * 1536]); v[j] = in ? x : 0.f; }
    float sum = 0.f;
#pragma unroll
    for (int j = 0; j < 2 * HALF; ++j) sum += v[j];
#pragma unroll
    for (int i = 0; i < 64; ++i) {
        const int t = t0 + i, lo = t - HALF < 0 ? 0 : t - HALF, hi = t + HALF > len ? len : t + HALF;
        *(LAS unsigned short*)(Pt + i * 144 + lane * 2) = f2bf(sum * __builtin_amdgcn_rcpf((float)(hi - lo)) - v[i + HALF]);
        sum += v[i + 2 * HALF] - v[i];
    }
}
PH void ph_pool16(LAS unsigned char* lsm, const bf16_t* px, const bf16_t* pwt, const float* pool_scale, bf16_t* mix) {
    const int lane = TID() & 63, wib = TID() >> 6, wave = BID() * NWAVE + wib, nw = GDIM() * NWAVE, fr = lane & 15, fq = lane >> 4;
    LAS unsigned char* Pt = lsm + STAGE_OFF + wib * (64 * 144);
    for (int task = wave; task < (NT / 64) * 4; task += nw) {
        const int r0 = (task >> 2) * 64, gi = task & 3; int s0, len, t0; seq_info(r0, s0, len, t0);
        const bf16_t* col = px + (size_t)s0 * 1536 + gi * 64 + lane;
        __builtin_amdgcn_wave_barrier();
        if (gi == 0) pool_window<1>(col, t0, len, Pt, lane); else if (gi == 1) pool_window<2>(col, t0, len, Pt, lane); else if (gi == 2) pool_window<4>(col, t0, len, Pt, lane); else pool_window<8>(col, t0, len, Pt, lane);
        __builtin_amdgcn_wave_barrier();
        pg8::bf16x8 wf[4][2];
#pragma unroll
        for (int nt = 0; nt < 4; ++nt)
#pragma unroll
            for (int ks = 0; ks < 2; ++ks) wf[nt][ks] = *(const pg8::bf16x8*)(pwt + (size_t)gi * 4096 + (16 * nt + fr) * 64 + 32 * ks + 8 * fq);
#pragma unroll
        for (int mt = 0; mt < 4; ++mt) {
            pg8::bf16x8 pf[2];
#pragma unroll
            for (int ks = 0; ks < 2; ++ks) pf[ks] = *(const LAS pg8::bf16x8*)(Pt + (16 * mt + fr) * 144 + (32 * ks + 8 * fq) * 2);
#pragma unroll
            for (int nt = 0; nt < 4; ++nt) {
                pg8::f32x4 acc = (pg8::f32x4){0.f, 0.f, 0.f, 0.f};
#pragma unroll
                for (int ks = 0; ks < 2; ++ks) acc = __builtin_amdgcn_mfma_f32_16x16x32_bf16(wf[nt][ks], pf[ks], acc, 0, 0, 0);
                const pg8::f32x4 sc = *(const pg8::f32x4*)(pool_scale + gi * 64 + 16 * nt + 4 * fq);
                const pg8::f32x4 v = acc * sc;
                pg8::u32x2 o; o.x = pg8::cvt_pk_bf16(v[0], v[1]); o.y = pg8::cvt_pk_bf16(v[2], v[3]);
                *(pg8::u32x2*)(mix + (size_t)(r0 + 16 * mt + fr) * D + gi * 64 + 16 * nt + 4 * fq) = o;
            }
        }
        __builtin_amdgcn_wave_barrier();
    }
    __syncthreads();
}
typedef short s16x4 __attribute__((ext_vector_type(4)));
typedef float f32x16 __attribute__((ext_vector_type(16)));
constexpr int AT_KP = 144, AT_VP = 192, AT_KB = 64 * AT_KP, AT_VB = 64 * AT_VP;
PH pg8::bf16x8 pack_bf16x8(float x0, float x1, float x2, float x3, float x4, float x5, float x6, float x7) {
    pg8::u32x4 pk; pk[0] = pg8::cvt_pk_bf16(x0, x1); pk[1] = pg8::cvt_pk_bf16(x2, x3); pk[2] = pg8::cvt_pk_bf16(x4, x5); pk[3] = pg8::cvt_pk_bf16(x6, x7);
    return __builtin_bit_cast(pg8::bf16x8, pk);
}
PH void ph_attn16(LAS unsigned char* lsm, const bf16_t* px, const float* sink, bf16_t* mix) {
    LAS unsigned char* base = lsm + STAGE_OFF;
    const int tid = TID(), lane = tid & 63, wid = __builtin_amdgcn_readfirstlane(tid >> 6), l31 = lane & 31, h = lane >> 5;
    const int skey = tid >> 3, spc = tid & 7;
    const int trq = (lane & 15) >> 2, trp = lane & 3, trblk = (lane >> 4) & 1;
    const float C = 0.125f * 1.4426950408889634f;
    for (int u = BID(); u < 1728; u += GDIM()) {
        int b, kvh, q0, nb, c_lo, qrow0;
        if (u < 1536) { b = u / 96; const int rem = u % 96; kvh = rem >> 5; q0 = (rem & 31) * 64;
            c_lo = (128 - q0 + 63) >> 6; c_lo = c_lo < 0 ? 0 : c_lo; int c_hi = (2112 - q0) >> 6; c_hi = c_hi > 4 ? 4 : c_hi; nb = c_hi - c_lo + 1; qrow0 = b * SEQ + q0; }
        else { const int v = u - 1536; b = v / 12; const int rem = v % 12; kvh = rem >> 2; q0 = 0; c_lo = 0; nb = 0; qrow0 = NX + b * CTX + (rem & 3) * 64; }
        const int n = nb + 4;
        const int hq = kvh * 4 + (wid >> 1), iq = 32 * (wid & 1) + l31;
        pg8::bf16x8 qf[4];
        { const bf16_t* qp = px + (size_t)(qrow0 + iq) * 1536 + 256 + hq * 64 + 8 * h;
#pragma unroll
          for (int s = 0; s < 4; ++s) qf[s] = *(const pg8::bf16x8*)(qp + 16 * s); }
        float mrun = sink[hq] * 1.4426950408889634f, lrun = h == 0 ? 1.f : 0.f;
        f32x16 o[2];
#pragma unroll
        for (int q = 0; q < 16; ++q) { o[0][q] = 0.f; o[1][q] = 0.f; }
        const size_t kcol = 1024 + kvh * 64 + spc * 8, vcol = 1216 + kvh * 64 + spc * 8;
        pg8::u32x4 kreg, vreg, kreg2, vreg2;
        auto kvload = [&](int kk, pg8::u32x4& kr, pg8::u32x4& vr) { kk = kk < n ? kk : n - 1;
            const int rowbase = kk < nb ? b * SEQ + q0 - 128 + 64 * (c_lo + kk) : NX + b * CTX + 64 * (kk - nb);
            const bf16_t* rp = px + (size_t)(rowbase + skey) * 1536; kr = *(const pg8::u32x4*)(rp + kcol); vr = *(const pg8::u32x4*)(rp + vcol); };
        kvload(0, kreg2, vreg2); kvload(1, kreg, vreg);
        *(LAS pg8::u32x4*)(base + skey * AT_KP + spc * 16) = kreg2;
        *(LAS pg8::u32x4*)(base + 2 * AT_KB + skey * AT_VP + spc * 16) = vreg2;
        __syncthreads();
        for (int k = 0; k < n; ++k) {
            int mtype = 0;
            if (k < nb) { const int c = c_lo + k; mtype = c == 0 ? 1 : (c == 4 ? 2 : 0); }
            kvload(k + 2, kreg2, vreg2);
            const LAS unsigned char* Kb = base + (k & 1) * AT_KB; const LAS unsigned char* Vb = base + 2 * AT_KB + (k & 1) * AT_VB;
            f32x16 st[2];
#pragma unroll
            for (int kt = 0; kt < 2; ++kt) {
#pragma unroll
                for (int q = 0; q < 16; ++q) st[kt][q] = 0.f;
#pragma unroll
                for (int s = 0; s < 4; ++s) { const pg8::bf16x8 a = *(const LAS pg8::bf16x8*)(Kb + (32 * kt + l31) * AT_KP + (16 * s + 8 * h) * 2);
                    st[kt] = __builtin_amdgcn_mfma_f32_32x32x16_bf16(a, qf[s], st[kt], 0, 0, 0); }
            }
            float mx = -1e30f;
#pragma unroll
            for (int kt = 0; kt < 2; ++kt)
#pragma unroll
                for (int r = 0; r < 16; ++r) { float t = st[kt][r] * C;
                    if (mtype) { const int j = 32 * kt + (r & 3) + 8 * (r >> 2) + 4 * h; const bool ok = mtype == 1 ? (j >= iq) : (j <= iq); t = ok ? t : -1e30f; }
                    st[kt][r] = t; mx = fmaxf(mx, t); }
            mx = fmaxf(mx, __shfl_xor(mx, 32));
            const float mnew = fmaxf(mrun, mx), alpha = __builtin_amdgcn_exp2f(mrun - mnew);
            mrun = mnew; lrun *= alpha;
#pragma unroll
            for (int q = 0; q < 16; ++q) { o[0][q] *= alpha; o[1][q] *= alpha; }
            float lsum = 0.f;
#pragma unroll
            for (int kt = 0; kt < 2; ++kt)
#pragma unroll
                for (int r = 0; r < 16; ++r) { const float pv = __builtin_amdgcn_exp2f(st[kt][r] - mnew); st[kt][r] = pv; lsum += pv; }
            lrun += lsum;
            pg8::bf16x8 pf[4];
#pragma unroll
            for (int ks = 0; ks < 4; ++ks) { const int kt = ks >> 1, s8 = (ks & 1) * 8;
                pf[ks] = pack_bf16x8(st[kt][s8], st[kt][s8 + 1], st[kt][s8 + 2], st[kt][s8 + 3], st[kt][s8 + 4], st[kt][s8 + 5], st[kt][s8 + 6], st[kt][s8 + 7]); }
#pragma unroll
            for (int dt = 0; dt < 2; ++dt)
#pragma unroll
                for (int ks = 0; ks < 4; ++ks) { const int k0 = 16 * ks + 4 * h + trq;
                    const LAS unsigned char* ap = Vb + k0 * AT_VP + (32 * dt + 16 * trblk + 4 * trp) * 2;
                    const s16x4 lo = __builtin_amdgcn_ds_read_tr16_b64_v4i16((LAS s16x4*)ap), hi = __builtin_amdgcn_ds_read_tr16_b64_v4i16((LAS s16x4*)(ap + 8 * AT_VP));
                    const pg8::bf16x8 vf = __builtin_shufflevector(lo, hi, 0, 1, 2, 3, 4, 5, 6, 7);
                    o[dt] = __builtin_amdgcn_mfma_f32_32x32x16_bf16(vf, pf[ks], o[dt], 0, 0, 0); }
            if (k + 1 < n) { *(LAS pg8::u32x4*)(base + ((k + 1) & 1) * AT_KB + skey * AT_KP + spc * 16) = kreg;
                             *(LAS pg8::u32x4*)(base + 2 * AT_KB + ((k + 1) & 1) * AT_VB + skey * AT_VP + spc * 16) = vreg; }
            kreg = kreg2; vreg = vreg2;
            asm volatile("s_waitcnt lgkmcnt(0)" ::: "memory"); __builtin_amdgcn_s_barrier(); asm volatile("" ::: "memory");
        }
        const float ltot = lrun + __shfl_xor(lrun, 32), inv = 1.f / ltot;
        bf16_t* op = mix + (size_t)(qrow0 + iq) * D + 256 + hq * 64 + 4 * h;
#pragma unroll
        for (int dt = 0; dt < 2; ++dt)
#pragma unroll
            for (int rg = 0; rg < 4; ++rg) { pg8::u32x2 w; w.x = pg8::cvt_pk_bf16(o[dt][4 * rg] * inv, o[dt][4 * rg + 1] * inv); w.y = pg8::cvt_pk_bf16(o[dt][4 * rg + 2] * inv, o[dt][4 * rg + 3] * inv);
                *(pg8::u32x2*)(op + 32 * dt + 8 * rg) = w; }
    }
}
PH void ph_scanprep(float* lds, const float* px, const OddW& w, const ScanArrays& sa) {
    float* fl = lds;
    float* hs = lds + 2720;
    const int tid = TID(), lane = tid & 63, wv = tid >> 6;
    for (int r = BID(); r < NT; r += GDIM()) {
        int s0, len, t; seq_info(r, s0, len, t);
        const float* pr = px + (size_t)r * ODD_IN;
        for (int col = tid; col < 2720; col += NTHR) {
            const float u = pr[col], pv = t > 0 ? pr[col - ODD_IN] : 0.f, nx = t < len - 1 ? pr[col + ODD_IN] : 0.f;
            float f = u + w.mu[col] * (pv - u) + w.mu[2720 + col] * (nx - u);
            if (col >= 2304 && col < 2432) f = tanhf(f);
            if (col >= 2560) f = sigmoidf_(f);
            fl[col] = f;
        }
        __syncthreads();
        float kkr[2] = {0.f, 0.f};
#pragma unroll
        for (int i = 0; i < 2; ++i) { const int c = tid + NTHR * i; if (c < RW) { kkr[i] = fl[768 + c] * w.k_k[c]; const float ss = wave_sum(kkr[i] * kkr[i]); if (lane == 0) hs[8 * i + wv] = ss; } }
        __syncthreads();
#pragma unroll
        for (int i = 0; i < 2; ++i) {
            const int c = tid + NTHR * i;
            if (c < RW) {
                const int head = c >> 6;
                float lw0 = w.w0[c], lw1 = w.w0[768 + c], la0 = w.a0[c], la1 = w.a0[768 + c], gg = 0.f;
                for (int j = 0; j < 64; ++j) {
                    lw0 += fl[2304 + j] * w.w2[(size_t)j * 768 + c];
                    lw1 += fl[2368 + j] * w.w2[(size_t)(64 + j) * 768 + c];
                    la0 += fl[2432 + j] * w.a2[(size_t)j * 768 + c];
                    la1 += fl[2496 + j] * w.a2[(size_t)(64 + j) * 768 + c];
                }
                for (int j = 0; j < 160; ++j) gg += fl[2560 + j] * w.g2[(size_t)j * 768 + c];
                const float kk = kkr[i] / fmaxf(sqrtf(hs[head]), 1e-12f);
                const float k = fl[768 + c], v = fl[1536 + c], rr = fl[c], ka = w.k_a[c];
                const size_t o = (size_t)r * RW + c;
                sa.R[o] = rr; sa.V[o] = v; sa.KK[o] = kk; sa.G[o] = gg;
                const float z0 = -lw0, sp0 = fmaxf(z0, 0.f) + log1pf(expf(-fabsf(z0))); const float wl0 = -sp0 - 0.5f;
                const float z1 = -lw1, sp1 = fmaxf(z1, 0.f) + log1pf(expf(-fabsf(z1))); const float wl1 = -sp1 - 0.5f;
                sa.W[0][o] = expf(-expf(wl0)); sa.W[1][o] = expf(-expf(wl1));
                const float a_0 = sigmoidf_(la0), a_1 = sigmoidf_(la1);
                sa.KD[0][o] = k * (1.f + (a_0 - 1.f) * ka); sa.KD[1][o] = k * (1.f + (a_1 - 1.f) * ka);
                sa.BB[0][o] = kk * a_0; sa.BB[1][o] = kk * a_1;
            }
        }
        __syncthreads();
    }
}
PH void ph_scan(float* lds, const ScanArrays& sa) {
    const int lane = TID() & 63, wib = TID() >> 6;
    const int chain = BID() * NWAVE + wib;
    if (chain >= NB * 12 * 2) return;
    float* sh = lds + wib * 320;
    const int dir = chain & 1, bh = chain >> 1, b = bh / 12, hh = bh % 12;
    const float* Wd = sa.W[dir]; const float* KD = sa.KD[dir]; const float* BB = sa.BB[dir]; float* Y = sa.Y[dir];
    float S[64];
#pragma unroll
    for (int j = 0; j < 64; ++j) S[j] = 0.f;
    for (int s = 0; s < CTX + SEQ; ++s) {
        int tok;
        if (s < CTX) { const int tt = dir ? CTX - 1 - s : s; tok = NX + b * CTX + tt; }
        else { int tt = s - CTX; tt = dir ? SEQ - 1 - tt : tt; tok = b * SEQ + tt; }
        const size_t off = (size_t)tok * RW + hh * 64 + lane;
        const float v = sa.V[off];
        __builtin_amdgcn_wave_barrier();
        sh[lane] = Wd[off]; sh[64 + lane] = KD[off]; sh[128 + lane] = BB[off]; sh[192 + lane] = sa.KK[off]; sh[256 + lane] = sa.R[off];
        __builtin_amdgcn_wave_barrier();
        float sacc = 0.f;
#pragma unroll
        for (int j = 0; j < 64; ++j) sacc += S[j] * sh[192 + j];
#pragma unroll
        for (int j = 0; j < 64; ++j) S[j] = S[j] * sh[j] + (v * sh[64 + j] - sacc * sh[128 + j]);
        float y = 0.f;
#pragma unroll
        for (int j = 0; j < 64; ++j) y += S[j] * sh[256 + j];
        Y[off] = y;
    }
}
PH void ph_readout(const ScanArrays& sa, const OddW& w, bf16_t* mix) {
    const int lane = TID() & 63, wave = (BID() * NTHR + TID()) >> 6, nw = GDIM() * NWAVE;
    for (int task = wave; task < NT * 12; task += nw) {
        const int r = task / 12, hh = task % 12, c = hh * 64 + lane;
        const size_t o = (size_t)r * RW + c;
        const float y = sa.Y[0][o] + sa.Y[1][o];
        const float mean = wave_sum(y) * (1.f / 64.f), d = y - mean, var = wave_sum(d * d) * (1.f / 64.f);
        const float yn = d * rsqrtf(var + 64e-5f) * w.gn_g[c] + w.gn_b[c];
        const float coef = wave_sum(sa.R[o] * (sa.KD[0][o] + sa.KD[1][o]) * w.r_k[c]);
        mix[(size_t)r * D + c] = f2bf((yn + coef * sa.V[o]) * sa.G[o]);
    }
}
PH void ph_fft_tab(bf16_t* tabT) {
    const int i = BID() * NTHR + TID();
    if (i < 128 * 64) { const int col = i >> 6, c = i & 63, part = col >> 6, k2 = col & 63; const float fr_ = (float)((k2 * c) & 63) / 64.f; tabT[i] = f2bf(part ? __builtin_amdgcn_sinf(fr_) : __builtin_amdgcn_cosf(fr_)); }
}
PH void ph_fft_prep16(const bf16_t* px, const bf16_t* tabT, bf16_t* bt_lat, bf16_t* bt_ctx) {
    const int lane = TID() & 63, fr = lane & 15, fq = lane >> 4, wave = (BID() * NTHR + TID()) >> 6, nw = GDIM() * NWAVE;
    for (int task = wave; task < (NT / 16) * 4; task += nw) {
        const int r0 = (task >> 2) * 16, g = task & 3;
        pg8::bf16x8 uf[2];
#pragma unroll
        for (int ks = 0; ks < 2; ++ks) uf[ks] = *(const pg8::bf16x8*)(px + (size_t)(r0 + fr) * 3072 + 2720 + g * 64 + 32 * ks + 8 * fq);
        bf16_t* base; int T, t;
        if (r0 < NX) { const int b = r0 >> 11; t = r0 & 2047; T = 2048; base = bt_lat + (size_t)(b * 4 + g) * 64 * 4096; }
        else { const int q = r0 - NX, b = q >> 8; t = q & 255; T = 256; base = bt_ctx + (size_t)(b * 4 + g) * 64 * 512; }
#pragma unroll
        for (int nt = 0; nt < 8; ++nt) {
            pg8::f32x4 acc = (pg8::f32x4){0.f, 0.f, 0.f, 0.f};
#pragma unroll
            for (int ks = 0; ks < 2; ++ks) { const pg8::bf16x8 tf = *(const pg8::bf16x8*)(tabT + (size_t)(16 * nt + fr) * 64 + 32 * ks + 8 * fq);
                acc = __builtin_amdgcn_mfma_f32_16x16x32_bf16(uf[ks], tf, acc, 0, 0, 0); }
            const int col = 16 * nt + fr, part = col >> 6, k2 = col & 63;
            pg8::u32x2 o; o.x = (unsigned)f2bf(acc[0]) | ((unsigned)f2bf(acc[1]) << 16); o.y = (unsigned)f2bf(acc[2]) | ((unsigned)f2bf(acc[3]) << 16);
            *(pg8::u32x2*)(base + (size_t)k2 * 2 * T + part * T + t + 4 * fq) = o;
        }
    }
}
PH void ph_twiddle16(bf16_t* tw, int T) {
    const int total = T * T, lg = 31 - __builtin_clz(T);
    for (int i = BID() * NTHR + TID(); i < total; i += GDIM() * NTHR) {
        const int k1 = i >> lg, t = i & (T - 1); const int m = (k1 * t) & (T - 1);
        const float fr_ = (float)m / (float)T;
        tw[(size_t)k1 * 2 * T + t] = f2bf(__builtin_amdgcn_cosf(fr_)); tw[(size_t)k1 * 2 * T + T + t] = f2bf(-__builtin_amdgcn_sinf(fr_));
    }
}
struct DenseOrder : pg8::TileOrder { __device__ __forceinline__ bool next(int i, pg8::Unit& u) const { u.e = 0; return tile(i, u.pm, u.pn); } };
struct EpiF32Guard {
    static constexpr bool PERM = false;
    float* C; int ldc, ncols;
    __device__ __forceinline__ void operator()(const pg8::f32x4 (&acc)[2][2][4][2], const pg8::Unit& u, int wr, int wc, int fr, int fq) const {
        const int row0 = u.pm * 256 + wr * 64 + fr, col0 = u.pn * 256 + wc * 32 + 4 * fq;
#pragma unroll
        for (int ai = 0; ai < 2; ++ai)
#pragma unroll
            for (int m = 0; m < 4; ++m) { float* rowp = C + (size_t)(row0 + ai * 128 + m * 16) * ldc;
#pragma unroll
                for (int bj = 0; bj < 2; ++bj)
#pragma unroll
                    for (int n = 0; n < 2; ++n) { const int c = col0 + bj * 128 + n * 16; if (c < ncols) *(pg8::f32x4*)(rowp + c) = acc[ai][bj][m][n]; } }
    }
};
struct EpiResid {
    static constexpr bool PERM = false;
    float* h; const float* gate;
    __device__ __forceinline__ void operator()(const pg8::f32x4 (&acc)[2][2][4][2], const pg8::Unit& u, int wr, int wc, int fr, int fq) const {
        const int row0 = u.pm * 256 + wr * 64 + fr, col0 = u.pn * 256 + wc * 32 + 4 * fq;
#pragma unroll
        for (int ai = 0; ai < 2; ++ai)
#pragma unroll
            for (int m = 0; m < 4; ++m) { const int row = row0 + ai * 128 + m * 16; float* rowp = h + (size_t)row * D; const float* gp = gate + (size_t)mod_row(row) * MODW;
#pragma unroll
                for (int bj = 0; bj < 2; ++bj)
#pragma unroll
                    for (int n = 0; n < 2; ++n) { const int c = col0 + bj * 128 + n * 16; const pg8::f32x4 g = *(const pg8::f32x4*)(gp + c); pg8::f32x4* hp = (pg8::f32x4*)(rowp + c); *hp = *hp + g * acc[ai][bj][m][n]; } }
    }
};
struct EpiDft {
    static constexpr bool PERM = true;
    bf16_t* mix; int T, row0; float scale;
    struct Pre {}; __device__ __forceinline__ Pre prefetch(const pg8::Unit&, int, int) const { return Pre{}; }
    __device__ __forceinline__ void operator()(const pg8::f32x4 (&acc)[2][2][4][2], const pg8::Unit& u, int wr, int wc, int fr, int fq, const Pre&) const {
        const int r0 = u.pm * 256 + wr * 64 + fr, col0 = u.pn * 256 + wc * 32 + 8 * fq;
#pragma unroll
        for (int ai = 0; ai < 2; ++ai)
#pragma unroll
            for (int m = 0; m < 4; ++m) { const int k1 = r0 + ai * 128 + m * 16;
#pragma unroll
                for (int bj = 0; bj < 2; ++bj) { const int c = col0 + bj * 128, bg = c >> 6, k2 = c & 63, b = bg >> 2, g = bg & 3;
                    const pg8::f32x4 v0 = acc[ai][bj][m][0] * scale, v1 = acc[ai][bj][m][1] * scale;
                    pg8::u32x4 w; w.x = pg8::cvt_pk_bf16(v0[0], v0[1]); w.y = pg8::cvt_pk_bf16(v0[2], v0[3]); w.z = pg8::cvt_pk_bf16(v1[0], v1[1]); w.w = pg8::cvt_pk_bf16(v1[2], v1[3]);
                    *(pg8::u32x4*)(mix + (size_t)(row0 + b * T + k1) * D + 768 + g * 64 + k2) = w; } }
    }
};
struct EpiPlainBf16 {
    static constexpr bool PERM = true;
    bf16_t* O; int ldc;
    struct Pre {}; __device__ __forceinline__ Pre prefetch(const pg8::Unit&, int, int) const { return Pre{}; }
    __device__ __forceinline__ void operator()(const pg8::f32x4 (&acc)[2][2][4][2], const pg8::Unit& u, int wr, int wc, int fr, int fq, const Pre&) const {
        const int row0 = u.pm * 256 + wr * 64 + fr, col0 = u.pn * 256 + wc * 32 + 8 * fq;
#pragma unroll
        for (int ai = 0; ai < 2; ++ai)
#pragma unroll
            for (int m = 0; m < 4; ++m) { bf16_t* rowp = O + (size_t)(row0 + ai * 128 + m * 16) * ldc + col0;
#pragma unroll
                for (int bj = 0; bj < 2; ++bj) { const pg8::f32x4 zz = (pg8::f32x4){0.f, 0.f, 0.f, 0.f}; const pg8::f32x4 v0 = acc[ai][bj][m][0] + zz, v1 = acc[ai][bj][m][1] + zz;
                    pg8::u32x4 w; w.x = pg8::cvt_pk_bf16(v0[0], v0[1]); w.y = pg8::cvt_pk_bf16(v0[2], v0[3]); w.z = pg8::cvt_pk_bf16(v1[0], v1[1]); w.w = pg8::cvt_pk_bf16(v1[2], v1[3]);
                    *(pg8::u32x4*)(rowp + bj * 128) = w; } }
    }
};
template <class Epi>
PH void ph_gemm16(LAS unsigned char* smem, const bf16_t* A, const bf16_t* Bt, int M, int N, int K, const Epi& E, int blk, int nblk) {
    DenseOrder S; S.init(M / 256, N / 256, nblk, blk);
    pg8::Gemm g; g.A = A; g.Bt = Bt; g.M = M; g.N = N; g.K = K; g.bgstride = 0;
    pg8::gemm_phase(smem + STAGE_OFF, g, S, E);
}

PH void ph_convT_small(const float* src, bf16_t* dst, int K, int N, int nmat) {
    const int total = nmat * K * N, kn = K * N;
    for (int i = BID() * NTHR + TID(); i < total; i += GDIM() * NTHR) {
        const int mat = i / kn, rem = i - mat * kn, n = rem / K, k = rem - n * K;
        dst[i] = f2bf(src[((size_t)mat * K + k) * N + n]);
    }
}
PH void unpack8(const pg8::u32x4 w, float (&f)[8]) { f[0] = bflo(w.x); f[1] = bfhi(w.x); f[2] = bflo(w.y); f[3] = bfhi(w.y); f[4] = bflo(w.z); f[5] = bfhi(w.z); f[6] = bflo(w.w); f[7] = bfhi(w.w); }
PH pg8::u32x4 pack8(const float (&f)[8]) { pg8::u32x4 w; w.x = pg8::cvt_pk_bf16(f[0], f[1]); w.y = pg8::cvt_pk_bf16(f[2], f[3]); w.z = pg8::cvt_pk_bf16(f[4], f[5]); w.w = pg8::cvt_pk_bf16(f[6], f[7]); return w; }
constexpr int OP_LP = 848, OP_TOK = 144;
template <int KS, int NT0, int NTN>
PH void oddprep_seg(LAS unsigned char* Lt, const bf16_t* Wt, int Kw, int koff, const float* bias, float sc, bool sig, bf16_t* outp, int t0, int wid, int fr, int fq) {
    pg8::bf16x8 wf[NTN][KS];
#pragma unroll
    for (int nt = 0; nt < NTN; ++nt)
#pragma unroll
        for (int ks = 0; ks < KS; ++ks) wf[nt][ks] = *(const pg8::bf16x8*)(Wt + (size_t)(96 * wid + 16 * NT0 + 32 * (nt >> 1) + 8 * (fr >> 2) + 4 * (nt & 1) + (fr & 3)) * Kw + 32 * ks + 8 * fq);
    pg8::f32x4 bv[NTN];
#pragma unroll
    for (int nt = 0; nt < NTN; ++nt) bv[nt] = bias ? *(const pg8::f32x4*)(bias + 96 * wid + 16 * NT0 + 32 * (nt >> 1) + 8 * fq + 4 * (nt & 1)) : (pg8::f32x4){0.f, 0.f, 0.f, 0.f};
#pragma unroll 1
    for (int mt = 0; mt < OP_TOK / 16; ++mt) {
        pg8::bf16x8 lf[KS];
#pragma unroll
        for (int ks = 0; ks < KS; ++ks) lf[ks] = *(const LAS pg8::bf16x8*)(Lt + (16 * mt + fr) * OP_LP + (koff + 32 * ks + 8 * fq) * 2);
#pragma unroll
        for (int np = 0; np < NTN / 2; ++np) {
            pg8::f32x4 v[2];
#pragma unroll
            for (int hh = 0; hh < 2; ++hh) {
                pg8::f32x4 acc = (pg8::f32x4){0.f, 0.f, 0.f, 0.f};
#pragma unroll
                for (int ks = 0; ks < KS; ++ks) acc = __builtin_amdgcn_mfma_f32_16x16x32_bf16(wf[2 * np + hh][ks], lf[ks], acc, 0, 0, 0);
                v[hh] = acc + bv[2 * np + hh];
                if (sig) {
#pragma unroll
                    for (int q = 0; q < 4; ++q) v[hh][q] = sc * __builtin_amdgcn_rcpf(1.f + __builtin_amdgcn_exp2f(-1.4426950408889634f * v[hh][q])); }
            }
            pg8::u32x4 o; o.x = pg8::cvt_pk_bf16(v[0][0], v[0][1]); o.y = pg8::cvt_pk_bf16(v[0][2], v[0][3]); o.z = pg8::cvt_pk_bf16(v[1][0], v[1][1]); o.w = pg8::cvt_pk_bf16(v[1][2], v[1][3]);
            *(pg8::u32x4*)(outp + (size_t)(t0 + 16 * mt + fr) * RW + 96 * wid + 16 * NT0 + 32 * np + 8 * fq) = o;
        }
    }
}
PH void ph_oddprep(LAS unsigned char* lsm, const bf16_t* px, const OddW& w, const bf16_t* w2t, const bf16_t* a2t, const bf16_t* g2t, const ScanIn& si) {
    LAS unsigned char* Lt = lsm + STAGE_OFF;
    const int tid = TID(), lane = tid & 63, wid = __builtin_amdgcn_readfirstlane(tid >> 6), fr = lane & 15, fq = lane >> 4;
    for (int unit = BID(); unit < NT / OP_TOK; unit += GDIM()) {
        const int t0 = unit * OP_TOK;
        __syncthreads();
        const int tbase = t0 + wid * (OP_TOK / 8);
#pragma unroll 1
        for (int it = 0; it < 6; ++it) {
            const int idx = it * 64 + lane; const bool act = idx < 340; const int col0 = (act ? idx : 339) * 8;
            const float4 m0a = *(const float4*)(w.mu + col0), m0b = *(const float4*)(w.mu + col0 + 4), m1a = *(const float4*)(w.mu + 2720 + col0), m1b = *(const float4*)(w.mu + 2720 + col0 + 4);
            const float mu0[8] = {m0a.x, m0a.y, m0a.z, m0a.w, m0b.x, m0b.y, m0b.z, m0b.w}, mu1[8] = {m1a.x, m1a.y, m1a.z, m1a.w, m1b.x, m1b.y, m1b.z, m1b.w};
#pragma unroll 1
            for (int hf = 0; hf < 2; ++hf) {
            pg8::u32x4 rw[OP_TOK / 16 + 2];
#pragma unroll
            for (int j = 0; j < OP_TOK / 16 + 2; ++j) { int rr = tbase + hf * (OP_TOK / 16) - 1 + j; rr = rr < 0 ? 0 : (rr > NT - 1 ? NT - 1 : rr); rw[j] = *(const pg8::u32x4*)(px + (size_t)rr * 3072 + col0); }
#pragma unroll
            for (int tl = 0; tl < OP_TOK / 16; ++tl) {
                const int tloc = wid * (OP_TOK / 8) + hf * (OP_TOK / 16) + tl, r = t0 + tloc; int s0, len, t; seq_info(r, s0, len, t);
                const float fpv = t > 0 ? 1.f : 0.f, fnx = t < len - 1 ? 1.f : 0.f;
                float u[8], pv[8], nx[8], f[8];
                unpack8(rw[tl + 1], u); unpack8(rw[tl], pv); unpack8(rw[tl + 2], nx);
#pragma unroll
                for (int q = 0; q < 8; ++q) f[q] = u[q] + mu0[q] * (pv[q] * fpv - u[q]) + mu1[q] * (nx[q] * fnx - u[q]);
                if (col0 < 768) { *(pg8::u32x4*)(si.R + (size_t)r * RW + col0) = pack8(f); }
                else if (col0 < 1536) { const int c = col0 - 768;
                    *(pg8::u32x4*)(si.K + (size_t)r * RW + c) = pack8(f); }
                else if (col0 < 2304) { *(pg8::u32x4*)(si.V + (size_t)r * RW + col0 - 1536) = pack8(f); }
                else if (act) { const int jj = col0 - 2304;
                    if (jj < 128) { for (int q = 0; q < 8; ++q) f[q] = 1.f - 2.f * __builtin_amdgcn_rcpf(1.f + __builtin_amdgcn_exp2f(2.8853900817779268f * f[q])); }
                    else if (jj >= 256) { for (int q = 0; q < 8; ++q) f[q] = __builtin_amdgcn_rcpf(1.f + __builtin_amdgcn_exp2f(-1.4426950408889634f * f[q])); }
                    *(LAS pg8::u32x4*)(Lt + tloc * OP_LP + jj * 2) = pack8(f); }
            }
            }
        }
        __syncthreads();
        SUBSTAMP_L(lsm, 27);
        oddprep_seg<2, 0, 6>(Lt, w2t, 64, 0, w.w0, 0.6065306597126334f, true, si.X[0], t0, wid, fr, fq);
        oddprep_seg<2, 0, 6>(Lt, w2t + (size_t)768 * 64, 64, 64, w.w0 + 768, 0.6065306597126334f, true, si.X[1], t0, wid, fr, fq);
        oddprep_seg<2, 0, 6>(Lt, a2t, 64, 128, w.a0, 1.f, true, si.A[0], t0, wid, fr, fq);
        oddprep_seg<2, 0, 6>(Lt, a2t + (size_t)768 * 64, 64, 192, w.a0 + 768, 1.f, true, si.A[1], t0, wid, fr, fq);
        oddprep_seg<5, 0, 2>(Lt, g2t, 160, 256, nullptr, 1.f, false, si.G, t0, wid, fr, fq);
        oddprep_seg<5, 2, 2>(Lt, g2t, 160, 256, nullptr, 1.f, false, si.G, t0, wid, fr, fq);
        oddprep_seg<5, 4, 2>(Lt, g2t, 160, 256, nullptr, 1.f, false, si.G, t0, wid, fr, fq);
    }
    __syncthreads();
}
PH float quad_sum(float v) {
    v += __builtin_bit_cast(float, __builtin_amdgcn_update_dpp(0, __builtin_bit_cast(int, v), 0xB1, 0xF, 0xF, true));
    v += __builtin_bit_cast(float, __builtin_amdgcn_update_dpp(0, __builtin_bit_cast(int, v), 0x4E, 0xF, 0xF, true));
    return v;
}

constexpr int RS_WAVES = NB * 12 * 2 * 2, RS_BLOCKS = RS_WAVES / 4;
PH void ph_scan_rs(LAS unsigned char* lsm, const ScanIn& si, const float* k_a) {
    const int tid = TID(), lane = tid & 63, wib = tid >> 6, gw = BID() * 4 + wib;
    if (wib >= 4 || gw >= RS_WAVES) return;
    LAS float* sh = (LAS float*)(lsm + STAGE_OFF + wib * 12288);
    const int chain = gw >> 1, hw = gw & 1, dir = chain & 1, bh = chain >> 1, b = bh / 12, hh = bh % 12, cb = lane & 3, r = lane >> 2, row0 = 32 * hw + r;
    const int sl = lane >> 4, cq = lane & 15;
    const bf16_t* Xd = si.X[dir]; const bf16_t* Ad = si.A[dir]; float* Y = si.Y[dir];
    const pg8::f32x4 ka4 = *(const pg8::f32x4*)(k_a + hh * 64 + 4 * cq);
    const int N = CTX + SEQ, NG = N / 4;
    auto tok_of = [&](int s) { int tk; if (s < CTX) { const int tt = dir ? CTX - 1 - s : s; tk = NX + b * CTX + tt; } else { int tt = s - CTX; tt = dir ? SEQ - 1 - tt : tt; tk = b * SEQ + tt; } return tk; };
    struct Raw { pg8::u32x2 x, a, k, kk, r, v; };
    auto gload = [&](int g, Raw& q) { g = g < NG ? g : NG - 1; const size_t off = (size_t)tok_of(4 * g + sl) * RW + hh * 64 + 4 * cq;
        q.x = *(const pg8::u32x2*)(Xd + off); q.a = *(const pg8::u32x2*)(Ad + off); q.k = *(const pg8::u32x2*)(si.K + off);
        q.kk = *(const pg8::u32x2*)(si.KK + off); q.r = *(const pg8::u32x2*)(si.R + off); q.v = *(const pg8::u32x2*)(si.V + off); };
    auto stage = [&](int gp, const Raw& q) { LAS float* d = sh + (gp * 4 + sl) * 384 + 4 * cq;
        const pg8::f32x4 x = (pg8::f32x4){bflo(q.x.x), bfhi(q.x.x), bflo(q.x.y), bfhi(q.x.y)}, a = (pg8::f32x4){bflo(q.a.x), bfhi(q.a.x), bflo(q.a.y), bfhi(q.a.y)};
        const pg8::f32x4 k = (pg8::f32x4){bflo(q.k.x), bfhi(q.k.x), bflo(q.k.y), bfhi(q.k.y)}, kk = (pg8::f32x4){bflo(q.kk.x), bfhi(q.kk.x), bflo(q.kk.y), bfhi(q.kk.y)};
        pg8::f32x4 w;
#pragma unroll
        for (int i = 0; i < 4; ++i) w[i] = __builtin_amdgcn_exp2f(-x[i] * 1.4426950408889634f);
        *(LAS pg8::f32x4*)(d) = w; *(LAS pg8::f32x4*)(d + 64) = k * ((a - 1.f) * ka4 + 1.f); *(LAS pg8::f32x4*)(d + 128) = kk * a; *(LAS pg8::f32x4*)(d + 192) = kk;
        *(LAS pg8::f32x4*)(d + 256) = (pg8::f32x4){bflo(q.r.x), bfhi(q.r.x), bflo(q.r.y), bfhi(q.r.y)}; *(LAS pg8::f32x4*)(d + 320) = (pg8::f32x4){bflo(q.v.x), bfhi(q.v.x), bflo(q.v.y), bfhi(q.v.y)}; };
    typedef float f32x2 __attribute__((ext_vector_type(2)));
    f32x2 Sa[8], Sb[8];
#pragma unroll
    for (int c = 0; c < 8; ++c) { Sa[c] = (f32x2){0.f, 0.f}; Sb[c] = (f32x2){0.f, 0.f}; }
    f32x2 kq[8]; float va, vb;
    auto pre_kk = [&](int rec) { const LAS float* d = sh + rec * 384;
#pragma unroll
        for (int c4 = 0; c4 < 4; ++c4) { const pg8::f32x4 t = *(const LAS pg8::f32x4*)(d + 192 + 16 * cb + 4 * c4); kq[2 * c4] = (f32x2){t[0], t[1]}; kq[2 * c4 + 1] = (f32x2){t[2], t[3]}; }
        va = d[320 + row0]; vb = d[320 + row0 + 16]; };
    auto step = [&](int s, int rec, int nrec) {
        const LAS float* d = sh + rec * 384 + 16 * cb;
        f32x2 wv[8], kd[8], bb[8], rr[8];
#pragma unroll
        for (int c4 = 0; c4 < 4; ++c4) {
            const pg8::f32x4 t0 = *(const LAS pg8::f32x4*)(d + 4 * c4), t1 = *(const LAS pg8::f32x4*)(d + 64 + 4 * c4), t2 = *(const LAS pg8::f32x4*)(d + 128 + 4 * c4), t4 = *(const LAS pg8::f32x4*)(d + 256 + 4 * c4);
            wv[2 * c4] = (f32x2){t0[0], t0[1]}; wv[2 * c4 + 1] = (f32x2){t0[2], t0[3]}; kd[2 * c4] = (f32x2){t1[0], t1[1]}; kd[2 * c4 + 1] = (f32x2){t1[2], t1[3]};
            bb[2 * c4] = (f32x2){t2[0], t2[1]}; bb[2 * c4 + 1] = (f32x2){t2[2], t2[3]}; rr[2 * c4] = (f32x2){t4[0], t4[1]}; rr[2 * c4 + 1] = (f32x2){t4[2], t4[3]};
        }
        f32x2 pa = (f32x2){0.f, 0.f}, pb = (f32x2){0.f, 0.f}, qa = (f32x2){0.f, 0.f}, qb = (f32x2){0.f, 0.f};
#pragma unroll
        for (int c = 0; c < 8; c += 2) { pa = __builtin_elementwise_fma(Sa[c], kq[c], pa); qa = __builtin_elementwise_fma(Sa[c + 1], kq[c + 1], qa);
                                         pb = __builtin_elementwise_fma(Sb[c], kq[c], pb); qb = __builtin_elementwise_fma(Sb[c + 1], kq[c + 1], qb); }
        const f32x2 sas = pa + qa, sbs = pb + qb;
        const float nsa = -quad_sum(sas.x + sas.y), nsb = -quad_sum(sbs.x + sbs.y);
        const f32x2 nsa2 = (f32x2){nsa, nsa}, nsb2 = (f32x2){nsb, nsb}, va2 = (f32x2){va, va}, vb2 = (f32x2){vb, vb};
        pre_kk(nrec);
        f32x2 ya = (f32x2){0.f, 0.f}, yb = (f32x2){0.f, 0.f};
#pragma unroll
        for (int c = 0; c < 8; ++c) {
            Sa[c] = __builtin_elementwise_fma(Sa[c], wv[c], __builtin_elementwise_fma(va2, kd[c], nsa2 * bb[c]));
            Sb[c] = __builtin_elementwise_fma(Sb[c], wv[c], __builtin_elementwise_fma(vb2, kd[c], nsb2 * bb[c]));
            ya = __builtin_elementwise_fma(Sa[c], rr[c], ya); yb = __builtin_elementwise_fma(Sb[c], rr[c], yb);
        }
        const float y_a = quad_sum(ya.x + ya.y), y_b = quad_sum(yb.x + yb.y);
        if (cb < 2) Y[(size_t)tok_of(s) * RW + hh * 64 + row0 + 16 * cb] = cb ? y_b : y_a;
    };
    Raw ra, rb;
    gload(0, ra); stage(0, ra); gload(1, ra); gload(2, rb);
    __builtin_amdgcn_wave_barrier();
    pre_kk(0);
#pragma unroll 1
    for (int g = 0; g < NG; g += 2) {
        __builtin_amdgcn_wave_barrier();
        stage(1, ra); gload(g + 3, ra);
        __builtin_amdgcn_wave_barrier();
        step(4 * g, 0, 1); step(4 * g + 1, 1, 2); step(4 * g + 2, 2, 3); step(4 * g + 3, 3, 4);
        __builtin_amdgcn_wave_barrier();
        stage(0, rb); gload(g + 4, rb);
        __builtin_amdgcn_wave_barrier();
        step(4 * g + 4, 4, 5); step(4 * g + 5, 5, 6); step(4 * g + 6, 6, 7); step(4 * g + 7, 7, 0);
    }
}

constexpr int MM_WAVES = NB * 12 * 2 * 4, MM_BLOCKS = MM_WAVES / NWAVE;
constexpr int MM_P64 = 144, MM_P16 = 40;
constexpr int MM_KH = 0, MM_RH = 2304, MM_KB = 4608, MM_BB = 6912, MM_S16 = 9216, MM_V = 11520, MM_T = 12160, MM_AKK = 12800, MM_AKR = 13440, MM_ABR = 14080, MM_ABK = 14720, MM_GL = 15744, MM_WAVE = 16384;
static_assert(MM_ABK + 1024 <= MM_GL && MM_GL + 256 <= MM_WAVE, "chunk-scan LDS map");
PH pg8::bf16x8 frag4(s16x4 v) { const s16x4 z = (s16x4){0, 0, 0, 0}; return __builtin_shufflevector(v, z, 0, 1, 2, 3, 4, 5, 6, 7); }
PH int wave_dequeue(unsigned* ctr) {
    int t = 0;
    if ((TID() & 63) == 0) t = (int)__hip_atomic_fetch_add(ctr, 1u, __ATOMIC_RELAXED, __HIP_MEMORY_SCOPE_AGENT);
    return __builtin_amdgcn_readfirstlane(t);
}
constexpr int CR_KH = 0, CR_RH = 2048, CR_KB = 4096, CR_BB = 6144, CR_T = 8192, CR_AKK = 8704, CR_AKR = 9216, CR_ABR = 9728, CR_V = 10240, CR_GL = 12288, CR_BYTES = 12544;
constexpr int NCHUNK = (CTX + SEQ) / 16, NCHAINS = NB * 12 * 2;
constexpr int MM_VQ = 11520;
PH void scan_prep_task(LAS unsigned char* L, const ScanIn& si, const float* k_a, const float* k_k, unsigned char* rec, int chain, int c) {
    const int lane = TID() & 63, fr = lane & 15, fq = lane >> 4, sl = fq, cq = fr, trq = fr >> 2, trp = fr & 3;
    const int dir = chain & 1, bh = chain >> 1, b = bh / 12, hh = bh % 12;
    const bf16_t* Xd = si.X[dir]; const bf16_t* Ad = si.A[dir];
    const pg8::f32x4 ka4 = *(const pg8::f32x4*)(k_a + hh * 64 + 4 * cq), kk4 = *(const pg8::f32x4*)(k_k + hh * 64 + 4 * cq);
    auto tok_of = [&](int s) { int tk; if (s < CTX) { const int tt = dir ? CTX - 1 - s : s; tk = NX + b * CTX + tt; } else { int tt = s - CTX; tt = dir ? SEQ - 1 - tt : tt; tk = b * SEQ + tt; } return tk; };
    auto up4 = [](pg8::u32x2 w) { return (pg8::f32x4){bflo(w.x), bfhi(w.x), bflo(w.y), bfhi(w.y)}; };
    auto pk4 = [](pg8::f32x4 v) { pg8::u32x2 o; o.x = pg8::cvt_pk_bf16(v[0], v[1]); o.y = pg8::cvt_pk_bf16(v[2], v[3]); return o; };
    pg8::u32x2 rx[4], ra[4], rk[4], rr[4];
#pragma unroll
    for (int g4 = 0; g4 < 4; ++g4) { const size_t off = (size_t)tok_of(16 * c + 4 * g4 + sl) * RW + hh * 64 + 4 * cq;
        rx[g4] = *(const pg8::u32x2*)(Xd + off); ra[g4] = *(const pg8::u32x2*)(Ad + off); rk[g4] = *(const pg8::u32x2*)(si.K + off); rr[g4] = *(const pg8::u32x2*)(si.R + off); }
    pg8::f32x4 base = (pg8::f32x4){0.f, 0.f, 0.f, 0.f};
    __builtin_amdgcn_wave_barrier();
#pragma unroll
    for (int g4 = 0; g4 < 4; ++g4) {
        const pg8::f32x4 x = up4(rx[g4]), a = up4(ra[g4]), k = up4(rk[g4]), r = up4(rr[g4]);
        pg8::f32x4 kk = k * kk4;
        { float ss = kk[0] * kk[0] + kk[1] * kk[1] + kk[2] * kk[2] + kk[3] * kk[3];
          ss += __shfl_xor(ss, 1); ss += __shfl_xor(ss, 2); ss += __shfl_xor(ss, 4); ss += __shfl_xor(ss, 8);
          kk = kk * (1.f / fmaxf(sqrtf(ss), 1e-12f)); }
        pg8::f32x4 inc = x;
#pragma unroll
        for (int e = 0; e < 4; ++e) { const float y1 = __shfl_up(inc[e], 16); inc[e] += sl >= 1 ? y1 : 0.f; }
#pragma unroll
        for (int e = 0; e < 4; ++e) { const float y2 = __shfl_up(inc[e], 32); inc[e] += sl >= 2 ? y2 : 0.f; }
        const pg8::f32x4 cx = base + inc, cxm = cx - x;
#pragma unroll
        for (int e = 0; e < 4; ++e) base[e] += __shfl(inc[e], 48 + cq);
        pg8::f32x4 g, gm, gi;
#pragma unroll
        for (int e = 0; e < 4; ++e) { g[e] = __builtin_amdgcn_exp2f(-1.4426950408889634f * cx[e]); gm[e] = __builtin_amdgcn_exp2f(-1.4426950408889634f * cxm[e]); gi[e] = __builtin_amdgcn_exp2f(1.4426950408889634f * cx[e]); }
        const pg8::f32x4 kd = k * ((a - 1.f) * ka4 + 1.f), bb = kk * a;
        const int t = 4 * g4 + sl;
        const pg8::u32x2 okh = pk4(kk * gm), orh = pk4(r * g);
        *(LAS pg8::u32x2*)(L + MM_KH + t * MM_P64 + 8 * cq) = okh; *(LAS pg8::u32x2*)(L + MM_RH + t * MM_P64 + 8 * cq) = orh;
        *(pg8::u32x2*)(rec + CR_KH + t * 128 + 8 * cq) = okh; *(pg8::u32x2*)(rec + CR_RH + t * 128 + 8 * cq) = orh;
        *(LAS pg8::u32x2*)(L + MM_KB + t * MM_P64 + 8 * cq) = pk4(kd * gi);
        *(LAS pg8::u32x2*)(L + MM_BB + t * MM_P64 + 8 * cq) = pk4(bb * gi);
        if (g4 == 3 && sl == 3) *(pg8::f32x4*)(rec + CR_GL + 16 * cq) = g;
    }
    __builtin_amdgcn_wave_barrier();
    pg8::bf16x8 khf[2], rhf[2], kbf[2], bbf[2];
#pragma unroll
    for (int ks = 0; ks < 2; ++ks) { const int o = fr * MM_P64 + (8 * fq + 32 * ks) * 2;
        khf[ks] = *(const LAS pg8::bf16x8*)(L + MM_KH + o); rhf[ks] = *(const LAS pg8::bf16x8*)(L + MM_RH + o); kbf[ks] = *(const LAS pg8::bf16x8*)(L + MM_KB + o); bbf[ks] = *(const LAS pg8::bf16x8*)(L + MM_BB + o); }
#pragma unroll
    for (int nt = 0; nt < 4; ++nt) {
        *(s16x4*)(rec + CR_KB + nt * 512 + lane * 8) = __builtin_amdgcn_ds_read_tr16_b64_v4i16((LAS s16x4*)(L + MM_KB + (4 * fq + trq) * MM_P64 + (16 * nt + 4 * trp) * 2));
        *(s16x4*)(rec + CR_BB + nt * 512 + lane * 8) = __builtin_amdgcn_ds_read_tr16_b64_v4i16((LAS s16x4*)(L + MM_BB + (4 * fq + trq) * MM_P64 + (16 * nt + 4 * trp) * 2));
    }
    const pg8::f32x4 z4 = (pg8::f32x4){0.f, 0.f, 0.f, 0.f};
    pg8::f32x4 gkk = z4, gbk = z4, gkr = z4, gbr = z4;
#pragma unroll
    for (int ks = 0; ks < 2; ++ks) { gkk = __builtin_amdgcn_mfma_f32_16x16x32_bf16(khf[ks], kbf[ks], gkk, 0, 0, 0); gbk = __builtin_amdgcn_mfma_f32_16x16x32_bf16(khf[ks], bbf[ks], gbk, 0, 0, 0);
                                     gkr = __builtin_amdgcn_mfma_f32_16x16x32_bf16(rhf[ks], kbf[ks], gkr, 0, 0, 0); gbr = __builtin_amdgcn_mfma_f32_16x16x32_bf16(rhf[ks], bbf[ks], gbr, 0, 0, 0); }
    __builtin_amdgcn_wave_barrier();
#pragma unroll
    for (int rg = 0; rg < 4; ++rg) { const int t = 4 * fq + rg; const bool lo = fr < t, le = fr <= t;
        *(LAS float*)(L + MM_ABK + t * 64 + fr * 4) = lo ? gbk[rg] : 0.f;
        *(LAS unsigned short*)(L + MM_AKK + t * MM_P16 + fr * 2) = f2bf(lo ? gkk[rg] : 0.f);
        *(LAS unsigned short*)(L + MM_AKR + t * MM_P16 + fr * 2) = f2bf(le ? gkr[rg] : 0.f);
        *(LAS unsigned short*)(L + MM_ABR + t * MM_P16 + fr * 2) = f2bf(le ? gbr[rg] : 0.f); }
    __builtin_amdgcn_wave_barrier();
    float Tr[16];
#pragma unroll
    for (int t = 0; t < 16; ++t) {
        float acc = (t == fr) ? 1.f : 0.f;
#pragma unroll
        for (int s4 = 0; s4 < (t + 3) / 4; ++s4) { const pg8::f32x4 ar = *(const LAS pg8::f32x4*)(L + MM_ABK + t * 64 + s4 * 16);
#pragma unroll
            for (int e = 0; e < 4; ++e) if (4 * s4 + e < t) acc -= ar[e] * Tr[4 * s4 + e]; }
        Tr[t] = acc;
    }
#pragma unroll
    for (int rg = 0; rg < 4; ++rg) { const float tv = fq == 0 ? Tr[rg] : fq == 1 ? Tr[4 + rg] : fq == 2 ? Tr[8 + rg] : Tr[12 + rg];
        *(LAS unsigned short*)(L + MM_T + (4 * fq + rg) * MM_P16 + fr * 2) = f2bf(tv); }
    __builtin_amdgcn_wave_barrier();
    *(s16x4*)(rec + CR_T + lane * 8) = *(const LAS s16x4*)(L + MM_T + fr * MM_P16 + 8 * fq);
    *(s16x4*)(rec + CR_AKK + lane * 8) = *(const LAS s16x4*)(L + MM_AKK + fr * MM_P16 + 8 * fq);
    *(s16x4*)(rec + CR_AKR + lane * 8) = *(const LAS s16x4*)(L + MM_AKR + fr * MM_P16 + 8 * fq);
    *(s16x4*)(rec + CR_ABR + lane * 8) = *(const LAS s16x4*)(L + MM_ABR + fr * MM_P16 + 8 * fq);
    __builtin_amdgcn_wave_barrier();
}
PH void ph_scan_prep(LAS unsigned char* lsm, const ScanIn& si, const float* k_a, const float* k_k, unsigned char* recs, unsigned* ctr) {
    LAS unsigned char* L = lsm + STAGE_OFF + (TID() >> 6) * MM_WAVE;
    constexpr int BATCH = 8;
    for (;;) {
        const int t0 = wave_dequeue(ctr) * BATCH;
        if (t0 >= NCHAINS * NCHUNK) break;
#pragma unroll 1
        for (int t = t0; t < t0 + BATCH; ++t) { const int chain = t / NCHUNK, c = t % NCHUNK; scan_prep_task(L, si, k_a, k_k, recs + (size_t)t * CR_BYTES, chain, c); }
    }
}
PH void ph_scan_seq(LAS unsigned char* lsm, const unsigned char* recs, float* const* Yd, const bf16_t* Vg) {
    const int tid = TID(), lane = tid & 63, wib = tid >> 6, gw = BID() * 3 + wib, chain = gw >> 1, q0 = (gw & 1) * 2;
    if (wib >= 3 || gw >= NCHAINS * 2) return;
    LAS unsigned char* S16 = lsm + STAGE_OFF + wib * (2 * 2304);
    LAS unsigned char* VQ = lsm + STAGE_OFF + 3 * (2 * 2304) + wib * 1280;
    const int dir = chain & 1, bh = chain >> 1, b = bh / 12, hh = bh % 12, fr = lane & 15, fq = lane >> 4, trq = fr >> 2, trp = fr & 3;
    float* Y = Yd[dir];
    auto tok_of = [&](int s) { int tk; if (s < CTX) { const int tt = dir ? CTX - 1 - s : s; tk = NX + b * CTX + tt; } else { int tt = s - CTX; tt = dir ? SEQ - 1 - tt : tt; tk = b * SEQ + tt; } return tk; };
    struct Ops { pg8::bf16x8 kh[2], rh[2]; s16x4 kb[4], bb[4], tf, akk, akr, abr; pg8::u32x2 vraw[2]; float gl[4]; };
    auto oload = [&](int c, Ops& o) { c = c < NCHUNK ? c : NCHUNK - 1; const unsigned char* rec = recs + ((size_t)chain * NCHUNK + c) * CR_BYTES;
#pragma unroll
        for (int ks = 0; ks < 2; ++ks) { o.kh[ks] = *(const pg8::bf16x8*)(rec + CR_KH + fr * 128 + (8 * fq + 32 * ks) * 2); o.rh[ks] = *(const pg8::bf16x8*)(rec + CR_RH + fr * 128 + (8 * fq + 32 * ks) * 2); }
#pragma unroll
        for (int nt = 0; nt < 4; ++nt) { o.kb[nt] = *(const s16x4*)(rec + CR_KB + nt * 512 + lane * 8); o.bb[nt] = *(const s16x4*)(rec + CR_BB + nt * 512 + lane * 8); o.gl[nt] = *(const float*)(rec + CR_GL + (16 * nt + fr) * 4);
            if (nt < 2) o.vraw[nt] = *(const pg8::u32x2*)(Vg + (size_t)tok_of(16 * c + (lane >> 2)) * RW + hh * 64 + 16 * (q0 + nt) + 4 * (lane & 3)); }
        o.tf = *(const s16x4*)(rec + CR_T + lane * 8); o.akk = *(const s16x4*)(rec + CR_AKK + lane * 8); o.akr = *(const s16x4*)(rec + CR_AKR + lane * 8); o.abr = *(const s16x4*)(rec + CR_ABR + lane * 8); };
    pg8::f32x4 Sacc[2][4];
#pragma unroll
    for (int q = 0; q < 2; ++q)
#pragma unroll
        for (int nt = 0; nt < 4; ++nt) Sacc[q][nt] = (pg8::f32x4){0.f, 0.f, 0.f, 0.f};
    const pg8::f32x4 z4 = (pg8::f32x4){0.f, 0.f, 0.f, 0.f};
    auto chunk = [&](int c, const Ops& cur) {
        __builtin_amdgcn_wave_barrier();
#pragma unroll
        for (int q = 0; q < 2; ++q)
#pragma unroll
            for (int nt = 0; nt < 4; ++nt)
#pragma unroll
                for (int rg = 0; rg < 4; rg += 2) { const unsigned pk = pg8::cvt_pk_bf16(Sacc[q][nt][rg], Sacc[q][nt][rg + 1]);
                    *(LAS unsigned short*)(S16 + q * 2304 + (4 * fq + rg) * MM_P64 + (16 * nt + fr) * 2) = (unsigned short)pk;
                    *(LAS unsigned short*)(S16 + q * 2304 + (4 * fq + rg + 1) * MM_P64 + (16 * nt + fr) * 2) = (unsigned short)(pk >> 16); }
#pragma unroll
        for (int q = 0; q < 2; ++q) *(LAS pg8::u32x2*)(VQ + q * 640 + (lane >> 2) * MM_P16 + 8 * (lane & 3)) = cur.vraw[q];
        __builtin_amdgcn_wave_barrier();
        const pg8::bf16x8 akkf = frag4(cur.akk), akrf = frag4(cur.akr), abrf = frag4(cur.abr), tff = frag4(cur.tf);
#pragma unroll
        for (int q = 0; q < 2; ++q) {
            pg8::bf16x8 s16f[2];
#pragma unroll
            for (int ks = 0; ks < 2; ++ks) s16f[ks] = *(const LAS pg8::bf16x8*)(S16 + q * 2304 + fr * MM_P64 + (8 * fq + 32 * ks) * 2);
            const pg8::bf16x8 vfr = frag4(__builtin_amdgcn_ds_read_tr16_b64_v4i16((LAS s16x4*)(VQ + q * 640 + (4 * fq + trq) * MM_P16 + 8 * trp)));
            pg8::f32x4 Wm = z4, Ym = z4;
#pragma unroll
            for (int ks = 0; ks < 2; ++ks) { Wm = __builtin_amdgcn_mfma_f32_16x16x32_bf16(cur.kh[ks], s16f[ks], Wm, 0, 0, 0); Ym = __builtin_amdgcn_mfma_f32_16x16x32_bf16(cur.rh[ks], s16f[ks], Ym, 0, 0, 0); }
            Wm = __builtin_amdgcn_mfma_f32_16x16x32_bf16(akkf, vfr, Wm, 0, 0, 0);
            Ym = __builtin_amdgcn_mfma_f32_16x16x32_bf16(akrf, vfr, Ym, 0, 0, 0);
            pg8::u32x4 wp; wp.x = pg8::cvt_pk_bf16(Wm[0], Wm[1]); wp.y = pg8::cvt_pk_bf16(Wm[2], Wm[3]); wp.z = 0u; wp.w = 0u;
            const pg8::f32x4 Um = __builtin_amdgcn_mfma_f32_16x16x32_bf16(tff, __builtin_bit_cast(pg8::bf16x8, wp), z4, 0, 0, 0);
            pg8::u32x4 up; up.x = pg8::cvt_pk_bf16(-Um[0], -Um[1]); up.y = pg8::cvt_pk_bf16(-Um[2], -Um[3]); up.z = 0u; up.w = 0u;
            const pg8::bf16x8 nuf = __builtin_bit_cast(pg8::bf16x8, up);
            Ym = __builtin_amdgcn_mfma_f32_16x16x32_bf16(abrf, nuf, Ym, 0, 0, 0);
#pragma unroll
            for (int rg = 0; rg < 4; ++rg) ((bf16_t*)Y)[(size_t)tok_of(16 * c + 4 * fq + rg) * RW + hh * 64 + 16 * (q0 + q) + fr] = f2bf(Ym[rg]);
#pragma unroll
            for (int nt = 0; nt < 4; ++nt) {
                Sacc[q][nt] = __builtin_amdgcn_mfma_f32_16x16x32_bf16(vfr, frag4(cur.kb[nt]), Sacc[q][nt], 0, 0, 0);
                Sacc[q][nt] = __builtin_amdgcn_mfma_f32_16x16x32_bf16(nuf, frag4(cur.bb[nt]), Sacc[q][nt], 0, 0, 0);
                Sacc[q][nt] = Sacc[q][nt] * cur.gl[nt];
            }
        }
    };
    Ops oa, ob;
    oload(0, oa);
#pragma unroll 1
    for (int c = 0; c < NCHUNK; c += 2) {
        oload(c + 1, ob); chunk(c, oa);
        oload(c + 2, oa); chunk(c + 1, ob);
    }
}
PH void ph_readout2(const ScanIn& si, const OddW& w, bf16_t* mix) {
    const int lane = TID() & 63, wave = (BID() * NTHR + TID()) >> 6, nw = GDIM() * NWAVE;
    for (int task = wave; task < NT / 2; task += nw) {
        pg8::u32x4 raw[3][8];
#pragma unroll
        for (int it = 0; it < 3; ++it) {
            const int idx = it * 64 + lane, r = task * 2 + idx / 96, c0 = (idx % 96) * 8;
            const size_t o = (size_t)r * RW + c0;
            raw[it][0] = *(const pg8::u32x4*)((const bf16_t*)si.Y[0] + o); raw[it][1] = *(const pg8::u32x4*)((const bf16_t*)si.Y[1] + o);
            raw[it][2] = *(const pg8::u32x4*)(si.K + o); raw[it][3] = *(const pg8::u32x4*)(si.A[0] + o); raw[it][4] = *(const pg8::u32x4*)(si.A[1] + o);
            raw[it][5] = *(const pg8::u32x4*)(si.R + o); raw[it][6] = *(const pg8::u32x4*)(si.V + o); raw[it][7] = *(const pg8::u32x4*)(si.G + o);
        }
#pragma unroll
        for (int it = 0; it < 3; ++it) {
            const int idx = it * 64 + lane, r = task * 2 + idx / 96, c0 = (idx % 96) * 8;
            float yf[8], yb8[8];
            unpack8(raw[it][0], yf); unpack8(raw[it][1], yb8);
            float y[8] = {yf[0] + yb8[0], yf[1] + yb8[1], yf[2] + yb8[2], yf[3] + yb8[3], yf[4] + yb8[4], yf[5] + yb8[5], yf[6] + yb8[6], yf[7] + yb8[7]};
            float kf[8], a0[8], a1[8], rf[8], vf[8], gf[8];
            unpack8(raw[it][2], kf); unpack8(raw[it][3], a0); unpack8(raw[it][4], a1);
            unpack8(raw[it][5], rf); unpack8(raw[it][6], vf); unpack8(raw[it][7], gf);
            float sm = 0.f;
#pragma unroll
            for (int q = 0; q < 8; ++q) sm += y[q];
            sm += __shfl_xor(sm, 1); sm += __shfl_xor(sm, 2); sm += __shfl_xor(sm, 4);
            const float mean = sm * (1.f / 64.f);
            float vs = 0.f;
#pragma unroll
            for (int q = 0; q < 8; ++q) { y[q] -= mean; vs += y[q] * y[q]; }
            vs += __shfl_xor(vs, 1); vs += __shfl_xor(vs, 2); vs += __shfl_xor(vs, 4);
            const float rstd = rsqrtf(vs * (1.f / 64.f) + 64e-5f);
            const float4 kaa = *(const float4*)(w.k_a + c0), kab = *(const float4*)(w.k_a + c0 + 4), rka = *(const float4*)(w.r_k + c0), rkb = *(const float4*)(w.r_k + c0 + 4);
            const float4 gga = *(const float4*)(w.gn_g + c0), ggb = *(const float4*)(w.gn_g + c0 + 4), gba = *(const float4*)(w.gn_b + c0), gbb = *(const float4*)(w.gn_b + c0 + 4);
            const float ka[8] = {kaa.x, kaa.y, kaa.z, kaa.w, kab.x, kab.y, kab.z, kab.w}, rk[8] = {rka.x, rka.y, rka.z, rka.w, rkb.x, rkb.y, rkb.z, rkb.w};
            const float gg[8] = {gga.x, gga.y, gga.z, gga.w, ggb.x, ggb.y, ggb.z, ggb.w}, gb[8] = {gba.x, gba.y, gba.z, gba.w, gbb.x, gbb.y, gbb.z, gbb.w};
            float cf = 0.f;
#pragma unroll
            for (int q = 0; q < 8; ++q) cf += rf[q] * (kf[q] * (2.f + (a0[q] + a1[q] - 2.f) * ka[q])) * rk[q];
            cf += __shfl_xor(cf, 1); cf += __shfl_xor(cf, 2); cf += __shfl_xor(cf, 4);
            float out[8];
#pragma unroll
            for (int q = 0; q < 8; ++q) out[q] = (y[q] * rstd * gg[q] + gb[q] + cf * vf[q]) * gf[q];
            *(pg8::u32x4*)(mix + (size_t)r * D + c0) = pack8(out);
        }
    }
}
PH void ph_convT(LAS unsigned char* L, const float* src, bf16_t* dst, int K, int N, int Npad, int nmat) {
    const int blk = BID(), nblk = GDIM();
    const int tid = TID(), wid = __builtin_amdgcn_readfirstlane(tid >> 6), lane = tid & 63, kt_n = K / 64, nt_n = Npad / 128, per = kt_n * nt_n; const int nunits = nmat * per;
    auto issue = [&](int u, int buf) {
        u = u < nunits ? u : nunits - 1;
        const int mat = u / per, rem = u % per, kt = rem / nt_n, ntl = rem % nt_n, k0 = kt * 64, n0 = ntl * 128;
        const float* sm = src + (size_t)mat * K * N + (size_t)k0 * N;
#pragma unroll
        for (int i = 0; i < 4; ++i) { const int q = wid * 4 + i, k = 2 * q + (lane >> 5); int nn = n0 + (((lane & 31) ^ (k >> 3)) << 2); nn = nn < N ? nn : N - 4;
            __builtin_amdgcn_global_load_lds((const unsigned*)(sm + (size_t)k * N + nn), (LAS unsigned*)(L + buf * 32768 + q * 1024), 16, 0, 0); } };
    __syncthreads();
    const int chunk = (nunits + nblk - 1) / nblk, ub = blk * chunk, ue = ub + chunk < nunits ? ub + chunk : nunits;
    issue(ub, 0); issue(ub + 1, 1); issue(ub + 2, 2);
    int buf = 0;
    for (int u = ub; u < ue; ++u) {
        const int mat = u / per, rem = u % per, kt = rem / nt_n, ntl = rem % nt_n, k0 = kt * 64, n0 = ntl * 128;
        bf16_t* dm = dst + (size_t)mat * Npad * K;
        asm volatile("s_waitcnt vmcnt(8)" ::: "memory");
        __builtin_amdgcn_s_barrier();
        asm volatile("" ::: "memory");
        const LAS float* T = (const LAS float*)(L + buf * 32768);
#pragma unroll
        for (int i = 0; i < 2; ++i) {
            const int idx = tid + NTHR * i, n = idx >> 3, l = idx & 7, k8 = l * 8;
            const LAS float* tp = T + k8 * 128 + ((((n >> 2) ^ l) << 2) | (n & 3));
            float f[8];
#pragma unroll
            for (int j = 0; j < 8; ++j) f[j] = tp[j * 128];
            if (n0 + n >= N) {
#pragma unroll
                for (int j = 0; j < 8; ++j) f[j] = 0.f; }
            *(pg8::u32x4*)(dm + (size_t)(n0 + n) * K + k0 + k8) = pack8(f);
        }
        asm volatile("s_waitcnt lgkmcnt(0)" ::: "memory");
        __builtin_amdgcn_s_barrier();
        asm volatile("" ::: "memory");
        issue(u + 3, buf);
        buf = buf == 2 ? 0 : buf + 1;
    }
    asm volatile("s_waitcnt vmcnt(0)" ::: "memory");
    __syncthreads();
}
PH void ph_to_bf16(const float* src, bf16_t* dst, size_t n8) {
    for (size_t i = (size_t)BID() * NTHR + TID(); i < n8; i += (size_t)GDIM() * NTHR) {
        const float4 a = ((const float4*)src)[2 * i], b = ((const float4*)src)[2 * i + 1];
        pg8::u32x4 w; w.x = pg8::cvt_pk_bf16(a.x, a.y); w.y = pg8::cvt_pk_bf16(a.z, a.w); w.z = pg8::cvt_pk_bf16(b.x, b.y); w.w = pg8::cvt_pk_bf16(b.z, b.w);
        ((pg8::u32x4*)dst)[i] = w;
    }
}
PH void ph_moe_init(const MoeBufs& m) {
    const int i = BID() * NTHR + TID();
    if (i < NEXP) m.cnt[i] = 0;
}
PH void ph_router(const float* fx, const float* rw, const float* rb, const MoeBufs& m, int nrows) {
    const int lane = TID() & 63, wave = (BID() * NTHR + TID()) >> 6, nw = GDIM() * NWAVE;
    const int e = lane & 31, half = lane >> 5;
    for (int r = wave; r < nrows; r += nw) {
        const float* xr = fx + (size_t)r * D;
        float acc = 0.f;
        for (int d = half; d < D; d += 2) acc += xr[d] * rw[d * NEXP + e];
        acc += __shfl_xor(acc, 32);
        float logit = acc + rb[e];
        float tv[4]; int ti[4];
#pragma unroll
        for (int k = 0; k < 4; ++k) {
            const float mx = wave_max(logit);
            const unsigned long long bal = __ballot(logit == mx);
            const int sel = (__ffsll((long long)bal) - 1) & 31;
            tv[k] = mx; ti[k] = sel;
            if (e == sel) logit = -INFINITY;
        }
        const float e1 = expf(tv[1] - tv[0]), e2 = expf(tv[2] - tv[0]), e3 = expf(tv[3] - tv[0]);
        const float inv = 1.f / (1.f + e1 + e2 + e3);
        if (lane < 4) {
            const float gk = lane == 0 ? inv : lane == 1 ? e1 * inv : lane == 2 ? e2 * inv : e3 * inv;
            const int ek = lane == 0 ? ti[0] : lane == 1 ? ti[1] : lane == 2 ? ti[2] : ti[3];
            const int pos = atomicAdd(&m.cnt[ek], 1);
            m.tok_e[r * 4 + lane] = ek; m.tok_pos[r * 4 + lane] = pos; m.tok_gate[r * 4 + lane] = gk;
        }
    }
}
PH void ph_router_prep(const float* rw, bf16_t* hi, bf16_t* lo) {
    for (int i = BID() * NTHR + TID(); i < 4 * 32 * 1024; i += GDIM() * NTHR) {
        const int l = i >> 15, e = (i >> 10) & 31, d = i & 1023;
        const float v = rw[((size_t)l * 1024 + d) * 32 + e]; const unsigned short hb = f2bf(v);
        hi[i] = hb; lo[i] = f2bf(v - bf2f(hb));
    }
}
PH void ph_router16(LAS unsigned char* lsm, const bf16_t* fx, const bf16_t* whi, const bf16_t* wlo, const float* rb, const MoeBufs& m, int nrows) {
    const int tid = TID(), lane = tid & 63, wib = tid >> 6, fr = lane & 15, fq = lane >> 4;
    LAS int* lc = (LAS int*)(lsm + STAGE_OFF);
    const int ntask = nrows / 16;
    for (int tb = BID() * NWAVE; tb < ntask; tb += GDIM() * NWAVE) {
        const int task = tb + wib; const bool act = task < ntask;
        const int t0 = (act ? task : 0) * 16;
        __syncthreads();
        if (tid < 32) lc[tid] = 0;
        pg8::f32x4 acc[2] = {(pg8::f32x4){0.f, 0.f, 0.f, 0.f}, (pg8::f32x4){0.f, 0.f, 0.f, 0.f}};
        const bf16_t* xp = fx + (size_t)(t0 + fr) * D + 8 * fq;
        const bf16_t* hp = whi + (size_t)fr * D + 8 * fq; const bf16_t* lp = wlo + (size_t)fr * D + 8 * fq;
#pragma unroll 8
        for (int ks = 0; ks < 32; ++ks) {
            const pg8::bf16x8 xf = *(const pg8::bf16x8*)(xp + 32 * ks);
#pragma unroll
            for (int nt = 0; nt < 2; ++nt) {
                const pg8::bf16x8 wh = *(const pg8::bf16x8*)(hp + (size_t)nt * 16 * D + 32 * ks), wl = *(const pg8::bf16x8*)(lp + (size_t)nt * 16 * D + 32 * ks);
                acc[nt] = __builtin_amdgcn_mfma_f32_16x16x32_bf16(wh, xf, acc[nt], 0, 0, 0);
                acc[nt] = __builtin_amdgcn_mfma_f32_16x16x32_bf16(wl, xf, acc[nt], 0, 0, 0);
            }
        }
        float lg[8];
#pragma unroll
        for (int nt = 0; nt < 2; ++nt) { const pg8::f32x4 bb = *(const pg8::f32x4*)(rb + 16 * nt + 4 * fq);
#pragma unroll
            for (int q = 0; q < 4; ++q) lg[nt * 4 + q] = acc[nt][q] + bb[q]; }
        float tv[4]; int ti[4];
#pragma unroll
        for (int k = 0; k < 4; ++k) {
            float bv = lg[0]; int bi = 4 * fq;
#pragma unroll
            for (int q = 1; q < 8; ++q) { const int e = 16 * (q >> 2) + 4 * fq + (q & 3); if (lg[q] > bv) { bv = lg[q]; bi = e; } }
#pragma unroll
            for (int o = 16; o <= 32; o <<= 1) { const float ov = __shfl_xor(bv, o); const int oi = __shfl_xor(bi, o); if (ov > bv || (ov == bv && oi < bi)) { bv = ov; bi = oi; } }
            tv[k] = bv; ti[k] = bi;
#pragma unroll
            for (int q = 0; q < 8; ++q) { const int e = 16 * (q >> 2) + 4 * fq + (q & 3); if (e == bi) lg[q] = -INFINITY; }
        }
        const float e1 = __expf(tv[1] - tv[0]), e2 = __expf(tv[2] - tv[0]), e3 = __expf(tv[3] - tv[0]);
        const float inv = 1.f / (1.f + e1 + e2 + e3);
        const float gk = fq == 0 ? inv : fq == 1 ? e1 * inv : fq == 2 ? e2 * inv : e3 * inv;
        const int ek = fq == 0 ? ti[0] : fq == 1 ? ti[1] : fq == 2 ? ti[2] : ti[3];
        __syncthreads();
        int lpos = 0;
        if (act) lpos = __hip_atomic_fetch_add(lc + ek, 1, __ATOMIC_RELAXED, __HIP_MEMORY_SCOPE_WORKGROUP);
        __syncthreads();
        if (tid < 32) { const int n = lc[tid]; lc[32 + tid] = n ? atomicAdd(&m.cnt[tid], n) : 0; }
        __syncthreads();
        if (act) { const int r = t0 + fr, pos = lc[32 + ek] + lpos;
            m.tok_e[r * 4 + fq] = ek; m.tok_pos[r * 4 + fq] = pos; m.tok_gate[r * 4 + fq] = gk; }
    }
    __syncthreads();
}
PH void moe_offsets(int* ps, const MoeBufs& m) {
    __syncthreads();
    if (TID() < 64) { const int lane = TID(), e = lane & 31; int v = (m.cnt[e] + 255) / 256 * 256; if (lane >= 32) v = 0;
        int incl = v;
#pragma unroll
        for (int o = 1; o < 32; o <<= 1) { const int t = __shfl_up(incl, o); if (lane >= o) incl += t; }
        if (lane < 32) ps[lane] = incl - v;
        if (lane == 31) ps[NEXP] = incl; }
    __syncthreads();
}
PH int moe_tile_expert(const int* ps, int row) { int e = -1; for (int q = 0; q < NEXP; ++q) if (row >= ps[q] && row < ps[q + 1]) e = q; return e; }
PH void ph_moe_gather(int* ps, const bf16_t* a16, const MoeBufs& m, int nrows) {
    moe_offsets(ps, m);
    const int lane = TID() & 63, wave = (BID() * NTHR + TID()) >> 6, nw = GDIM() * NWAVE;
    for (int r = wave; r < nrows; r += nw) {
        const pg8::u32x4* src = (const pg8::u32x4*)(a16 + (size_t)r * D);
        const pg8::u32x4 v0 = src[lane], v1 = src[lane + 64];
#pragma unroll
        for (int k = 0; k < 4; ++k) {
            const int dest = ps[m.tok_e[r * 4 + k]] + m.tok_pos[r * 4 + k];
            pg8::u32x4* dp = (pg8::u32x4*)(m.Xp + (size_t)dest * D);
            dp[lane] = v0; dp[lane + 64] = v1;
        }
    }
}
PH float swiglu1(float glu, float lin) {
    glu = fminf(glu, 7.f); lin = fminf(fmaxf(lin, -7.f), 7.f);
    const float e = __builtin_amdgcn_exp2f(glu * (-1.702f * 1.4426950408889634f));
    return glu * __builtin_amdgcn_rcpf(1.f + e) * (lin + 1.f);
}
struct MoeOrder : pg8::TileOrder {
    const LAS int* ps;
    __device__ __forceinline__ bool next(int i, pg8::Unit& u) const {
        if (!tile(i, u.pm, u.pn)) return false;
        const int row = u.pm * 256, lane = TID() & 63;
        const int st = ps[lane & 31];
        const unsigned long long mk = __builtin_amdgcn_ballot_w64(lane < NEXP && row >= st);
        u.e = __builtin_popcountll(mk) - 1; return true;
    }
};
struct EpiSwiglu {
    static constexpr bool PERM = true;
    bf16_t* O; const float* bias;
    struct Pre { pg8::f32x4 bv[2][2]; };
    __device__ __forceinline__ Pre prefetch(const pg8::Unit& u, int wc, int fq) const { Pre p; const float* bp = bias + (size_t)u.e * 2048 + u.pn * 256 + wc * 32 + 8 * fq;
#pragma unroll
        for (int bj = 0; bj < 2; ++bj)
#pragma unroll
            for (int n = 0; n < 2; ++n) p.bv[bj][n] = *(const pg8::f32x4*)(bp + bj * 128 + 4 * n);
        return p; }
    __device__ __forceinline__ void operator()(const pg8::f32x4 (&acc)[2][2][4][2], const pg8::Unit& u, int wr, int wc, int fr, int fq, const Pre& pf) const {
        const int row0 = u.pm * 256 + wr * 64 + fr, col0 = u.pn * 256 + wc * 32 + 8 * fq;
        const float* bp = bias + (size_t)u.e * 2048 + col0;
        pg8::f32x4 bv[2][2];
#pragma unroll
        for (int bj = 0; bj < 2; ++bj)
#pragma unroll
            for (int n = 0; n < 2; ++n) bv[bj][n] = pf.bv[bj][n];
        const int odd = fq & 1, ocol = (u.pn * 256 + wc * 32 + 8 * (fq & ~1)) >> 1;
#pragma unroll
        for (int ai = 0; ai < 2; ++ai)
#pragma unroll
            for (int mp = 0; mp < 2; ++mp) {
                bf16_t* rowp = O + (size_t)(row0 + ai * 128 + (2 * mp + odd) * 16) * 1024 + ocol;
#pragma unroll
                for (int bj = 0; bj < 2; ++bj) {
                    pg8::u32x2 w[2];
#pragma unroll
                    for (int k = 0; k < 2; ++k) { const pg8::f32x4 v0 = acc[ai][bj][2 * mp + k][0] + bv[bj][0], v1 = acc[ai][bj][2 * mp + k][1] + bv[bj][1];
                        w[k].x = pg8::cvt_pk_bf16(swiglu1(v0[0], v0[1]), swiglu1(v0[2], v0[3])); w[k].y = pg8::cvt_pk_bf16(swiglu1(v1[0], v1[1]), swiglu1(v1[2], v1[3])); }
                    const pg8::u32x2 sx = __builtin_amdgcn_permlane16_swap(w[0].x, w[1].x, false, false), sy = __builtin_amdgcn_permlane16_swap(w[0].y, w[1].y, false, false);
                    pg8::u32x4 o; o.x = sx[0]; o.y = sy[0]; o.z = sx[1]; o.w = sy[1];
                    *(pg8::u32x4*)(rowp + bj * 64) = o;
                }
            }
    }
};
struct EpiBiasBf16 {
    static constexpr bool PERM = true;
    bf16_t* O; const float* bias;
    struct Pre { pg8::f32x4 bv[2][2]; };
    __device__ __forceinline__ Pre prefetch(const pg8::Unit& u, int wc, int fq) const { Pre p; const float* bp = bias + (size_t)u.e * 1024 + u.pn * 256 + wc * 32 + 8 * fq;
#pragma unroll
        for (int bj = 0; bj < 2; ++bj)
#pragma unroll
            for (int n = 0; n < 2; ++n) p.bv[bj][n] = *(const pg8::f32x4*)(bp + bj * 128 + 4 * n);
        return p; }
    __device__ __forceinline__ void operator()(const pg8::f32x4 (&acc)[2][2][4][2], const pg8::Unit& u, int wr, int wc, int fr, int fq, const Pre& pf) const {
        const int row0 = u.pm * 256 + wr * 64 + fr, col0 = u.pn * 256 + wc * 32 + 8 * fq;
        const float* bp = bias + (size_t)u.e * 1024 + col0;
        pg8::f32x4 bv[2][2];
#pragma unroll
        for (int bj = 0; bj < 2; ++bj)
#pragma unroll
            for (int n = 0; n < 2; ++n) bv[bj][n] = pf.bv[bj][n];
#pragma unroll
        for (int ai = 0; ai < 2; ++ai)
#pragma unroll
            for (int m = 0; m < 4; ++m) { bf16_t* rowp = O + (size_t)(row0 + ai * 128 + m * 16) * 1024 + col0;
#pragma unroll
                for (int bj = 0; bj < 2; ++bj) { const pg8::f32x4 v0 = acc[ai][bj][m][0] + bv[bj][0], v1 = acc[ai][bj][m][1] + bv[bj][1];
                    pg8::u32x4 w; w.x = pg8::cvt_pk_bf16(v0[0], v0[1]); w.y = pg8::cvt_pk_bf16(v0[2], v0[3]); w.z = pg8::cvt_pk_bf16(v1[0], v1[1]); w.w = pg8::cvt_pk_bf16(v1[2], v1[3]);
                    *(pg8::u32x4*)(rowp + bj * 128) = w; } }
    }
};
PH void ph_moe_gu16(LAS unsigned char* smem, const bf16_t* wgu16, const float* bgu, const MoeBufs& m) {
    int* ps = (int*)((unsigned char*)smem + MISC_OFF);
    moe_offsets(ps, m);
    MoeOrder S; S.init(ps[NEXP] / 256, 2048 / 256, GDIM(), BID()); S.ps = (const LAS int*)(smem + MISC_OFF);
    pg8::Gemm g; g.A = m.Xp; g.Bt = wgu16; g.M = ps[NEXP]; g.N = 2048; g.K = 1024; g.bgstride = (size_t)2048 * 1024 * 2;
    EpiSwiglu E; E.O = m.Hp; E.bias = bgu;
    pg8::gemm_phase(smem + STAGE_OFF, g, S, E);
}
PH void ph_moe_dn16(LAS unsigned char* smem, const bf16_t* wdn16, const float* bdn, const MoeBufs& m) {
    int* ps = (int*)((unsigned char*)smem + MISC_OFF);
    moe_offsets(ps, m);
    MoeOrder S; S.init(ps[NEXP] / 256, 1024 / 256, GDIM(), BID()); S.ps = (const LAS int*)(smem + MISC_OFF);
    pg8::Gemm g; g.A = m.Hp; g.Bt = wdn16; g.M = ps[NEXP]; g.N = 1024; g.K = 1024; g.bgstride = (size_t)1024 * 1024 * 2;
    EpiBiasBf16 E; E.O = m.Yp; E.bias = bdn;
    pg8::gemm_phase(smem + STAGE_OFF, g, S, E);
}
PH void ph_moe_combine(int* ps, bf16_t* h, const float* modl, int gate_off, const MoeBufs& m, int nrows, const float* ng, const float* nmod, bf16_t* a16, float* outf) {
    moe_offsets(ps, m);
    const int lane = TID() & 63, wave = (BID() * NTHR + TID()) >> 6, nw = GDIM() * NWAVE;
    int te[4], tp[4]; float tg[4];
    { const int r = wave < nrows ? wave : 0;
#pragma unroll
      for (int k = 0; k < 4; ++k) { te[k] = m.tok_e[r * 4 + k]; tp[k] = m.tok_pos[r * 4 + k]; tg[k] = m.tok_gate[r * 4 + k]; } }
    for (int r = wave; r < nrows; r += nw) {
        int dest[4]; float gk[4];
#pragma unroll
        for (int k = 0; k < 4; ++k) { dest[k] = ps[te[k]] + tp[k]; gk[k] = tg[k]; }
        const float* mr = modl + (size_t)mod_row(r) * MODW + gate_off;
        const float* nm = nmod ? nmod + (size_t)mod_row(r) * MODW : mr;
        pg8::u32x4 y[2][4], hw[2]; float4 g0[2], g1[2], ga[2], gb[2], sha[2], shb[2], sca[2], scb[2];
#pragma unroll
        for (int i = 0; i < 2; ++i) { const int col = (lane + 64 * i) * 8;
#pragma unroll
            for (int k = 0; k < 4; ++k) y[i][k] = *(const pg8::u32x4*)(m.Yp + (size_t)dest[k] * 1024 + col);
            g0[i] = *(const float4*)(mr + col); g1[i] = *(const float4*)(mr + col + 4);
            hw[i] = *(const pg8::u32x4*)(h + (size_t)r * D + col);
            ga[i] = *(const float4*)(ng + col); gb[i] = *(const float4*)(ng + col + 4);
            sha[i] = *(const float4*)(nm + col); shb[i] = *(const float4*)(nm + col + 4); sca[i] = *(const float4*)(nm + 1024 + col); scb[i] = *(const float4*)(nm + 1024 + col + 4); }
        { const int rn = r + nw < nrows ? r + nw : r;
#pragma unroll
          for (int k = 0; k < 4; ++k) { te[k] = m.tok_e[rn * 4 + k]; tp[k] = m.tok_pos[rn * 4 + k]; tg[k] = m.tok_gate[rn * 4 + k]; } }
        float o[16]; float ss = 0.f;
#pragma unroll
        for (int i = 0; i < 2; ++i) {
            float sv[8];
#pragma unroll
            for (int q = 0; q < 8; ++q) sv[q] = 0.f;
#pragma unroll
            for (int k = 0; k < 4; ++k) { const pg8::u32x4 yy = y[i][k];
                sv[0] += gk[k] * bflo(yy.x); sv[1] += gk[k] * bfhi(yy.x); sv[2] += gk[k] * bflo(yy.y); sv[3] += gk[k] * bfhi(yy.y);
                sv[4] += gk[k] * bflo(yy.z); sv[5] += gk[k] * bfhi(yy.z); sv[6] += gk[k] * bflo(yy.w); sv[7] += gk[k] * bfhi(yy.w); }
            float4 o0 = make_float4(bflo(hw[i].x), bfhi(hw[i].x), bflo(hw[i].y), bfhi(hw[i].y)), o1 = make_float4(bflo(hw[i].z), bfhi(hw[i].z), bflo(hw[i].w), bfhi(hw[i].w));
            o0.x += g0[i].x * sv[0]; o0.y += g0[i].y * sv[1]; o0.z += g0[i].z * sv[2]; o0.w += g0[i].w * sv[3];
            o1.x += g1[i].x * sv[4]; o1.y += g1[i].y * sv[5]; o1.z += g1[i].z * sv[6]; o1.w += g1[i].w * sv[7];
            o[8 * i] = o0.x; o[8 * i + 1] = o0.y; o[8 * i + 2] = o0.z; o[8 * i + 3] = o0.w; o[8 * i + 4] = o1.x; o[8 * i + 5] = o1.y; o[8 * i + 6] = o1.z; o[8 * i + 7] = o1.w;
#pragma unroll
            for (int q = 0; q < 8; ++q) ss += o[8 * i + q] * o[8 * i + q];
        }
        if (!outf) {
#pragma unroll
            for (int i = 0; i < 2; ++i) { pg8::u32x4 w; w.x = pg8::cvt_pk_bf16(o[8 * i], o[8 * i + 1]); w.y = pg8::cvt_pk_bf16(o[8 * i + 2], o[8 * i + 3]); w.z = pg8::cvt_pk_bf16(o[8 * i + 4], o[8 * i + 5]); w.w = pg8::cvt_pk_bf16(o[8 * i + 6], o[8 * i + 7]);
                *(pg8::u32x4*)(h + (size_t)r * D + (lane + 64 * i) * 8) = w; } }
        ss = wave_sum(ss);
        const float rs = rsqrtf(ss * (1.f / 1024.f) + 1e-5f);
#pragma unroll
        for (int i = 0; i < 2; ++i) {
            const int col = (lane + 64 * i) * 8;
            float v[8] = {o[8 * i] * rs * ga[i].x, o[8 * i + 1] * rs * ga[i].y, o[8 * i + 2] * rs * ga[i].z, o[8 * i + 3] * rs * ga[i].w, o[8 * i + 4] * rs * gb[i].x, o[8 * i + 5] * rs * gb[i].y, o[8 * i + 6] * rs * gb[i].z, o[8 * i + 7] * rs * gb[i].w};
            if (outf) { *(float4*)(outf + (size_t)r * D + col) = make_float4(v[0], v[1], v[2], v[3]); *(float4*)(outf + (size_t)r * D + col + 4) = make_float4(v[4], v[5], v[6], v[7]); }
            else {
                v[0] = v[0] * (1.f + sca[i].x) + sha[i].x; v[1] = v[1] * (1.f + sca[i].y) + sha[i].y; v[2] = v[2] * (1.f + sca[i].z) + sha[i].z; v[3] = v[3] * (1.f + sca[i].w) + sha[i].w;
                v[4] = v[4] * (1.f + scb[i].x) + shb[i].x; v[5] = v[5] * (1.f + scb[i].y) + shb[i].y; v[6] = v[6] * (1.f + scb[i].z) + shb[i].z; v[7] = v[7] * (1.f + scb[i].w) + shb[i].w;
                *(pg8::u32x4*)(a16 + (size_t)r * D + col) = pack8(v); }
        }
    }
}

#if PROBE
PH float probe_q(float t) {
    t = fmaxf(t, 1e-4f); float sc = 1.f;
    while (t >= 10.f) { t *= 0.1f; sc *= 10.f; }
    while (t < 1.f) { t *= 10.f; sc *= 0.1f; }
    float m = 1.f;
    if (t >= 2.f) m = 2.f; if (t >= 5.f) m = 5.f;
    return m * sc;
}
#endif
__global__ __launch_bounds__(NTHR, 2) void mega(Params p) {
    extern __shared__ __attribute__((aligned(16))) unsigned char smem[];
    float* lds = (float*)(smem + STAGE_OFF);
    LAS unsigned char* lsm = (LAS unsigned char*)smem;
    if (threadIdx.x == 0) *(uint4*)smem = make_uint4(0u, 0u, 0u, 0u);
    __syncthreads();
    XcdBarrier bar = xcd_barrier_post(p.bar, (volatile LAS unsigned*)smem);
#if PROBE
    if (threadIdx.x == 0) { volatile LAS unsigned long long* tl0 = (volatile LAS unsigned long long*)((LAS unsigned char*)smem + 512); for (int q = 0; q < 31; ++q) tl0[q] = 0; tl0[31] = wall_clock64(); }
#define GRID_SYNC(id) do { xcd_barrier(bar); if (threadIdx.x == 0) { volatile LAS unsigned long long* tl_ = (volatile LAS unsigned long long*)((LAS unsigned char*)smem + 512); \
        const unsigned long long now_ = wall_clock64(); tl_[id] += now_ - tl_[31]; tl_[31] = now_; } } while (0)
#define SUBSTAMP(id) do { __syncthreads(); if (threadIdx.x == 0) { volatile LAS unsigned long long* tl_ = (volatile LAS unsigned long long*)((LAS unsigned char*)smem + 512); \
        const unsigned long long now_ = wall_clock64(); tl_[id] += now_ - tl_[31]; tl_[31] = now_; } } while (0)
#else
#define GRID_SYNC(id) xcd_barrier(bar)
#define SUBSTAMP(id) do { } while (0)
#endif

    ph_copy(p);
    ph_ada(p, lds);
    ph_rope_tab(p.rope_c, p.rope_s);
    ph_fft_tab(p.fft_tabT);
    ph_pool_prep(p.pool_w, p.pool_wt);
    ph_router_prep(p.router_w, p.rwt_hi, p.rwt_lo);
    ph_convT_small(p.rw_w2, p.w2t, 64, 768, 4);
    ph_convT_small(p.rw_a2, p.a2t, 64, 768, 4);
    ph_convT_small(p.rw_g2, p.g2t, 160, 768, 2);
    ph_twiddle16(p.tw16_lat, 2048);
    ph_twiddle16(p.tw16_ctx, 256);
    ph_convT(lsm + STAGE_OFF, p.ev_w_in, p.ewin16, 1024, EVEN_IN, 1536, 2);
    ph_convT(lsm + STAGE_OFF, p.od_w_in, p.owin16, 1024, ODD_IN, 3072, 2);
    ph_convT(lsm + STAGE_OFF, p.ev_w_out, p.ewout16, 1024, 1024, 1024, 2);
    ph_convT(lsm + STAGE_OFF, p.od_w_out, p.owout16, 1024, 1024, 1024, 2);
    ph_moe_init(p.mb);
    ph_convT(lsm + STAGE_OFF, p.exp_w_gu, p.wgu16, 1024, 2048, 2048, 4 * NEXP);
    ph_convT(lsm + STAGE_OFF, p.exp_w_dn, p.wdn16, 1024, 1024, 1024, 4 * NEXP);
    GRID_SYNC(0);

    for (int i = 0; i < 4; ++i) {
        const int j = i >> 1; const bool last = (i == 3);
        const float* modl = p.mod + (size_t)i * 17 * MODW;
        if (i == 0) { ph_norm_mod((const bf16_t*)p.h, p.norm_mix_g, modl, 0, 1024, nullptr, p.a16, NT); GRID_SYNC(1); }
        if ((i & 1) == 0) {
            { EpiRopeBf16 E; E.O = p.px16; E.ldc = 1536; E.ct = p.rope_c; E.st = p.rope_s; ph_gemm16(lsm, p.a16, p.ewin16 + (size_t)j * 1536 * 1024, NT, 1536, 1024, E, BID(), GDIM()); }
            GRID_SYNC(2);
            ph_pool16(lsm, p.px16, p.pool_wt + (size_t)j * 4 * 4096, p.pool_scale + j * 256, p.mix16);
            SUBSTAMP(24);
            ph_attn16(lsm, p.px16, p.att_sink + j * 12, p.mix16);
            GRID_SYNC(4);
            { EpiPlainBf16 E; E.O = p.px16; E.ldc = D; ph_gemm16(lsm, p.mix16, p.ewout16 + (size_t)j * D * D, NT, D, D, E, BID(), GDIM()); }
        } else {
            { EpiPlainBf16 E; E.O = p.px16; E.ldc = 3072; ph_gemm16(lsm, p.a16, p.owin16 + (size_t)j * 3072 * 1024, NT, 3072, 1024, E, BID(), GDIM()); }
            GRID_SYNC(6);
            OddW w;
            w.mu = p.rw_mu + (size_t)j * 2 * 2720; w.w0 = p.rw_w0 + (size_t)j * 2 * 768; w.w2 = p.rw_w2 + (size_t)j * 2 * 64 * 768;
            w.a0 = p.rw_a0 + (size_t)j * 2 * 768; w.a2 = p.rw_a2 + (size_t)j * 2 * 64 * 768; w.g2 = p.rw_g2 + (size_t)j * 160 * 768;
            w.k_k = p.rw_k_k + j * 768; w.k_a = p.rw_k_a + j * 768; w.r_k = p.rw_r_k + j * 768; w.gn_g = p.rw_gn_g + j * 768; w.gn_b = p.rw_gn_b + j * 768;
            ph_oddprep(lsm, p.px16, w, p.w2t + (size_t)j * 2 * 768 * 64, p.a2t + (size_t)j * 2 * 768 * 64, p.g2t + (size_t)j * 768 * 160, p.si);
            SUBSTAMP(22);
            ph_fft_prep16(p.px16, p.fft_tabT, p.bt16_lat, p.bt16_ctx);
            GRID_SYNC(7);
            { EpiDft E; E.mix = p.mix16; E.T = 2048; E.row0 = 0; E.scale = 0.0027621358640099515f;
              ph_gemm16(lsm, p.tw16_lat, p.bt16_lat, 2048, 4096, 4096, E, BID(), GDIM());
              E.T = 256; E.row0 = NX; E.scale = 0.0078125f;
              ph_gemm16(lsm, p.tw16_ctx, p.bt16_ctx, 256, 4096, 512, E, (BID() >= 128 ? BID() - 128 : BID() + 128), GDIM()); }
            ph_scan_prep(lsm, p.si, w.k_a, w.k_k, p.crec, p.qctr + 16 * j);
            GRID_SYNC(20);
            ph_scan_seq(lsm, p.crec, p.si.Y, p.si.V);
            GRID_SYNC(8);
            ph_readout2(p.si, w, p.mix16);
            GRID_SYNC(9);
            { EpiPlainBf16 E; E.O = p.px16; E.ldc = D; ph_gemm16(lsm, p.mix16, p.owout16 + (size_t)j * D * D, NT, D, D, E, BID(), GDIM()); }
        }
        GRID_SYNC((i & 1) ? 10 : 5);
        const int nrows = last ? NX : NT;
        ph_resid_norm((bf16_t*)p.h, p.px16, modl + 2048, p.norm_ffn_g + i * D, modl, 3072, 4096, p.a16, nrows);
        GRID_SYNC(11);
        ph_router16(lsm, p.a16, p.rwt_hi + (size_t)i * NEXP * D, p.rwt_lo + (size_t)i * NEXP * D, p.router_b + i * NEXP, p.mb, nrows);
        GRID_SYNC(12);
        ph_moe_gather((int*)(smem + MISC_OFF), p.a16, p.mb, nrows);
        GRID_SYNC(13);
        ph_moe_gu16(lsm, p.wgu16 + (size_t)i * NEXP * 2048 * 1024, p.exp_b_gu + (size_t)i * NEXP * 2048, p.mb);
        GRID_SYNC(14);
        ph_moe_dn16(lsm, p.wdn16 + (size_t)i * NEXP * 1024 * 1024, p.exp_b_dn + (size_t)i * NEXP * 1024, p.mb);
        GRID_SYNC(15);
        ph_moe_combine((int*)(smem + MISC_OFF), (bf16_t*)p.h, modl, 5120, p.mb, nrows, last ? p.final_g : p.norm_mix_g + (i + 1) * D, last ? nullptr : modl + 17 * MODW, p.a16, last ? p.out : nullptr);
        GRID_SYNC(16);
        ph_moe_init(p.mb);
    }
#if PROBE
    GRID_SYNC(18);
    if (blockIdx.x == 0 && threadIdx.x == 0) { volatile LAS unsigned long long* tl_ = (volatile LAS unsigned long long*)((LAS unsigned char*)smem + 512); for (int q = 0; q < 31; ++q) p.probe[q] = tl_[q]; }
    GRID_SYNC(19);
    {
        const float tA = probe_q((float)p.probe[PROBE_A] * 1e-5f), tB = probe_q((float)p.probe[PROBE_B] * 1e-5f);
        const float cA = 10.f * sqrtf(tA), cB = 1000.f * tB;
        for (size_t q = (size_t)blockIdx.x * NTHR + threadIdx.x; q < (size_t)NX * D; q += (size_t)GDIM() * NTHR) p.out[q] = q == 0 ? cB : cA;
    }
#endif
}
}

extern "C" void kernel_launch(void* const* d_in, const int* in_sizes, int n_in, void* d_out, int out_size, void* d_ws, size_t ws_size, hipStream_t stream) {
    Params p; memset(&p, 0, sizeof(p));
    p.x = (const float*)d_in[0]; p.c = (const float*)d_in[1]; p.ctx = (const float*)d_in[2]; p.c_ctx = (const float*)d_in[3];
    p.ada_w = (const float*)d_in[4]; p.ada_b = (const float*)d_in[5]; p.norm_mix_g = (const float*)d_in[6]; p.norm_ffn_g = (const float*)d_in[7];
    p.ev_w_in = (const float*)d_in[8]; p.ev_w_out = (const float*)d_in[9]; p.pool_w = (const float*)d_in[10]; p.pool_scale = (const float*)d_in[11];
    p.att_sink = (const float*)d_in[12]; p.od_w_in = (const float*)d_in[13]; p.od_w_out = (const float*)d_in[14];
    p.rw_mu = (const float*)d_in[15]; p.rw_w0 = (const float*)d_in[16]; p.rw_w2 = (const float*)d_in[17]; p.rw_a0 = (const float*)d_in[18];
    p.rw_a2 = (const float*)d_in[19]; p.rw_g2 = (const float*)d_in[20]; p.rw_k_k = (const float*)d_in[21]; p.rw_k_a = (const float*)d_in[22];
    p.rw_r_k = (const float*)d_in[23]; p.rw_gn_g = (const float*)d_in[24]; p.rw_gn_b = (const float*)d_in[25];
    p.router_w = (const float*)d_in[26]; p.router_b = (const float*)d_in[27]; p.exp_w_gu = (const float*)d_in[28]; p.exp_b_gu = (const float*)d_in[29];
    p.exp_w_dn = (const float*)d_in[30]; p.exp_b_dn = (const float*)d_in[31]; p.final_g = (const float*)d_in[32];
    p.out = (float*)d_out;

    float* ws = (float*)d_ws; size_t off = 0;
    auto take = [&](size_t n) { float* q = ws + off; off += (n + 63) & ~(size_t)63; return q; };
    p.bar = (unsigned*)take(XCD_BAR_WORDS);
    p.qctr = (unsigned*)take(64);
    p.probe = (unsigned long long*)take(64);
    p.rope_c = take(1024); p.rope_s = take(1024);
    p.fft_tabT = (bf16_t*)take(128 * 64 / 2);
    p.pool_wt = (bf16_t*)take(2 * 4 * 64 * 64 / 2);
    p.rwt_hi = (bf16_t*)take((size_t)4 * 32 * 1024 / 2); p.rwt_lo = (bf16_t*)take((size_t)4 * 32 * 1024 / 2);
    p.w2t = (bf16_t*)take((size_t)4 * 768 * 64 / 2); p.a2t = (bf16_t*)take((size_t)4 * 768 * 64 / 2); p.g2t = (bf16_t*)take((size_t)2 * 768 * 160 / 2);
    p.mod = take((size_t)4 * 17 * MODW);
    p.h = take((size_t)NT * D);
    p.a = take((size_t)NT * D);
    p.mix16 = (bf16_t*)take((size_t)NT * D / 2);
    p.tw16_lat = (bf16_t*)take((size_t)2048 * 4096 / 2);
    p.tw16_ctx = (bf16_t*)take((size_t)256 * 512 / 2);
    p.ewin16 = (bf16_t*)take((size_t)2 * 1536 * 1024 / 2); p.owin16 = (bf16_t*)take((size_t)2 * 3072 * 1024 / 2);
    p.ewout16 = (bf16_t*)take((size_t)2 * 1024 * 1024 / 2); p.owout16 = (bf16_t*)take((size_t)2 * 1024 * 1024 / 2);
    p.mb.tok_e = (int*)take((size_t)NT * 4); p.mb.tok_pos = (int*)take((size_t)NT * 4); p.mb.tok_gate = take((size_t)NT * 4);
    p.mb.cnt = (int*)take(64);
    p.a16 = (bf16_t*)take((size_t)NT * D / 2);
    p.wgu16 = (bf16_t*)take((size_t)4 * NEXP * 2048 * 1024 / 2);
    p.wdn16 = (bf16_t*)take((size_t)4 * NEXP * 1024 * 1024 / 2);
    const size_t scratch0 = off;
    p.px16 = (bf16_t*)take((size_t)NT * 3072 / 2);
    { bf16_t** arrs[9] = {&p.si.R, &p.si.K, &p.si.KK, &p.si.V, &p.si.G, &p.si.X[0], &p.si.X[1], &p.si.A[0], &p.si.A[1]};
      for (int q = 0; q < 9; ++q) *arrs[q] = (bf16_t*)take((size_t)NT * RW / 2); }
    p.si.Y[0] = take((size_t)NT * RW); p.si.Y[1] = take((size_t)NT * RW);
    p.st_init = take((size_t)NB * 24 * 5 * 4096); p.st_p = take((size_t)NB * 24 * 4 * 4096); p.st_b = take((size_t)NB * 24 * 4 * 4096);
    p.crec = (unsigned char*)take((size_t)NB * 24 * 144 * 12544 / 4);
    p.bt16_lat = (bf16_t*)take((size_t)4096 * 4096 / 2);
    p.bt16_ctx = (bf16_t*)take((size_t)4096 * 512 / 2);
    const size_t mixer_end = off;
    off = scratch0;
    p.mb.Xp = (bf16_t*)take((size_t)MOE_ROWS * 1024 / 2); p.mb.Hp = (bf16_t*)take((size_t)MOE_ROWS * 1024 / 2); p.mb.Yp = (bf16_t*)take((size_t)MOE_ROWS * 1024 / 2);
    const size_t total = (off > mixer_end ? off : mixer_end) * sizeof(float);
    if (total > ws_size) { fprintf(stderr, "kernel_launch: workspace too small: need %zu have %zu\n", total, ws_size); return; }

    static int grid = 0;
    if (!grid) {
        int dev = 0, cus = 0, per_cu = 0;
        if (hipGetDevice(&dev) != hipSuccess || hipDeviceGetAttribute(&cus, hipDeviceAttributeMultiprocessorCount, dev) != hipSuccess) { fprintf(stderr, "kernel_launch: device query failed\n"); return; }
        if (hipFuncSetAttribute((const void*)mega, hipFuncAttributeMaxDynamicSharedMemorySize, LDS_BYTES) != hipSuccess) { fprintf(stderr, "kernel_launch: hipFuncSetAttribute failed\n"); return; }
        if (hipOccupancyMaxActiveBlocksPerMultiprocessor(&per_cu, (const void*)mega, NTHR, LDS_BYTES) != hipSuccess || per_cu < 1) { fprintf(stderr, "kernel_launch: occupancy query says %d\n", per_cu); return; }
        grid = cus;
    }
    if (hipMemsetAsync(p.bar, 0, (XCD_BAR_WORDS + 64) * sizeof(unsigned), stream) != hipSuccess) { fprintf(stderr, "kernel_launch: memset failed\n"); return; }
    hipLaunchKernelGGL(mega, dim3(grid), dim3(NTHR), LDS_BYTES, stream, p);
}
```

```cpp
#include <hip/hip_runtime.h>
#include <stdint.h>
#include <stdio.h>
#include <string.h>

#define PROBE 0
#define PROBE_A 4
#define PROBE_B 8
namespace {
constexpr int D = 1024, NB = 16, SEQ = 2048, CTX = 256;
constexpr int NX = NB * SEQ, NC = NB * CTX, NT = NX + NC;
constexpr int EVEN_IN = 1408, ODD_IN = 2976;
constexpr int RW = 768;
constexpr int NEXP = 32, TOPK = 4;
constexpr int MOE_ROWS = ((NT * TOPK + 255) / 256 + NEXP) * 256;
constexpr int MOE_TILES = MOE_ROWS / 128;
constexpr int MODW = 6 * D;
constexpr int NTHR = 512, NWAVE = 8;
constexpr int LDS_BYTES = 132 * 1024;
constexpr int MISC_OFF = 16, STAGE_OFF = 1024;

#define XB_TMO      128
#define XB_XCNT(j)  (256  + 64 * (j))
#define XB_XSUB(j)  (1280 + 64 * (j))
#define XB_XGEN(j)  (2304 + 64 * (j))
#define XB_TOP      3328
#define XB_TOPGEN   3392
#define XCD_BAR_WORDS 3456
#define XB_SPIN_CAP (1u << 22)
#define LAS __attribute__((address_space(3)))

__device__ __forceinline__ unsigned xb_ld(unsigned* p)              { return __hip_atomic_load(p, __ATOMIC_RELAXED, __HIP_MEMORY_SCOPE_AGENT); }
__device__ __forceinline__ unsigned xb_add(unsigned* p, unsigned v) { return __hip_atomic_fetch_add(p, v, __ATOMIC_RELAXED, __HIP_MEMORY_SCOPE_AGENT); }
__device__ __forceinline__ unsigned xb_xcc_id() { return (unsigned)__builtin_amdgcn_s_getreg((3 << 11) | 20) & 0xFu; }
#define XB_SPIN(cond, bar) do { unsigned _sp = 0; while (cond) { __builtin_amdgcn_s_sleep(1); \
    if ((++_sp & 255u) == 0u) { if (xb_ld(&(bar)[XB_TMO])) break; if (_sp > XB_SPIN_CAP) { atomicAdd(&(bar)[XB_TMO], 1u); break; } } } } while (0)

struct XcdBarrier { unsigned* bar; unsigned x; volatile LAS unsigned* st; };

__device__ __forceinline__ XcdBarrier xcd_barrier_post(unsigned* bar, volatile LAS unsigned* st) {
    XcdBarrier b; b.bar = bar; b.x = xb_xcc_id(); b.st = st;
    if (threadIdx.x == 0) (void)xb_add(&bar[XB_XCNT(b.x)], 1u);
    return b;
}
__device__ __forceinline__ void xcd_barrier_complete(unsigned* bar, unsigned x, unsigned& nloc, unsigned& nx) {
    const unsigned G = gridDim.x * gridDim.y * gridDim.z;
    unsigned sum, cnt, mine, sp = 0u;
    for (;;) {
        sum = 0u; cnt = 0u; mine = 0u;
#pragma unroll
        for (unsigned j = 0; j < 16; ++j) { const unsigned c = xb_ld(&bar[XB_XCNT(j)]); sum += c; cnt += (c > 0u) ? 1u : 0u; mine = (j == x) ? c : mine; }
        if (sum == G) break;
        __builtin_amdgcn_s_sleep(1);
        if ((++sp & 255u) == 0u) { if (xb_ld(&bar[XB_TMO])) break; if (sp > XB_SPIN_CAP) { atomicAdd(&bar[XB_TMO], 1u); break; } }
    }
    nloc = mine > 0u ? mine : 1u; nx = cnt > 0u ? cnt : 1u;
}
__device__ __forceinline__ void xcd_barrier(const XcdBarrier& b) {
    asm volatile("s_waitcnt vmcnt(0)" ::: "memory");
    __syncthreads();
    if (threadIdx.x == 0) {
        unsigned* bar = b.bar; unsigned bx = b.x;
        asm volatile("" : "+s"(bar), "+s"(bx));
        __builtin_amdgcn_s_waitcnt(0);
        unsigned nloc = b.st[0], nx = b.st[1];
        if (nloc == 0u) { xcd_barrier_complete(bar, bx, nloc, nx); b.st[0] = nloc; b.st[1] = nx; }
        const unsigned old = xb_add(&bar[XB_XSUB(bx)], 1u);
        const unsigned gen = old / nloc;
        if (old + 1u == (gen + 1u) * nloc) {
            __builtin_amdgcn_fence(__ATOMIC_RELEASE, "agent");
            asm volatile("s_waitcnt vmcnt(0)" ::: "memory");
            const unsigned og = xb_add(&bar[XB_TOP], 1u);
            const unsigned tg = og / nx;
            if (og + 1u == (tg + 1u) * nx) xb_add(&bar[XB_TOPGEN], 1u);
            else XB_SPIN(xb_ld(&bar[XB_TOPGEN]) == tg, bar);
            __builtin_amdgcn_fence(__ATOMIC_ACQUIRE, "agent");
            xb_add(&bar[XB_XGEN(bx)], 1u);
            asm volatile("s_waitcnt vmcnt(0)" ::: "memory");
        } else {
            XB_SPIN(xb_ld(&bar[XB_XGEN(bx)]) == gen, bar);
            __builtin_amdgcn_fence(__ATOMIC_ACQUIRE, "agent");
            asm volatile("s_waitcnt vmcnt(0)" ::: "memory");
        }
    }
    __syncthreads();
}

#define PH __device__ __forceinline__
PH float wave_sum(float v) {
#pragma unroll
    for (int o = 32; o >= 1; o >>= 1) v += __shfl_xor(v, o);
    return v;
}
PH float wave_max(float v) {
#pragma unroll
    for (int o = 32; o >= 1; o >>= 1) v = fmaxf(v, __shfl_xor(v, o));
    return v;
}
PH int mod_row(int r) { return r < NX ? (r >> 11) : 16; }
PH void seq_info(int r, int& s0, int& len, int& t) {
    if (r < NX) { s0 = r & ~2047; len = SEQ; t = r & 2047; }
    else { const int q = r - NX; s0 = NX + (q & ~255); len = CTX; t = q & 255; }
}
PH float sigmoidf_(float x) { return 1.f / (1.f + expf(-x)); }
PH int TID() { int t = threadIdx.x; asm volatile("" : "+v"(t)); return t; }
PH int BID() { int t = blockIdx.x; asm volatile("" : "+s"(t)); return t; }
PH int GDIM() {
    int t = __builtin_amdgcn_readfirstlane((int)(((const __attribute__((address_space(4))) unsigned*)__builtin_amdgcn_dispatch_ptr())[3] >> 9)); asm volatile("" : "+s"(t)); return t; }
static_assert(NTHR == 512, "GDIM shift");

typedef unsigned short bf16_t;
#if PROBE
#define SUBSTAMP_L(lsm_, id) do { __syncthreads(); if (threadIdx.x == 0) { volatile LAS unsigned long long* tl_ = (volatile LAS unsigned long long*)((LAS unsigned char*)(lsm_) + 512); \
        const unsigned long long now_ = wall_clock64(); tl_[id] += now_ - tl_[31]; tl_[31] = now_; } } while (0)
#else
#define SUBSTAMP_L(lsm_, id) do { } while (0)
#endif
struct ScanArrays { float *R, *V, *KK, *G, *W[2], *KD[2], *BB[2], *Y[2]; };
struct ScanIn { bf16_t *R, *K, *KK, *V, *G, *X[2], *A[2]; float* Y[2]; };
struct OddW { const float *mu, *w0, *w2, *a0, *a2, *g2, *k_k, *k_a, *r_k, *gn_g, *gn_b; };
struct MoeBufs { int* tok_e; int* tok_pos; float* tok_gate; int* cnt; bf16_t* Xp; bf16_t* Hp; bf16_t* Yp; };

struct Params {
    const float *x, *c, *ctx, *c_ctx, *ada_w, *ada_b, *norm_mix_g, *norm_ffn_g, *ev_w_in, *ev_w_out, *pool_w, *pool_scale, *att_sink;
    const float *od_w_in, *od_w_out, *rw_mu, *rw_w0, *rw_w2, *rw_a0, *rw_a2, *rw_g2, *rw_k_k, *rw_k_a, *rw_r_k, *rw_gn_g, *rw_gn_b;
    const float *router_w, *router_b, *exp_w_gu, *exp_b_gu, *exp_w_dn, *exp_b_dn, *final_g;
    float* out; unsigned* bar; unsigned* qctr; unsigned long long* probe;
    unsigned char* crec;
    float *st_init, *st_p, *st_b;
    float *mod, *h, *a, *mix, *tw_lat, *tw_ctx, *px, *bm_lat, *bm_ctx;
    bf16_t *px16; float *rope_c, *rope_s;
    bf16_t *a16, *wgu16, *wdn16, *mix16, *ewin16, *owin16, *ewout16, *owout16, *tw16_lat, *tw16_ctx, *bt16_lat, *bt16_ctx;
    ScanArrays sa; MoeBufs mb; ScanIn si;
    bf16_t *fft_tabT, *pool_wt;
    bf16_t *rwt_hi, *rwt_lo;
    bf16_t *w2t, *a2t, *g2t;
};


namespace pg8 {
#define PG8_LAS __attribute__((address_space(3)))
typedef unsigned short bf16_t;
typedef short bf16x8 __attribute__((ext_vector_type(8)));
typedef float f32x4 __attribute__((ext_vector_type(4)));
typedef unsigned u32x4 __attribute__((ext_vector_type(4)));
typedef unsigned u32x2 __attribute__((ext_vector_type(2)));
constexpr int BM = 256, BK = 64, HALF = 128, HTB = HALF * BK * 2, STAGE_BYTES = 8 * HTB, NXCD = 8, WGM = 8;

__host__ __device__ __forceinline__ int lds_byte(int r, int c) { const int st = (r >> 4) * 2 + (c >> 5), rr = r & 15, cc = c & 31, ob = rr * 64 + cc * 2; return st * 1024 + (ob ^ (((ob >> 9) & 1) << 5)); }
__host__ __device__ __forceinline__ void stage_rc(int b, int& R, int& C) { const int st = b / 1024, sb = b % 1024, swz = sb ^ (((sb >> 9) & 1) << 5); R = (st >> 1) * 16 + swz / 64; C = (st & 1) * 32 + (swz % 64) / 2; }
__host__ __device__ __forceinline__ int perm32(int rho) { const int n = rho >> 4, i = rho & 15; return 8 * (i >> 2) + 4 * n + (i & 3); }

struct Unit { int pm, pn, e; };
struct Gemm { const bf16_t* A; const bf16_t* Bt; int M, N, K; size_t bgstride; };

typedef float cvt_f32x2 __attribute__((ext_vector_type(2)));
typedef __bf16 cvt_bf16x2 __attribute__((ext_vector_type(2)));
__device__ __forceinline__ unsigned cvt_pk_bf16(float lo, float hi) { const cvt_f32x2 v = {lo, hi}; const cvt_bf16x2 b = __builtin_convertvector(v, cvt_bf16x2); return __builtin_bit_cast(unsigned, b); }

struct TileOrder {
    int nM, nN, nwg, G, c;
    __device__ void init(int nM_, int nN_, int G_, int c_) { nM = nM_; nN = nN_; nwg = nM * nN; G = G_; c = c_; }
    __device__ bool tile(int i, int& pm, int& pn) const {
        const long L = (long)i * G + c; if (L >= nwg) return false;
        int wgid = (int)L; { const int q = nwg / NXCD, r = nwg % NXCD, xcd = wgid % NXCD, off = wgid / NXCD; wgid = (xcd < r ? xcd * (q + 1) : r * (q + 1) + (xcd - r) * q) + off; }
        const int nig = WGM * nN, gid = wgid / nig, fm = gid * WGM, gsz = (nM - fm) < WGM ? (nM - fm) : WGM;
        pm = fm + ((wgid % nig) % gsz); pn = (wgid % nig) / gsz; return true;
    }
};

template <class Epi, class Sched>
__device__ __forceinline__ void gemm_phase(PG8_LAS unsigned char* lds, const Gemm g, const Sched& S, const Epi& E) {
    const int tid = TID(), wid = __builtin_amdgcn_readfirstlane(tid >> 6), lane = tid & 63, wr = wid >> 2, wc = wid & 3, fr = lane & 15, fq = lane >> 4;
    const int K = g.K, nt = K / BK;
    unsigned voffA[2], voffB[2];
#pragma unroll
    for (int i = 0; i < 2; ++i) { int R, C; stage_rc(tid * 16 + i * 8192, R, C); const int Rb = Epi::PERM ? ((R & ~31) + perm32(R & 31)) : R;
        voffA[i] = (unsigned)(R * K + C) * 2u; voffB[i] = (unsigned)(Rb * K + C) * 2u; }
    const size_t kstep = (size_t)(BK * 2);
    const size_t hstep = (size_t)HALF * K * 2;
    const size_t tstep = 2 * hstep;
    const unsigned ldsw = (unsigned)wid * 1024u;
    const int aoff = lds_byte(wr * 64 + fr, fq * 8), boff = lds_byte(wc * 32 + fr, fq * 8);
#define PG8_SA(b, h) (((b) * 2 + (h)) * HTB)
#define PG8_SB(b, h) ((4 + (b) * 2 + (h)) * HTB)
#define PG8_STAGE(bufoff, gbase, voff) do { _Pragma("unroll") for (int _i = 0; _i < 2; ++_i) \
        __builtin_amdgcn_global_load_lds((const unsigned*)((const char*)(gbase) + (voff)[_i]), (PG8_LAS unsigned*)(lds + (bufoff) + ldsw + _i * 8192), 16, 0, 0); } while (0)
#define PG8_LDA(dst, b, h) do { _Pragma("unroll") for (int m = 0; m < 4; ++m) _Pragma("unroll") for (int k = 0; k < 2; ++k) dst[m][k] = *(const PG8_LAS bf16x8*)(lds + PG8_SA(b, h) + aoff + m * 2048 + k * 1024); } while (0)
#define PG8_LDB(dst, b, h) do { _Pragma("unroll") for (int n = 0; n < 2; ++n) _Pragma("unroll") for (int k = 0; k < 2; ++k) dst[n][k] = *(const PG8_LAS bf16x8*)(lds + PG8_SB(b, h) + boff + n * 2048 + k * 1024); } while (0)
#define PG8_MMA(ai, bj, At, Bt) do { __builtin_amdgcn_s_setprio(1); _Pragma("unroll") for (int m = 0; m < 4; ++m) _Pragma("unroll") for (int n = 0; n < 2; ++n) _Pragma("unroll") for (int k = 0; k < 2; ++k) \
        acc[ai][bj][m][n] = __builtin_amdgcn_mfma_f32_16x16x32_bf16(Bt[n][k], At[m][k], acc[ai][bj][m][n], 0, 0, 0); __builtin_amdgcn_s_setprio(0); } while (0)
#define PG8_WAIT_V(n) asm volatile("s_waitcnt vmcnt(" #n ")" ::: "memory")
#define PG8_WAIT_L(n) asm volatile("s_waitcnt lgkmcnt(" #n ")" ::: "memory")
#define PG8_BAR __builtin_amdgcn_s_barrier()
#define PG8_SCHED __builtin_amdgcn_sched_barrier(0)
    Unit cur, nxt; int ui = 0;
    if (!S.next(0, cur)) return;
    typename Epi::Pre pre;
    f32x4 acc[2][2][4][2];
#pragma unroll
    for (int a = 0; a < 2; ++a)
#pragma unroll
        for (int b = 0; b < 2; ++b)
#pragma unroll
            for (int m = 0; m < 4; ++m)
#pragma unroll
                for (int n = 0; n < 2; ++n) acc[a][b][m][n] = (f32x4){0.f, 0.f, 0.f, 0.f};
    bf16x8 At[4][2], B0[2][2], B1[2][2];
    const char* cA = (const char*)g.A + (size_t)cur.pm * tstep; const char* cB = (const char*)g.Bt + (size_t)cur.e * g.bgstride + (size_t)cur.pn * tstep;
    PG8_STAGE(PG8_SB(0, 0), cB, voffB); PG8_STAGE(PG8_SA(0, 0), cA, voffA); PG8_STAGE(PG8_SB(0, 1), cB + hstep, voffB); PG8_STAGE(PG8_SA(0, 1), cA + hstep, voffA);
    if (wr == 1) PG8_BAR;
    PG8_WAIT_V(4); PG8_BAR;
    PG8_STAGE(PG8_SB(1, 0), cB + kstep, voffB); PG8_STAGE(PG8_SA(1, 0), cA + kstep, voffA); PG8_STAGE(PG8_SB(1, 1), cB + hstep + kstep, voffB);
    PG8_WAIT_V(6); PG8_BAR;
    for (;;) {
        const bool has_next = S.next(ui + 1, nxt);
        const char* nA = has_next ? (const char*)g.A + (size_t)nxt.pm * tstep : cA; const char* nB = has_next ? (const char*)g.Bt + (size_t)nxt.e * g.bgstride + (size_t)nxt.pn * tstep : cB;
        for (int t = 0; t < nt; t += 2) {
            const bool last = (t == nt - 2);
            if (last) pre = E.prefetch(cur, wc, fq);
            const char* a1 = cA + (size_t)(t + 1) * kstep;
            const char* a2 = last ? nA : cA + (size_t)(t + 2) * kstep; const char* b2 = last ? nB : cB + (size_t)(t + 2) * kstep;
            const char* a3 = a2 + kstep; const char* b3 = b2 + kstep;
            PG8_LDB(B0, 0, 0); PG8_SCHED; PG8_LDA(At, 0, 0); PG8_STAGE(PG8_SA(1, 1), a1 + hstep, voffA);
            PG8_WAIT_L(8); PG8_BAR; PG8_WAIT_L(0); PG8_MMA(0, 0, At, B0); PG8_BAR; PG8_SCHED;
            PG8_LDB(B1, 0, 1); PG8_STAGE(PG8_SB(0, 0), b2, voffB);
            PG8_BAR; PG8_WAIT_L(0); PG8_MMA(0, 1, At, B1); PG8_BAR;
            PG8_LDA(At, 0, 1); PG8_STAGE(PG8_SA(0, 0), a2, voffA);
            PG8_BAR; PG8_WAIT_L(0); PG8_MMA(1, 0, At, B0); PG8_BAR; PG8_SCHED;
            PG8_STAGE(PG8_SB(0, 1), b2 + hstep, voffB);
            PG8_WAIT_V(6); PG8_BAR; PG8_MMA(1, 1, At, B1); PG8_BAR;
            PG8_LDB(B0, 1, 0); PG8_SCHED; PG8_LDA(At, 1, 0); PG8_STAGE(PG8_SA(0, 1), a2 + hstep, voffA);
            PG8_WAIT_L(8); PG8_BAR; PG8_WAIT_L(0); PG8_MMA(0, 0, At, B0); PG8_BAR; PG8_SCHED;
            PG8_LDB(B1, 1, 1); PG8_STAGE(PG8_SB(1, 0), b3, voffB);
            PG8_BAR; PG8_WAIT_L(0); PG8_MMA(0, 1, At, B1); PG8_BAR;
            PG8_LDA(At, 1, 1); PG8_STAGE(PG8_SA(1, 0), a3, voffA);
            PG8_BAR; PG8_WAIT_L(0); PG8_MMA(1, 0, At, B0); PG8_BAR; PG8_SCHED;
            PG8_STAGE(PG8_SB(1, 1), b3 + hstep, voffB);
            PG8_WAIT_V(6); PG8_BAR; PG8_MMA(1, 1, At, B1); PG8_BAR;
        }
        E(acc, cur, wr, wc, fr, fq, pre);
        if (!has_next) break;
#pragma unroll
        for (int a = 0; a < 2; ++a)
#pragma unroll
            for (int b = 0; b < 2; ++b)
#pragma unroll
                for (int m = 0; m < 4; ++m)
#pragma unroll
                    for (int n = 0; n < 2; ++n) acc[a][b][m][n] = (f32x4){0.f, 0.f, 0.f, 0.f};
        cur = nxt; cA = nA; cB = nB; ++ui;
    }
    PG8_WAIT_V(0);
    if (wr == 0) PG8_BAR;
    PG8_BAR;
#undef PG8_SA
#undef PG8_SB
#undef PG8_STAGE
#undef PG8_LDA
#undef PG8_LDB
#undef PG8_MMA
#undef PG8_WAIT_V
#undef PG8_WAIT_L
#undef PG8_BAR
#undef PG8_SCHED
}
}
PH unsigned short f2bf(float f) { unsigned u = __float_as_uint(f); u += 0x7fffu + ((u >> 16) & 1u); return (unsigned short)(u >> 16); }
PH float bf2f(unsigned short h) { return __uint_as_float((unsigned)h << 16); }
PH float bflo(unsigned w) { return __uint_as_float(w << 16); }
PH float bfhi(unsigned w) { return __uint_as_float(w & 0xffff0000u); }

PH void ph_copy(const Params& p) {
    const int n4x = NX * D / 4, n4 = NT * D / 4, st = GDIM() * NTHR;
    const float4* x4 = (const float4*)p.x; const float4* c4 = (const float4*)p.ctx; pg8::u32x2* h2 = (pg8::u32x2*)p.h;
    for (int i = BID() * NTHR + TID(); i < n4; i += 2 * st) {
        int j = i + st; const bool h1 = j < n4; j = h1 ? j : i;
        const float4 a = *(i < n4x ? x4 + i : c4 + (i - n4x)), b = *(j < n4x ? x4 + j : c4 + (j - n4x));
        pg8::u32x2 wa, wb; wa.x = pg8::cvt_pk_bf16(a.x, a.y); wa.y = pg8::cvt_pk_bf16(a.z, a.w); wb.x = pg8::cvt_pk_bf16(b.x, b.y); wb.y = pg8::cvt_pk_bf16(b.z, b.w);
        h2[i] = wa; if (h1) h2[j] = wb;
    }
}
PH void ph_ada(const Params& p, float* lds) {
    float* sc = lds;
    float* part = lds + 17 * 1024;
    const int tid = TID();
    for (int i = tid; i < 17 * 1024; i += NTHR) { const int r = i >> 10, k = i & 1023; const float v = r < 16 ? p.c[r * 1024 + k] : p.c_ctx[k]; sc[i] = v / (1.f + expf(-v)); }
    __syncthreads();
    for (int unit = BID(); unit < 4 * 96; unit += GDIM()) {
        const int l = unit / 96, cb = unit % 96, cl = tid & 63, ks = tid >> 6;
        const float* W = p.ada_w + (size_t)l * 1024 * MODW + cb * 64 + cl;
        float acc[17];
#pragma unroll
        for (int r = 0; r < 17; ++r) acc[r] = 0.f;
#pragma unroll 1
        for (int k = ks * 128; k < ks * 128 + 128; k += 16) {
            float w[16];
#pragma unroll
            for (int q = 0; q < 16; ++q) w[q] = W[(size_t)(k + q) * MODW];
#pragma unroll
            for (int q4 = 0; q4 < 4; ++q4)
#pragma unroll
                for (int r = 0; r < 17; ++r) { const float4 s4 = *(const float4*)(sc + r * 1024 + k + 4 * q4);
                    acc[r] += s4.x * w[4 * q4] + s4.y * w[4 * q4 + 1] + s4.z * w[4 * q4 + 2] + s4.w * w[4 * q4 + 3]; }
        }
#pragma unroll
        for (int r = 0; r < 17; ++r) part[(ks * 17 + r) * 64 + cl] = acc[r];
        __syncthreads();
        for (int i = tid; i < 17 * 64; i += NTHR) {
            const int r = i >> 6, cc = i & 63; float s = 0.f;
#pragma unroll
            for (int q = 0; q < 8; ++q) s += part[(q * 17 + r) * 64 + cc];
            p.mod[((size_t)l * 17 + r) * MODW + cb * 64 + cc] = s + p.ada_b[l * MODW + cb * 64 + cc];
        }
        __syncthreads();
    }
}
PH void ph_norm_mod(const bf16_t* h, const float* g, const float* modl, int sh_off, int sc_off, float* out, bf16_t* out16, int nrows) {
    const int lane = TID() & 63, wave = (BID() * NTHR + TID()) >> 6, nw = GDIM() * NWAVE;
    for (int r0 = wave; r0 < nrows; r0 += 2 * nw) {
        const int r1 = r0 + nw; const bool has1 = r1 < nrows;
        const pg8::u32x2* hp0 = (const pg8::u32x2*)(h + (size_t)r0 * D); const pg8::u32x2* hp1 = (const pg8::u32x2*)(h + (size_t)(has1 ? r1 : r0) * D);
        float4 v0[4], v1[4]; float ss0 = 0.f, ss1 = 0.f;
#pragma unroll
        for (int i = 0; i < 4; ++i) { const pg8::u32x2 a = hp0[lane + 64 * i], b = hp1[lane + 64 * i];
            v0[i] = make_float4(bflo(a.x), bfhi(a.x), bflo(a.y), bfhi(a.y)); v1[i] = make_float4(bflo(b.x), bfhi(b.x), bflo(b.y), bfhi(b.y)); }
#pragma unroll
        for (int i = 0; i < 4; ++i) { ss0 += v0[i].x * v0[i].x + v0[i].y * v0[i].y + v0[i].z * v0[i].z + v0[i].w * v0[i].w; ss1 += v1[i].x * v1[i].x + v1[i].y * v1[i].y + v1[i].z * v1[i].z + v1[i].w * v1[i].w; }
        ss0 = wave_sum(ss0); ss1 = wave_sum(ss1);
        const float* mra = modl + (size_t)mod_row(r0) * MODW; const float* mrb = modl + (size_t)mod_row(has1 ? r1 : r0) * MODW;
        float4 gq[4], sha[4], sca[4], shb[4], scb[4];
#pragma unroll
        for (int i = 0; i < 4; ++i) { const int col = (lane + 64 * i) * 4; gq[i] = *(const float4*)(g + col);
            sha[i] = *(const float4*)(mra + sh_off + col); sca[i] = *(const float4*)(mra + sc_off + col); shb[i] = *(const float4*)(mrb + sh_off + col); scb[i] = *(const float4*)(mrb + sc_off + col); }
#pragma unroll
        for (int rr = 0; rr < 2; ++rr) {
            if (rr == 1 && !has1) break;
            const int r = rr ? r1 : r0; const float rs = rsqrtf((rr ? ss1 : ss0) * (1.f / 1024.f) + 1e-5f);
#pragma unroll
            for (int i = 0; i < 4; ++i) {
                const int col = (lane + 64 * i) * 4; const float4 vv = rr ? v1[i] : v0[i];
                const float4 gg = gq[i];
                float4 o; o.x = vv.x * rs * gg.x; o.y = vv.y * rs * gg.y; o.z = vv.z * rs * gg.z; o.w = vv.w * rs * gg.w;
                {
                    const float4 sh = rr ? shb[i] : sha[i], sc = rr ? scb[i] : sca[i];
                    o.x = o.x * (1.f + sc.x) + sh.x; o.y = o.y * (1.f + sc.y) + sh.y; o.z = o.z * (1.f + sc.z) + sh.z; o.w = o.w * (1.f + sc.w) + sh.w;
                }
                if (out) *(float4*)(out + (size_t)r * D + col) = o;
                if (out16) { pg8::u32x2 w; w.x = pg8::cvt_pk_bf16(o.x, o.y); w.y = pg8::cvt_pk_bf16(o.z, o.w); *(pg8::u32x2*)(out16 + (size_t)r * D + col) = w; }
            }
        }
    }
}

PH void ph_resid_norm(bf16_t* h, const bf16_t* yx, const float* gate, const float* g, const float* modl, int sh_off, int sc_off, bf16_t* out16, int nrows) {
    const int lane = TID() & 63, wave = (BID() * NTHR + TID()) >> 6, nw = GDIM() * NWAVE;
    for (int r0 = wave; r0 < nrows; r0 += 2 * nw) {
        const int r1 = r0 + nw; const bool has1 = r1 < nrows; const int rb = has1 ? r1 : r0;
        float4 v0[4], v1[4]; pg8::u32x2 y0[4], y1[4];
#pragma unroll
        for (int i = 0; i < 4; ++i) { const pg8::u32x2 ha = ((const pg8::u32x2*)(h + (size_t)r0 * D))[lane + 64 * i], hb = ((const pg8::u32x2*)(h + (size_t)rb * D))[lane + 64 * i];
            v0[i] = make_float4(bflo(ha.x), bfhi(ha.x), bflo(ha.y), bfhi(ha.y)); v1[i] = make_float4(bflo(hb.x), bfhi(hb.x), bflo(hb.y), bfhi(hb.y));
            y0[i] = ((const pg8::u32x2*)(yx + (size_t)r0 * D))[lane + 64 * i]; y1[i] = ((const pg8::u32x2*)(yx + (size_t)rb * D))[lane + 64 * i]; }
        const float* g0p = gate + (size_t)mod_row(r0) * MODW; const float* g1p = gate + (size_t)mod_row(rb) * MODW;
        float4 ga[4], gb[4];
#pragma unroll
        for (int i = 0; i < 4; ++i) { const int col = (lane + 64 * i) * 4; ga[i] = *(const float4*)(g0p + col); gb[i] = *(const float4*)(g1p + col); }
        const float* mr0 = modl + (size_t)mod_row(r0) * MODW; const float* mr1 = modl + (size_t)mod_row(rb) * MODW;
        float4 gg[4], sh0[4], sc0[4], sh1[4], sc1[4];
#pragma unroll
        for (int i = 0; i < 4; ++i) { const int col = (lane + 64 * i) * 4; gg[i] = *(const float4*)(g + col);
            sh0[i] = *(const float4*)(mr0 + sh_off + col); sc0[i] = *(const float4*)(mr0 + sc_off + col); sh1[i] = *(const float4*)(mr1 + sh_off + col); sc1[i] = *(const float4*)(mr1 + sc_off + col); }
        float ss0 = 0.f, ss1 = 0.f;
#pragma unroll
        for (int i = 0; i < 4; ++i) {
            v0[i].x += ga[i].x * bflo(y0[i].x); v0[i].y += ga[i].y * bfhi(y0[i].x); v0[i].z += ga[i].z * bflo(y0[i].y); v0[i].w += ga[i].w * bfhi(y0[i].y);
            v1[i].x += gb[i].x * bflo(y1[i].x); v1[i].y += gb[i].y * bfhi(y1[i].x); v1[i].z += gb[i].z * bflo(y1[i].y); v1[i].w += gb[i].w * bfhi(y1[i].y);
            ss0 += v0[i].x * v0[i].x + v0[i].y * v0[i].y + v0[i].z * v0[i].z + v0[i].w * v0[i].w; ss1 += v1[i].x * v1[i].x + v1[i].y * v1[i].y + v1[i].z * v1[i].z + v1[i].w * v1[i].w; }
#pragma unroll
        for (int i = 0; i < 4; ++i) { pg8::u32x2 wa, wb; wa.x = pg8::cvt_pk_bf16(v0[i].x, v0[i].y); wa.y = pg8::cvt_pk_bf16(v0[i].z, v0[i].w); wb.x = pg8::cvt_pk_bf16(v1[i].x, v1[i].y); wb.y = pg8::cvt_pk_bf16(v1[i].z, v1[i].w);
            ((pg8::u32x2*)(h + (size_t)r0 * D))[lane + 64 * i] = wa; if (has1) ((pg8::u32x2*)(h + (size_t)r1 * D))[lane + 64 * i] = wb; }
        ss0 = wave_sum(ss0); ss1 = wave_sum(ss1);
#pragma unroll
        for (int rr = 0; rr < 2; ++rr) {
            if (rr == 1 && !has1) break;
            const int r = rr ? r1 : r0; const float rs = rsqrtf((rr ? ss1 : ss0) * (1.f / 1024.f) + 1e-5f);
#pragma unroll
            for (int i = 0; i < 4; ++i) {
                const int col = (lane + 64 * i) * 4; const float4 vv = rr ? v1[i] : v0[i]; const float4 sh = rr ? sh1[i] : sh0[i], sc = rr ? sc1[i] : sc0[i];
                float4 o; o.x = vv.x * rs * gg[i].x * (1.f + sc.x) + sh.x; o.y = vv.y * rs * gg[i].y * (1.f + sc.y) + sh.y; o.z = vv.z * rs * gg[i].z * (1.f + sc.z) + sh.z; o.w = vv.w * rs * gg[i].w * (1.f + sc.w) + sh.w;
                pg8::u32x2 w; w.x = pg8::cvt_pk_bf16(o.x, o.y); w.y = pg8::cvt_pk_bf16(o.z, o.w); *(pg8::u32x2*)(out16 + (size_t)r * D + col) = w;
            }
        }
    }
}

constexpr int GLDA = 132;
template <class ARow, class EPI>
PH void gemm_tile(float* lds, ARow arow, const float* __restrict__ B, int ldb, int N, int K, int m0, int n0, EPI epi) {
    float* As = lds; float* Bs = lds + 16 * GLDA;
    const int tid = TID(), ty = tid >> 4, tx = tid & 15;
    const int ar = tid >> 2, akq = (tid & 3) * 4;
    const float* ap = arow(m0 + ar);
    const int bk = (tid & 255) >> 4, bn = (tid & 15) * 4;
    const bool bload = tid < 256 && (n0 + bn) < N;
    float acc[4][4];
#pragma unroll
    for (int i = 0; i < 4; ++i)
#pragma unroll
        for (int j = 0; j < 4; ++j) acc[i][j] = 0.f;
    for (int k0 = 0; k0 < K; k0 += 16) {
        float4 av = make_float4(0.f, 0.f, 0.f, 0.f), bv = make_float4(0.f, 0.f, 0.f, 0.f);
        if (ap) av = *(const float4*)(ap + k0 + akq);
        if (bload) bv = *(const float4*)(B + (size_t)(k0 + bk) * ldb + n0 + bn);
        __syncthreads();
        As[(akq + 0) * GLDA + ar] = av.x; As[(akq + 1) * GLDA + ar] = av.y; As[(akq + 2) * GLDA + ar] = av.z; As[(akq + 3) * GLDA + ar] = av.w;
        if (tid < 256) *(float4*)&Bs[bk * 64 + bn] = bv;
        __syncthreads();
#pragma unroll
        for (int k = 0; k < 16; ++k) {
            const float4 a = *(const float4*)&As[k * GLDA + ty * 4];
            const float4 b = *(const float4*)&Bs[k * 64 + tx * 4];
            acc[0][0] += a.x * b.x; acc[0][1] += a.x * b.y; acc[0][2] += a.x * b.z; acc[0][3] += a.x * b.w;
            acc[1][0] += a.y * b.x; acc[1][1] += a.y * b.y; acc[1][2] += a.y * b.z; acc[1][3] += a.y * b.w;
            acc[2][0] += a.z * b.x; acc[2][1] += a.z * b.y; acc[2][2] += a.z * b.z; acc[2][3] += a.z * b.w;
            acc[3][0] += a.w * b.x; acc[3][1] += a.w * b.y; acc[3][2] += a.w * b.z; acc[3][3] += a.w * b.w;
        }
    }
    __syncthreads();
    const int col = n0 + tx * 4;
    if (col < N) {
#pragma unroll
        for (int i = 0; i < 4; ++i) epi(m0 + ty * 4 + i, col, make_float4(acc[i][0], acc[i][1], acc[i][2], acc[i][3]));
    }
}
PH void ph_gemm_plain(float* lds, const float* A, int lda, const float* B, int ldb, float* C, int ldc, int M, int N, int K) {
    const int nct = (N + 63) / 64, nunits = (M / 128) * nct;
    for (int u = BID(); u < nunits; u += GDIM()) {
        const int mt = u / nct, ct = u % nct;
        gemm_tile(lds, [&](int r) { return A + (size_t)r * lda; }, B, ldb, N, K, mt * 128, ct * 64,
                  [&](int row, int col, float4 v) { *(float4*)(C + (size_t)row * ldc + col) = v; });
    }
}
PH void ph_gemm_resid(float* lds, const float* A, const float* B, float* h, const float* modl, int gate_off) {
    const int nct = D / 64, nunits = (NT / 128) * nct;
    for (int u = BID(); u < nunits; u += GDIM()) {
        const int mt = u / nct, ct = u % nct;
        gemm_tile(lds, [&](int r) { return A + (size_t)r * D; }, B, D, D, D, mt * 128, ct * 64,
                  [&](int row, int col, float4 v) {
                      const float4 g = *(const float4*)(modl + (size_t)mod_row(row) * MODW + gate_off + col);
                      float4* hp = (float4*)(h + (size_t)row * D + col); float4 o = *hp;
                      o.x += g.x * v.x; o.y += g.y * v.y; o.z += g.z * v.z; o.w += g.w * v.w; *hp = o; });
    }
}

PH void ph_rope(float* px) {
    const size_t total = (size_t)NX * 480;
    for (size_t i = (size_t)BID() * NTHR + TID(); i < total; i += (size_t)GDIM() * NTHR) {
        const int r = (int)(i / 480), q5 = (int)(i % 480), hh = q5 >> 5, q = q5 & 31, a = q >> 4, f = q & 15;
        const int t = r & 2047, pos = a ? (t & 63) : (t >> 6);
        const float inv = powf(10000.f, -(float)f / 16.f);
        const float ang = (float)pos * inv, cs = cosf(ang), sn = sinf(ang);
        float* base = px + (size_t)r * EVEN_IN + 256 + hh * 64 + a * 32 + f;
        const float x1 = base[0], x2 = base[16];
        base[0] = x1 * cs - x2 * sn; base[16] = x2 * cs + x1 * sn;
    }
}
PH void ph_pool(const float* px, const float* pool_w, const float* pool_scale, bf16_t* mix) {
    const int lane = TID() & 63, wave = (BID() * NTHR + TID()) >> 6, nw = GDIM() * NWAVE;
    for (int task = wave; task < NT * 4; task += nw) {
        const int r = task >> 2, gi = task & 3; int s0, len, t; seq_info(r, s0, len, t);
        const int w = 2 << gi; int lo = t - w / 2, hi = t - w / 2 + w; lo = lo < 0 ? 0 : lo; hi = hi > len ? len : hi;
        float s = 0.f;
        for (int tt = lo; tt < hi; ++tt) s += px[(size_t)(s0 + tt) * EVEN_IN + gi * 64 + lane];
        const float pooled = s / (float)(hi - lo) - px[(size_t)r * EVEN_IN + gi * 64 + lane];
        const float* pw = pool_w + (size_t)gi * 4096;
        float acc = 0.f;
#pragma unroll 8
        for (int c = 0; c < 64; ++c) acc += __shfl(pooled, c) * pw[c * 64 + lane];
        mix[(size_t)r * D + gi * 64 + lane] = f2bf(acc * pool_scale[gi * 64 + lane]);
    }
}
PH void ph_attn(float* lds, const float* px, const float* sink, bf16_t* mix) {
    const int lane = TID() & 63, wib = TID() >> 6, wave = (BID() * NTHR + TID()) >> 6, nw = GDIM() * NWAVE;
    float* pb = lds + wib * 576;
    for (int task = wave; task < NT * 12; task += nw) {
        const int r = task / 12, hh = task % 12, kvh = hh >> 2;
        const bool lat = r < NX;
        const int b = lat ? (r >> 11) : ((r - NX) >> 8);
        int klo = 0, nloc = 0;
        if (lat) { const int t = r & 2047; klo = t - 128 < 0 ? 0 : t - 128; const int khi = t + 128 > 2047 ? 2047 : t + 128; nloc = khi - klo + 1; }
        const int nkeys = nloc + CTX;
        float q[64];
        const float* qp = px + (size_t)r * EVEN_IN + 256 + hh * 64;
#pragma unroll
        for (int d4 = 0; d4 < 16; ++d4) { const float4 v = *(const float4*)(qp + d4 * 4); q[d4 * 4] = v.x; q[d4 * 4 + 1] = v.y; q[d4 * 4 + 2] = v.z; q[d4 * 4 + 3] = v.w; }
        float mx = sink[hh];
        for (int kidx = lane; kidx < nkeys; kidx += 64) {
            const int krow = kidx < nloc ? (b * SEQ + klo + kidx) : (NX + b * CTX + (kidx - nloc));
            const float* kp = px + (size_t)krow * EVEN_IN + 1024 + kvh * 64;
            float s = 0.f;
#pragma unroll
            for (int d4 = 0; d4 < 16; ++d4) { const float4 v = *(const float4*)(kp + d4 * 4); s += q[d4 * 4] * v.x + q[d4 * 4 + 1] * v.y + q[d4 * 4 + 2] * v.z + q[d4 * 4 + 3] * v.w; }
            s *= 0.125f;
            pb[kidx] = s; mx = fmaxf(mx, s);
        }
        mx = wave_max(mx);
        float den = 0.f;
        for (int kidx = lane; kidx < nkeys; kidx += 64) { const float e = expf(pb[kidx] - mx); pb[kidx] = e; den += e; }
        den = wave_sum(den) + expf(sink[hh] - mx);
        __builtin_amdgcn_wave_barrier();
        float acc = 0.f;
        for (int kidx = 0; kidx < nkeys; ++kidx) {
            const int krow = kidx < nloc ? (b * SEQ + klo + kidx) : (NX + b * CTX + (kidx - nloc));
            acc += pb[kidx] * px[(size_t)krow * EVEN_IN + 1216 + kvh * 64 + lane];
        }
        mix[(size_t)r * D + 256 + hh * 64 + lane] = f2bf(acc / den);
        __builtin_amdgcn_wave_barrier();
    }
}


PH void ph_rope_tab(float* rc, float* rs) {
    const int i = BID() * NTHR + TID();
    if (i < 1024) { const int pos = i >> 4, f = i & 15; const float inv = powf(10000.f, -(float)f / 16.f), ang = (float)pos * inv; rc[i] = cosf(ang); rs[i] = sinf(ang); }
}
struct EpiRopeBf16 {
    static constexpr bool PERM = true;
    bf16_t* O; int ldc; const float* ct; const float* st;
    struct Pre {}; __device__ __forceinline__ Pre prefetch(const pg8::Unit&, int, int) const { return Pre{}; }
    __device__ __forceinline__ void operator()(const pg8::f32x4 (&acc)[2][2][4][2], const pg8::Unit& u, int wr, int wc, int fr, int fq, const Pre&) const {
        const int row0 = u.pm * 256 + wr * 64 + fr; const bool lat = u.pm * 256 < NX;
        const float sgn = fq < 2 ? -1.f : 1.f; const int f0 = 8 * (fq & 1);
#pragma unroll
        for (int ai = 0; ai < 2; ++ai)
#pragma unroll
            for (int m = 0; m < 4; ++m) { const int row = row0 + ai * 128 + m * 16, t = row & 2047;
#pragma unroll
                for (int bj = 0; bj < 2; ++bj) { const int cbase = u.pn * 256 + bj * 128 + wc * 32;
                    const pg8::f32x4 zz = (pg8::f32x4){0.f, 0.f, 0.f, 0.f};
                    pg8::f32x4 v0 = acc[ai][bj][m][0] + zz, v1 = acc[ai][bj][m][1] + zz;
                    if (lat && cbase >= 256 && cbase < 1216) {
                        const int pos = ((cbase >> 5) & 1) ? (t & 63) : (t >> 6);
                        const pg8::f32x4 c0 = *(const pg8::f32x4*)(ct + pos * 16 + f0), c1 = *(const pg8::f32x4*)(ct + pos * 16 + f0 + 4);
                        const pg8::f32x4 s0 = *(const pg8::f32x4*)(st + pos * 16 + f0) * sgn, s1 = *(const pg8::f32x4*)(st + pos * 16 + f0 + 4) * sgn;
                        pg8::f32x4 o0, o1;
#pragma unroll
                        for (int q = 0; q < 4; ++q) { o0[q] = __shfl_xor(v0[q], 32); o1[q] = __shfl_xor(v1[q], 32); }
                        v0 = v0 * c0 + o0 * s0; v1 = v1 * c1 + o1 * s1;
                    }
                    pg8::u32x4 w; w.x = pg8::cvt_pk_bf16(v0[0], v0[1]); w.y = pg8::cvt_pk_bf16(v0[2], v0[3]); w.z = pg8::cvt_pk_bf16(v1[0], v1[1]); w.w = pg8::cvt_pk_bf16(v1[2], v1[3]);
                    *(pg8::u32x4*)(O + (size_t)row * ldc + cbase + 8 * fq) = w; } }
    }
};
PH void ph_pool_prep(const float* pw, bf16_t* pwt) {
    for (int i = BID() * NTHR + TID(); i < 2 * 4 * 64 * 64; i += GDIM() * NTHR) { const int m = i >> 12, d = (i >> 6) & 63, c = i & 63; pwt[i] = f2bf(pw[(m << 12) + c * 64 + d]); }
}
template <int HALF>
PH void pool_window(const bf16_t* col, int t0, int len, LAS unsigned char* Pt, int lane) {
    float v[64 + 2 * HALF];
#pragma unroll
    for (int j = 0; j < 64 + 2 * HALF; ++j) { const int t = t0 - HALF + j; const bool in = t >= 0 && t < len; const float x = bf2f(col[(size_t)(in ? t : t0) * 1536]); v[j] = in ? x : 0.f; }
    float sum = 0.f;
#pragma unroll
    for (int j = 0; j < 2 * HALF; ++j) sum += v[j];
#pragma unroll
    for (int i = 0; i < 64; ++i) {
        const int t = t0 + i, lo = t - HALF < 0 ? 0 : t - HALF, hi = t + HALF > len ? len : t + HALF;
        *(LAS unsigned short*)(Pt + i * 144 + lane * 2) = f2bf(sum * __builtin_amdgcn_rcpf((float)(hi - lo)) - v[i + HALF]);
        sum += v[i + 2 * HALF] - v[i];
    }
}
PH void ph_pool16(LAS unsigned char* lsm, const bf16_t* px, const bf16_t* pwt, const float* pool_scale, bf16_t* mix) {
    const int lane = TID() & 63, wib = TID() >> 6, wave = BID() * NWAVE + wib, nw = GDIM() * NWAVE, fr = lane & 15, fq = lane >> 4;
    LAS unsigned char* Pt = lsm + STAGE_OFF + wib * (64 * 144);
    for (int task = wave; task < (NT / 64) * 4; task += nw) {
        const int r0 = (task >> 2) * 64, gi = task & 3; int s0, len, t0; seq_info(r0, s0, len, t0);
        const bf16_t* col = px + (size_t)s0 * 1536 + gi * 64 + lane;
        __builtin_amdgcn_wave_barrier();
        if (gi == 0) pool_window<1>(col, t0, len, Pt, lane); else if (gi == 1) pool_window<2>(col, t0, len, Pt, lane); else if (gi == 2) pool_window<4>(col, t0, len, Pt, lane); else pool_window<8>(col, t0, len, Pt, lane);
        __builtin_amdgcn_wave_barrier();
        pg8::bf16x8 wf[4][2];
#pragma unroll
        for (int nt = 0; nt < 4; ++nt)
#pragma unroll
            for (int ks = 0; ks < 2; ++ks) wf[nt][ks] = *(const pg8::bf16x8*)(pwt + (size_t)gi * 4096 + (16 * nt + fr) * 64 + 32 * ks + 8 * fq);
#pragma unroll
        for (int mt = 0; mt < 4; ++mt) {
            pg8::bf16x8 pf[2];
#pragma unroll
            for (int ks = 0; ks < 2; ++ks) pf[ks] = *(const LAS pg8::bf16x8*)(Pt + (16 * mt + fr) * 144 + (32 * ks + 8 * fq) * 2);
#pragma unroll
            for (int nt = 0; nt < 4; ++nt) {
                pg8::f32x4 acc = (pg8::f32x4){0.f, 0.f, 0.f, 0.f};
#pragma unroll
                for (int ks = 0; ks < 2; ++ks) acc = __builtin_amdgcn_mfma_f32_16x16x32_bf16(wf[nt][ks], pf[ks], acc, 0, 0, 0);
                const pg8::f32x4 sc = *(const pg8::f32x4*)(pool_scale + gi * 64 + 16 * nt + 4 * fq);
                const pg8::f32x4 v = acc * sc;
                pg8::u32x2 o; o.x = pg8::cvt_pk_bf16(v[0], v[1]); o.y = pg8::cvt_pk_bf16(v[2], v[3]);
                *(pg8::u32x2*)(mix + (size_t)(r0 + 16 * mt + fr) * D + gi * 64 + 16 * nt + 4 * fq) = o;
            }
        }
        __builtin_amdgcn_wave_barrier();
    }
    __syncthreads();
}
typedef short s16x4 __attribute__((ext_vector_type(4)));
typedef float f32x16 __attribute__((ext_vector_type(16)));
constexpr int AT_KP = 144, AT_VP = 192, AT_KB = 64 * AT_KP, AT_VB = 64 * AT_VP;
PH pg8::bf16x8 pack_bf16x8(float x0, float x1, float x2, float x3, float x4, float x5, float x6, float x7) {
    pg8::u32x4 pk; pk[0] = pg8::cvt_pk_bf16(x0, x1); pk[1] = pg8::cvt_pk_bf16(x2, x3); pk[2] = pg8::cvt_pk_bf16(x4, x5); pk[3] = pg8::cvt_pk_bf16(x6, x7);
    return __builtin_bit_cast(pg8::bf16x8, pk);
}
PH void ph_attn16(LAS unsigned char* lsm, const bf16_t* px, const float* sink, bf16_t* mix) {
    LAS unsigned char* base = lsm + STAGE_OFF;
    const int tid = TID(), lane = tid & 63, wid = __builtin_amdgcn_readfirstlane(tid >> 6), l31 = lane & 31, h = lane >> 5;
    const int skey = tid >> 3, spc = tid & 7;
    const int trq = (lane & 15) >> 2, trp = lane & 3, trblk = (lane >> 4) & 1;
    const float C = 0.125f * 1.4426950408889634f;
    for (int u = BID(); u < 1728; u += GDIM()) {
        int b, kvh, q0, nb, c_lo, qrow0;
        if (u < 1536) { b = u / 96; const int rem = u % 96; kvh = rem >> 5; q0 = (rem & 31) * 64;
            c_lo = (128 - q0 + 63) >> 6; c_lo = c_lo < 0 ? 0 : c_lo; int c_hi = (2112 - q0) >> 6; c_hi = c_hi > 4 ? 4 : c_hi; nb = c_hi - c_lo + 1; qrow0 = b * SEQ + q0; }
        else { const int v = u - 1536; b = v / 12; const int rem = v % 12; kvh = rem >> 2; q0 = 0; c_lo = 0; nb = 0; qrow0 = NX + b * CTX + (rem & 3) * 64; }
        const int n = nb + 4;
        const int hq = kvh * 4 + (wid >> 1), iq = 32 * (wid & 1) + l31;
        pg8::bf16x8 qf[4];
        { const bf16_t* qp = px + (size_t)(qrow0 + iq) * 1536 + 256 + hq * 64 + 8 * h;
#pragma unroll
          for (int s = 0; s < 4; ++s) qf[s] = *(const pg8::bf16x8*)(qp + 16 * s); }
        float mrun = sink[hq] * 1.4426950408889634f, lrun = h == 0 ? 1.f : 0.f;
        f32x16 o[2];
#pragma unroll
        for (int q = 0; q < 16; ++q) { o[0][q] = 0.f; o[1][q] = 0.f; }
        const size_t kcol = 1024 + kvh * 64 + spc * 8, vcol = 1216 + kvh * 64 + spc * 8;
        pg8::u32x4 kreg, vreg, kreg2, vreg2;
        auto kvload = [&](int kk, pg8::u32x4& kr, pg8::u32x4& vr) { kk = kk < n ? kk : n - 1;
            const int rowbase = kk < nb ? b * SEQ + q0 - 128 + 64 * (c_lo + kk) : NX + b * CTX + 64 * (kk - nb);
            const bf16_t* rp = px + (size_t)(rowbase + skey) * 1536; kr = *(const pg8::u32x4*)(rp + kcol); vr = *(const pg8::u32x4*)(rp + vcol); };
        kvload(0, kreg2, vreg2); kvload(1, kreg, vreg);
        *(LAS pg8::u32x4*)(base + skey * AT_KP + spc * 16) = kreg2;
        *(LAS pg8::u32x4*)(base + 2 * AT_KB + skey * AT_VP + spc * 16) = vreg2;
        __syncthreads();
        for (int k = 0; k < n; ++k) {
            int mtype = 0;
            if (k < nb) { const int c = c_lo + k; mtype = c == 0 ? 1 : (c == 4 ? 2 : 0); }
            kvload(k + 2, kreg2, vreg2);
            const LAS unsigned char* Kb = base + (k & 1) * AT_KB; const LAS unsigned char* Vb = base + 2 * AT_KB + (k & 1) * AT_VB;
            f32x16 st[2];
#pragma unroll
            for (int kt = 0; kt < 2; ++kt) {
#pragma unroll
                for (int q = 0; q < 16; ++q) st[kt][q] = 0.f;
#pragma unroll
                for (int s = 0; s < 4; ++s) { const pg8::bf16x8 a = *(const LAS pg8::bf16x8*)(Kb + (32 * kt + l31) * AT_KP + (16 * s + 8 * h) * 2);
                    st[kt] = __builtin_amdgcn_mfma_f32_32x32x16_bf16(a, qf[s], st[kt], 0, 0, 0); }
            }
            float mx = -1e30f;
#pragma unroll
            for (int kt = 0; kt < 2; ++kt)
#pragma unroll
                for (int r = 0; r < 16; ++r) { float t = st[kt][r] * C;
                    if (mtype) { const int j = 32 * kt + (r & 3) + 8 * (r >> 2) + 4 * h; const bool ok = mtype == 1 ? (j >= iq) : (j <= iq); t = ok ? t : -1e30f; }
                    st[kt][r] = t; mx = fmaxf(mx, t); }
            mx = fmaxf(mx, __shfl_xor(mx, 32));
            const float mnew = fmaxf(mrun, mx), alpha = __builtin_amdgcn_exp2f(mrun - mnew);
            mrun = mnew; lrun *= alpha;
#pragma unroll
            for (int q = 0; q < 16; ++q) { o[0][q] *= alpha; o[1][q] *= alpha; }
            float lsum = 0.f;
#pragma unroll
            for (int kt = 0; kt < 2; ++kt)
#pragma unroll
                for (int r = 0; r < 16; ++r) { const float pv = __builtin_amdgcn_exp2f(st[kt][r] - mnew); st[kt][r] = pv; lsum += pv; }
            lrun += lsum;
            pg8::bf16x8 pf[4];
#pragma unroll
            for (int ks = 0; ks < 4; ++ks) { const int kt = ks >> 1, s8 = (ks & 1) * 8;
                pf[ks] = pack_bf16x8(st[kt][s8], st[kt][s8 + 1], st[kt][s8 + 2], st[kt][s8 + 3], st[kt][s8 + 4], st[kt][s8 + 5], st[kt][s8 + 6], st[kt][s8 + 7]); }
#pragma unroll
            for (int dt = 0; dt < 2; ++dt)
#pragma unroll
                for (int ks = 0; ks < 4; ++ks) { const int k0 = 16 * ks + 4 * h + trq;
                    const LAS unsigned char* ap = Vb + k0 * AT_VP + (32 * dt + 16 * trblk + 4 * trp) * 2;
                    const s16x4 lo = __builtin_amdgcn_ds_read_tr16_b64_v4i16((LAS s16x4*)ap), hi = __builtin_amdgcn_ds_read_tr16_b64_v4i16((LAS s16x4*)(ap + 8 * AT_VP));
                    const pg8::bf16x8 vf = __builtin_shufflevector(lo, hi, 0, 1, 2, 3, 4, 5, 6, 7);
                    o[dt] = __builtin_amdgcn_mfma_f32_32x32x16_bf16(vf, pf[ks], o[dt], 0, 0, 0); }
            if (k + 1 < n) { *(LAS pg8::u32x4*)(base + ((k + 1) & 1) * AT_KB + skey * AT_KP + spc * 16) = kreg;
                             *(LAS pg8::u32x4*)(base + 2 * AT_KB + ((k + 1) & 1) * AT_VB + skey * AT_VP + spc * 16) = vreg; }
            kreg = kreg2; vreg = vreg2;
            asm volatile("s_waitcnt lgkmcnt(0)" ::: "memory"); __builtin_amdgcn_s_barrier(); asm volatile("" ::: "memory");
        }
        const float ltot = lrun + __shfl_xor(lrun, 32), inv = 1.f / ltot;
        bf16_t* op = mix + (size_t)(qrow0 + iq) * D + 256 + hq * 64 + 4 * h;
#pragma unroll
        for (int dt = 0; dt < 2; ++dt)
#pragma unroll
            for (int rg = 0; rg < 4; ++rg) { pg8::u32x2 w; w.x = pg8::cvt_pk_bf16(o[dt][4 * rg] * inv, o[dt][4 * rg + 1] * inv); w.y = pg8::cvt_pk_bf16(o[dt][4 * rg + 2] * inv, o[dt][4 * rg + 3] * inv);
                *(pg8::u32x2*)(op + 32 * dt + 8 * rg) = w; }
    }
}
PH void ph_scanprep(float* lds, const float* px, const OddW& w, const ScanArrays& sa) {
    float* fl = lds;
    float* hs = lds + 2720;
    const int tid = TID(), lane = tid & 63, wv = tid >> 6;
    for (int r = BID(); r < NT; r += GDIM()) {
        int s0, len, t; seq_info(r, s0, len, t);
        const float* pr = px + (size_t)r * ODD_IN;
        for (int col = tid; col < 2720; col += NTHR) {
            const float u = pr[col], pv = t > 0 ? pr[col - ODD_IN] : 0.f, nx = t < len - 1 ? pr[col + ODD_IN] : 0.f;
            float f = u + w.mu[col] * (pv - u) + w.mu[2720 + col] * (nx - u);
            if (col >= 2304 && col < 2432) f = tanhf(f);
            if (col >= 2560) f = sigmoidf_(f);
            fl[col] = f;
        }
        __syncthreads();
        float kkr[2] = {0.f, 0.f};
#pragma unroll
        for (int i = 0; i < 2; ++i) { const int c = tid + NTHR * i; if (c < RW) { kkr[i] = fl[768 + c] * w.k_k[c]; const float ss = wave_sum(kkr[i] * kkr[i]); if (lane == 0) hs[8 * i + wv] = ss; } }
        __syncthreads();
#pragma unroll
        for (int i = 0; i < 2; ++i) {
            const int c = tid + NTHR * i;
            if (c < RW) {
                const int head = c >> 6;
                float lw0 = w.w0[c], lw1 = w.w0[768 + c], la0 = w.a0[c], la1 = w.a0[768 + c], gg = 0.f;
                for (int j = 0; j < 64; ++j) {
                    lw0 += fl[2304 + j] * w.w2[(size_t)j * 768 + c];
                    lw1 += fl[2368 + j] * w.w2[(size_t)(64 + j) * 768 + c];
                    la0 += fl[2432 + j] * w.a2[(size_t)j * 768 + c];
                    la1 += fl[2496 + j] * w.a2[(size_t)(64 + j) * 768 + c];
                }
                for (int j = 0; j < 160; ++j) gg += fl[2560 + j] * w.g2[(size_t)j * 768 + c];
                const float kk = kkr[i] / fmaxf(sqrtf(hs[head]), 1e-12f);
                const float k = fl[768 + c], v = fl[1536 + c], rr = fl[c], ka = w.k_a[c];
                const size_t o = (size_t)r * RW + c;
                sa.R[o] = rr; sa.V[o] = v; sa.KK[o] = kk; sa.G[o] = gg;
                const float z0 = -lw0, sp0 = fmaxf(z0, 0.f) + log1pf(expf(-fabsf(z0))); const float wl0 = -sp0 - 0.5f;
                const float z1 = -lw1, sp1 = fmaxf(z1, 0.f) + log1pf(expf(-fabsf(z1))); const float wl1 = -sp1 - 0.5f;
                sa.W[0][o] = expf(-expf(wl0)); sa.W[1][o] = expf(-expf(wl1));
                const float a_0 = sigmoidf_(la0), a_1 = sigmoidf_(la1);
                sa.KD[0][o] = k * (1.f + (a_0 - 1.f) * ka); sa.KD[1][o] = k * (1.f + (a_1 - 1.f) * ka);
                sa.BB[0][o] = kk * a_0; sa.BB[1][o] = kk * a_1;
            }
        }
        __syncthreads();
    }
}
PH void ph_scan(float* lds, const ScanArrays& sa) {
    const int lane = TID() & 63, wib = TID() >> 6;
    const int chain = BID() * NWAVE + wib;
    if (chain >= NB * 12 * 2) return;
    float* sh = lds + wib * 320;
    const int dir = chain & 1, bh = chain >> 1, b = bh / 12, hh = bh % 12;
    const float* Wd = sa.W[dir]; const float* KD = sa.KD[dir]; const float* BB = sa.BB[dir]; float* Y = sa.Y[dir];
    float S[64];
#pragma unroll
    for (int j = 0; j < 64; ++j) S[j] = 0.f;
    for (int s = 0; s < CTX + SEQ; ++s) {
        int tok;
        if (s < CTX) { const int tt = dir ? CTX - 1 - s : s; tok = NX + b * CTX + tt; }
        else { int tt = s - CTX; tt = dir ? SEQ - 1 - tt : tt; tok = b * SEQ + tt; }
        const size_t off = (size_t)tok * RW + hh * 64 + lane;
        const float v = sa.V[off];
        __builtin_amdgcn_wave_barrier();
        sh[lane] = Wd[off]; sh[64 + lane] = KD[off]; sh[128 + lane] = BB[off]; sh[192 + lane] = sa.KK[off]; sh[256 + lane] = sa.R[off];
        __builtin_amdgcn_wave_barrier();
        float sacc = 0.f;
#pragma unroll
        for (int j = 0; j < 64; ++j) sacc += S[j] * sh[192 + j];
#pragma unroll
        for (int j = 0; j < 64; ++j) S[j] = S[j] * sh[j] + (v * sh[64 + j] - sacc * sh[128 + j]);
        float y = 0.f;
#pragma unroll
        for (int j = 0; j < 64; ++j) y += S[j] * sh[256 + j];
        Y[off] = y;
    }
}
PH void ph_readout(const ScanArrays& sa, const OddW& w, bf16_t* mix) {
    const int lane = TID() & 63, wave = (BID() * NTHR + TID()) >> 6, nw = GDIM() * NWAVE;
    for (int task = wave; task < NT * 12; task += nw) {
        const int r = task / 12, hh = task % 12, c = hh * 64 + lane;
        const size_t o = (size_t)r * RW + c;
        const float y = sa.Y[0][o] + sa.Y[1][o];
        const float mean = wave_sum(y) * (1.f / 64.f), d = y - mean, var = wave_sum(d * d) * (1.f / 64.f);
        const float yn = d * rsqrtf(var + 64e-5f) * w.gn_g[c] + w.gn_b[c];
        const float coef = wave_sum(sa.R[o] * (sa.KD[0][o] + sa.KD[1][o]) * w.r_k[c]);
        mix[(size_t)r * D + c] = f2bf((yn + coef * sa.V[o]) * sa.G[o]);
    }
}
PH void ph_fft_tab(bf16_t* tabT) {
    const int i = BID() * NTHR + TID();
    if (i < 128 * 64) { const int col = i >> 6, c = i & 63, part = col >> 6, k2 = col & 63; const float fr_ = (float)((k2 * c) & 63) / 64.f; tabT[i] = f2bf(part ? __builtin_amdgcn_sinf(fr_) : __builtin_amdgcn_cosf(fr_)); }
}
PH void ph_fft_prep16(const bf16_t* px, const bf16_t* tabT, bf16_t* bt_lat, bf16_t* bt_ctx) {
    const int lane = TID() & 63, fr = lane & 15, fq = lane >> 4, wave = (BID() * NTHR + TID()) >> 6, nw = GDIM() * NWAVE;
    for (int task = wave; task < (NT / 16) * 4; task += nw) {
        const int r0 = (task >> 2) * 16, g = task & 3;
        pg8::bf16x8 uf[2];
#pragma unroll
        for (int ks = 0; ks < 2; ++ks) uf[ks] = *(const pg8::bf16x8*)(px + (size_t)(r0 + fr) * 3072 + 2720 + g * 64 + 32 * ks + 8 * fq);
        bf16_t* base; int T, t;
        if (r0 < NX) { const int b = r0 >> 11; t = r0 & 2047; T = 2048; base = bt_lat + (size_t)(b * 4 + g) * 64 * 4096; }
        else { const int q = r0 - NX, b = q >> 8; t = q & 255; T = 256; base = bt_ctx + (size_t)(b * 4 + g) * 64 * 512; }
#pragma unroll
        for (int nt = 0; nt < 8; ++nt) {
            pg8::f32x4 acc = (pg8::f32x4){0.f, 0.f, 0.f, 0.f};
#pragma unroll
            for (int ks = 0; ks < 2; ++ks) { const pg8::bf16x8 tf = *(const pg8::bf16x8*)(tabT + (size_t)(16 * nt + fr) * 64 + 32 * ks + 8 * fq);
                acc = __builtin_amdgcn_mfma_f32_16x16x32_bf16(uf[ks], tf, acc, 0, 0, 0); }
            const int col = 16 * nt + fr, part = col >> 6, k2 = col & 63;
            pg8::u32x2 o; o.x = (unsigned)f2bf(acc[0]) | ((unsigned)f2bf(acc[1]) << 16); o.y = (unsigned)f2bf(acc[2]) | ((unsigned)f2bf(acc[3]) << 16);
            *(pg8::u32x2*)(base + (size_t)k2 * 2 * T + part * T + t + 4 * fq) = o;
        }
    }
}
PH void ph_twiddle16(bf16_t* tw, int T) {
    const size_t total = (size_t)T * T;
    for (size_t i = (size_t)BID() * NTHR + TID(); i < total; i += (size_t)GDIM() * NTHR) {
        const int k1 = (int)(i / T), t = (int)(i % T); const int m = (int)(((long long)k1 * t) % T);
        const float fr_ = (float)m / (float)T;
        tw[(size_t)k1 * 2 * T + t] = f2bf(__builtin_amdgcn_cosf(fr_)); tw[(size_t)k1 * 2 * T + T + t] = f2bf(-__builtin_amdgcn_sinf(fr_));
    }
}
struct DenseOrder : pg8::TileOrder { __device__ __forceinline__ bool next(int i, pg8::Unit& u) const { u.e = 0; return tile(i, u.pm, u.pn); } };
struct EpiF32Guard {
    static constexpr bool PERM = false;
    float* C; int ldc, ncols;
    __device__ __forceinline__ void operator()(const pg8::f32x4 (&acc)[2][2][4][2], const pg8::Unit& u, int wr, int wc, int fr, int fq) const {
        const int row0 = u.pm * 256 + wr * 64 + fr, col0 = u.pn * 256 + wc * 32 + 4 * fq;
#pragma unroll
        for (int ai = 0; ai < 2; ++ai)
#pragma unroll
            for (int m = 0; m < 4; ++m) { float* rowp = C + (size_t)(row0 + ai * 128 + m * 16) * ldc;
#pragma unroll
                for (int bj = 0; bj < 2; ++bj)
#pragma unroll
                    for (int n = 0; n < 2; ++n) { const int c = col0 + bj * 128 + n * 16; if (c < ncols) *(pg8::f32x4*)(rowp + c) = acc[ai][bj][m][n]; } }
    }
};
struct EpiResid {
    static constexpr bool PERM = false;
    float* h; const float* gate;
    __device__ __forceinline__ void operator()(const pg8::f32x4 (&acc)[2][2][4][2], const pg8::Unit& u, int wr, int wc, int fr, int fq) const {
        const int row0 = u.pm * 256 + wr * 64 + fr, col0 = u.pn * 256 + wc * 32 + 4 * fq;
#pragma unroll
        for (int ai = 0; ai < 2; ++ai)
#pragma unroll
            for (int m = 0; m < 4; ++m) { const int row = row0 + ai * 128 + m * 16; float* rowp = h + (size_t)row * D; const float* gp = gate + (size_t)mod_row(row) * MODW;
#pragma unroll
                for (int bj = 0; bj < 2; ++bj)
#pragma unroll
                    for (int n = 0; n < 2; ++n) { const int c = col0 + bj * 128 + n * 16; const pg8::f32x4 g = *(const pg8::f32x4*)(gp + c); pg8::f32x4* hp = (pg8::f32x4*)(rowp + c); *hp = *hp + g * acc[ai][bj][m][n]; } }
    }
};
struct EpiDft {
    static constexpr bool PERM = true;
    bf16_t* mix; int T, row0; float scale;
    struct Pre {}; __device__ __forceinline__ Pre prefetch(const pg8::Unit&, int, int) const { return Pre{}; }
    __device__ __forceinline__ void operator()(const pg8::f32x4 (&acc)[2][2][4][2], const pg8::Unit& u, int wr, int wc, int fr, int fq, const Pre&) const {
        const int r0 = u.pm * 256 + wr * 64 + fr, col0 = u.pn * 256 + wc * 32 + 8 * fq;
#pragma unroll
        for (int ai = 0; ai < 2; ++ai)
#pragma unroll
            for (int m = 0; m < 4; ++m) { const int k1 = r0 + ai * 128 + m * 16;
#pragma unroll
                for (int bj = 0; bj < 2; ++bj) { const int c = col0 + bj * 128, bg = c >> 6, k2 = c & 63, b = bg >> 2, g = bg & 3;
                    const pg8::f32x4 v0 = acc[ai][bj][m][0] * scale, v1 = acc[ai][bj][m][1] * scale;
                    pg8::u32x4 w; w.x = pg8::cvt_pk_bf16(v0[0], v0[1]); w.y = pg8::cvt_pk_bf16(v0[2], v0[3]); w.z = pg8::cvt_pk_bf16(v1[0], v1[1]); w.w = pg8::cvt_pk_bf16(v1[2], v1[3]);
                    *(pg8::u32x4*)(mix + (size_t)(row0 + b * T + k1) * D + 768 + g * 64 + k2) = w; } }
    }
};
struct EpiPlainBf16 {
    static constexpr bool PERM = true;
    bf16_t* O; int ldc;
    struct Pre {}; __device__ __forceinline__ Pre prefetch(const pg8::Unit&, int, int) const { return Pre{}; }
    __device__ __forceinline__ void operator()(const pg8::f32x4 (&acc)[2][2][4][2], const pg8::Unit& u, int wr, int wc, int fr, int fq, const Pre&) const {
        const int row0 = u.pm * 256 + wr * 64 + fr, col0 = u.pn * 256 + wc * 32 + 8 * fq;
#pragma unroll
        for (int ai = 0; ai < 2; ++ai)
#pragma unroll
            for (int m = 0; m < 4; ++m) { bf16_t* rowp = O + (size_t)(row0 + ai * 128 + m * 16) * ldc + col0;
#pragma unroll
                for (int bj = 0; bj < 2; ++bj) { const pg8::f32x4 zz = (pg8::f32x4){0.f, 0.f, 0.f, 0.f}; const pg8::f32x4 v0 = acc[ai][bj][m][0] + zz, v1 = acc[ai][bj][m][1] + zz;
                    pg8::u32x4 w; w.x = pg8::cvt_pk_bf16(v0[0], v0[1]); w.y = pg8::cvt_pk_bf16(v0[2], v0[3]); w.z = pg8::cvt_pk_bf16(v1[0], v1[1]); w.w = pg8::cvt_pk_bf16(v1[2], v1[3]);
                    *(pg8::u32x4*)(rowp + bj * 128) = w; } }
    }
};
template <class Epi>
PH void ph_gemm16(LAS unsigned char* smem, const bf16_t* A, const bf16_t* Bt, int M, int N, int K, const Epi& E, int blk, int nblk) {
    DenseOrder S; S.init(M / 256, N / 256, nblk, blk);
    pg8::Gemm g; g.A = A; g.Bt = Bt; g.M = M; g.N = N; g.K = K; g.bgstride = 0;
    pg8::gemm_phase(smem + STAGE_OFF, g, S, E);
}

PH void ph_convT_small(const float* src, bf16_t* dst, int K, int N, int nmat) {
    const size_t total = (size_t)nmat * K * N;
    for (size_t i = (size_t)BID() * NTHR + TID(); i < total; i += (size_t)GDIM() * NTHR) {
        const int mat = (int)(i / ((size_t)K * N)), rem = (int)(i % ((size_t)K * N)), n = rem / K, k = rem % K;
        dst[i] = f2bf(src[((size_t)mat * K + k) * N + n]);
    }
}
PH void unpack8(const pg8::u32x4 w, float (&f)[8]) { f[0] = bflo(w.x); f[1] = bfhi(w.x); f[2] = bflo(w.y); f[3] = bfhi(w.y); f[4] = bflo(w.z); f[5] = bfhi(w.z); f[6] = bflo(w.w); f[7] = bfhi(w.w); }
PH pg8::u32x4 pack8(const float (&f)[8]) { pg8::u32x4 w; w.x = pg8::cvt_pk_bf16(f[0], f[1]); w.y = pg8::cvt_pk_bf16(f[2], f[3]); w.z = pg8::cvt_pk_bf16(f[4], f[5]); w.w = pg8::cvt_pk_bf16(f[6], f[7]); return w; }
constexpr int OP_LP = 848, OP_TOK = 144;
template <int KS, int NT0, int NTN>
PH void oddprep_seg(LAS unsigned char* Lt, const bf16_t* Wt, int Kw, int koff, const float* bias, float sc, bool sig, bf16_t* outp, int t0, int wid, int fr, int fq) {
    pg8::bf16x8 wf[NTN][KS];
#pragma unroll
    for (int nt = 0; nt < NTN; ++nt)
#pragma unroll
        for (int ks = 0; ks < KS; ++ks) wf[nt][ks] = *(const pg8::bf16x8*)(Wt + (size_t)(96 * wid + 16 * NT0 + 32 * (nt >> 1) + 8 * (fr >> 2) + 4 * (nt & 1) + (fr & 3)) * Kw + 32 * ks + 8 * fq);
    pg8::f32x4 bv[NTN];
#pragma unroll
    for (int nt = 0; nt < NTN; ++nt) bv[nt] = bias ? *(const pg8::f32x4*)(bias + 96 * wid + 16 * NT0 + 32 * (nt >> 1) + 8 * fq + 4 * (nt & 1)) : (pg8::f32x4){0.f, 0.f, 0.f, 0.f};
#pragma unroll 1
    for (int mt = 0; mt < OP_TOK / 16; ++mt) {
        pg8::bf16x8 lf[KS];
#pragma unroll
        for (int ks = 0; ks < KS; ++ks) lf[ks] = *(const LAS pg8::bf16x8*)(Lt + (16 * mt + fr) * OP_LP + (koff + 32 * ks + 8 * fq) * 2);
#pragma unroll
        for (int np = 0; np < NTN / 2; ++np) {
            pg8::f32x4 v[2];
#pragma unroll
            for (int hh = 0; hh < 2; ++hh) {
                pg8::f32x4 acc = (pg8::f32x4){0.f, 0.f, 0.f, 0.f};
#pragma unroll
                for (int ks = 0; ks < KS; ++ks) acc = __builtin_amdgcn_mfma_f32_16x16x32_bf16(wf[2 * np + hh][ks], lf[ks], acc, 0, 0, 0);
                v[hh] = acc + bv[2 * np + hh];
                if (sig) {
#pragma unroll
                    for (int q = 0; q < 4; ++q) v[hh][q] = sc * __builtin_amdgcn_rcpf(1.f + __builtin_amdgcn_exp2f(-1.4426950408889634f * v[hh][q])); }
            }
            pg8::u32x4 o; o.x = pg8::cvt_pk_bf16(v[0][0], v[0][1]); o.y = pg8::cvt_pk_bf16(v[0][2], v[0][3]); o.z = pg8::cvt_pk_bf16(v[1][0], v[1][1]); o.w = pg8::cvt_pk_bf16(v[1][2], v[1][3]);
            *(pg8::u32x4*)(outp + (size_t)(t0 + 16 * mt + fr) * RW + 96 * wid + 16 * NT0 + 32 * np + 8 * fq) = o;
        }
    }
}
PH void ph_oddprep(LAS unsigned char* lsm, const bf16_t* px, const OddW& w, const bf16_t* w2t, const bf16_t* a2t, const bf16_t* g2t, const ScanIn& si) {
    LAS unsigned char* Lt = lsm + STAGE_OFF;
    const int tid = TID(), lane = tid & 63, wid = __builtin_amdgcn_readfirstlane(tid >> 6), fr = lane & 15, fq = lane >> 4;
    for (int unit = BID(); unit < NT / OP_TOK; unit += GDIM()) {
        const int t0 = unit * OP_TOK;
        __syncthreads();
        const int tbase = t0 + wid * (OP_TOK / 8);
#pragma unroll 1
        for (int it = 0; it < 6; ++it) {
            const int idx = it * 64 + lane; const bool act = idx < 340; const int col0 = (act ? idx : 339) * 8;
            const float4 m0a = *(const float4*)(w.mu + col0), m0b = *(const float4*)(w.mu + col0 + 4), m1a = *(const float4*)(w.mu + 2720 + col0), m1b = *(const float4*)(w.mu + 2720 + col0 + 4);
            const float mu0[8] = {m0a.x, m0a.y, m0a.z, m0a.w, m0b.x, m0b.y, m0b.z, m0b.w}, mu1[8] = {m1a.x, m1a.y, m1a.z, m1a.w, m1b.x, m1b.y, m1b.z, m1b.w};
#pragma unroll 1
            for (int hf = 0; hf < 2; ++hf) {
            pg8::u32x4 rw[OP_TOK / 16 + 2];
#pragma unroll
            for (int j = 0; j < OP_TOK / 16 + 2; ++j) { int rr = tbase + hf * (OP_TOK / 16) - 1 + j; rr = rr < 0 ? 0 : (rr > NT - 1 ? NT - 1 : rr); rw[j] = *(const pg8::u32x4*)(px + (size_t)rr * 3072 + col0); }
#pragma unroll
            for (int tl = 0; tl < OP_TOK / 16; ++tl) {
                const int tloc = wid * (OP_TOK / 8) + hf * (OP_TOK / 16) + tl, r = t0 + tloc; int s0, len, t; seq_info(r, s0, len, t);
                const float fpv = t > 0 ? 1.f : 0.f, fnx = t < len - 1 ? 1.f : 0.f;
                float u[8], pv[8], nx[8], f[8];
                unpack8(rw[tl + 1], u); unpack8(rw[tl], pv); unpack8(rw[tl + 2], nx);
#pragma unroll
                for (int q = 0; q < 8; ++q) f[q] = u[q] + mu0[q] * (pv[q] * fpv - u[q]) + mu1[q] * (nx[q] * fnx - u[q]);
                if (col0 < 768) { *(pg8::u32x4*)(si.R + (size_t)r * RW + col0) = pack8(f); }
                else if (col0 < 1536) { const int c = col0 - 768;
                    *(pg8::u32x4*)(si.K + (size_t)r * RW + c) = pack8(f); }
                else if (col0 < 2304) { *(pg8::u32x4*)(si.V + (size_t)r * RW + col0 - 1536) = pack8(f); }
                else if (act) { const int jj = col0 - 2304;
                    if (jj < 128) { for (int q = 0; q < 8; ++q) f[q] = 1.f - 2.f * __builtin_amdgcn_rcpf(1.f + __builtin_amdgcn_exp2f(2.8853900817779268f * f[q])); }
                    else if (jj >= 256) { for (int q = 0; q < 8; ++q) f[q] = __builtin_amdgcn_rcpf(1.f + __builtin_amdgcn_exp2f(-1.4426950408889634f * f[q])); }
                    *(LAS pg8::u32x4*)(Lt + tloc * OP_LP + jj * 2) = pack8(f); }
            }
            }
        }
        __syncthreads();
        SUBSTAMP_L(lsm, 27);
        oddprep_seg<2, 0, 6>(Lt, w2t, 64, 0, w.w0, 0.6065306597126334f, true, si.X[0], t0, wid, fr, fq);
        oddprep_seg<2, 0, 6>(Lt, w2t + (size_t)768 * 64, 64, 64, w.w0 + 768, 0.6065306597126334f, true, si.X[1], t0, wid, fr, fq);
        oddprep_seg<2, 0, 6>(Lt, a2t, 64, 128, w.a0, 1.f, true, si.A[0], t0, wid, fr, fq);
        oddprep_seg<2, 0, 6>(Lt, a2t + (size_t)768 * 64, 64, 192, w.a0 + 768, 1.f, true, si.A[1], t0, wid, fr, fq);
        oddprep_seg<5, 0, 2>(Lt, g2t, 160, 256, nullptr, 1.f, false, si.G, t0, wid, fr, fq);
        oddprep_seg<5, 2, 2>(Lt, g2t, 160, 256, nullptr, 1.f, false, si.G, t0, wid, fr, fq);
        oddprep_seg<5, 4, 2>(Lt, g2t, 160, 256, nullptr, 1.f, false, si.G, t0, wid, fr, fq);
    }
    __syncthreads();
}
PH float quad_sum(float v) {
    v += __builtin_bit_cast(float, __builtin_amdgcn_update_dpp(0, __builtin_bit_cast(int, v), 0xB1, 0xF, 0xF, true));
    v += __builtin_bit_cast(float, __builtin_amdgcn_update_dpp(0, __builtin_bit_cast(int, v), 0x4E, 0xF, 0xF, true));
    return v;
}

constexpr int RS_WAVES = NB * 12 * 2 * 2, RS_BLOCKS = RS_WAVES / 4;
PH void ph_scan_rs(LAS unsigned char* lsm, const ScanIn& si, const float* k_a) {
    const int tid = TID(), lane = tid & 63, wib = tid >> 6, gw = BID() * 4 + wib;
    if (wib >= 4 || gw >= RS_WAVES) return;
    LAS float* sh = (LAS float*)(lsm + STAGE_OFF + wib * 12288);
    const int chain = gw >> 1, hw = gw & 1, dir = chain & 1, bh = chain >> 1, b = bh / 12, hh = bh % 12, cb = lane & 3, r = lane >> 2, row0 = 32 * hw + r;
    const int sl = lane >> 4, cq = lane & 15;
    const bf16_t* Xd = si.X[dir]; const bf16_t* Ad = si.A[dir]; float* Y = si.Y[dir];
    const pg8::f32x4 ka4 = *(const pg8::f32x4*)(k_a + hh * 64 + 4 * cq);
    const int N = CTX + SEQ, NG = N / 4;
    auto tok_of = [&](int s) { int tk; if (s < CTX) { const int tt = dir ? CTX - 1 - s : s; tk = NX + b * CTX + tt; } else { int tt = s - CTX; tt = dir ? SEQ - 1 - tt : tt; tk = b * SEQ + tt; } return tk; };
    struct Raw { pg8::u32x2 x, a, k, kk, r, v; };
    auto gload = [&](int g, Raw& q) { g = g < NG ? g : NG - 1; const size_t off = (size_t)tok_of(4 * g + sl) * RW + hh * 64 + 4 * cq;
        q.x = *(const pg8::u32x2*)(Xd + off); q.a = *(const pg8::u32x2*)(Ad + off); q.k = *(const pg8::u32x2*)(si.K + off);
        q.kk = *(const pg8::u32x2*)(si.KK + off); q.r = *(const pg8::u32x2*)(si.R + off); q.v = *(const pg8::u32x2*)(si.V + off); };
    auto stage = [&](int gp, const Raw& q) { LAS float* d = sh + (gp * 4 + sl) * 384 + 4 * cq;
        const pg8::f32x4 x = (pg8::f32x4){bflo(q.x.x), bfhi(q.x.x), bflo(q.x.y), bfhi(q.x.y)}, a = (pg8::f32x4){bflo(q.a.x), bfhi(q.a.x), bflo(q.a.y), bfhi(q.a.y)};
        const pg8::f32x4 k = (pg8::f32x4){bflo(q.k.x), bfhi(q.k.x), bflo(q.k.y), bfhi(q.k.y)}, kk = (pg8::f32x4){bflo(q.kk.x), bfhi(q.kk.x), bflo(q.kk.y), bfhi(q.kk.y)};
        pg8::f32x4 w;
#pragma unroll
        for (int i = 0; i < 4; ++i) w[i] = __builtin_amdgcn_exp2f(-x[i] * 1.4426950408889634f);
        *(LAS pg8::f32x4*)(d) = w; *(LAS pg8::f32x4*)(d + 64) = k * ((a - 1.f) * ka4 + 1.f); *(LAS pg8::f32x4*)(d + 128) = kk * a; *(LAS pg8::f32x4*)(d + 192) = kk;
        *(LAS pg8::f32x4*)(d + 256) = (pg8::f32x4){bflo(q.r.x), bfhi(q.r.x), bflo(q.r.y), bfhi(q.r.y)}; *(LAS pg8::f32x4*)(d + 320) = (pg8::f32x4){bflo(q.v.x), bfhi(q.v.x), bflo(q.v.y), bfhi(q.v.y)}; };
    typedef float f32x2 __attribute__((ext_vector_type(2)));
    f32x2 Sa[8], Sb[8];
#pragma unroll
    for (int c = 0; c < 8; ++c) { Sa[c] = (f32x2){0.f, 0.f}; Sb[c] = (f32x2){0.f, 0.f}; }
    f32x2 kq[8]; float va, vb;
    auto pre_kk = [&](int rec) { const LAS float* d = sh + rec * 384;
#pragma unroll
        for (int c4 = 0; c4 < 4; ++c4) { const pg8::f32x4 t = *(const LAS pg8::f32x4*)(d + 192 + 16 * cb + 4 * c4); kq[2 * c4] = (f32x2){t[0], t[1]}; kq[2 * c4 + 1] = (f32x2){t[2], t[3]}; }
        va = d[320 + row0]; vb = d[320 + row0 + 16]; };
    auto step = [&](int s, int rec, int nrec) {
        const LAS float* d = sh + rec * 384 + 16 * cb;
        f32x2 wv[8], kd[8], bb[8], rr[8];
#pragma unroll
        for (int c4 = 0; c4 < 4; ++c4) {
            const pg8::f32x4 t0 = *(const LAS pg8::f32x4*)(d + 4 * c4), t1 = *(const LAS pg8::f32x4*)(d + 64 + 4 * c4), t2 = *(const LAS pg8::f32x4*)(d + 128 + 4 * c4), t4 = *(const LAS pg8::f32x4*)(d + 256 + 4 * c4);
            wv[2 * c4] = (f32x2){t0[0], t0[1]}; wv[2 * c4 + 1] = (f32x2){t0[2], t0[3]}; kd[2 * c4] = (f32x2){t1[0], t1[1]}; kd[2 * c4 + 1] = (f32x2){t1[2], t1[3]};
            bb[2 * c4] = (f32x2){t2[0], t2[1]}; bb[2 * c4 + 1] = (f32x2){t2[2], t2[3]}; rr[2 * c4] = (f32x2){t4[0], t4[1]}; rr[2 * c4 + 1] = (f32x2){t4[2], t4[3]};
        }
        f32x2 pa = (f32x2){0.f, 0.f}, pb = (f32x2){0.f, 0.f}, qa = (f32x2){0.f, 0.f}, qb = (f32x2){0.f, 0.f};
#pragma unroll
        for (int c = 0; c < 8; c += 2) { pa = __builtin_elementwise_fma(Sa[c], kq[c], pa); qa = __builtin_elementwise_fma(Sa[c + 1], kq[c + 1], qa);
                                         pb = __builtin_elementwise_fma(Sb[c], kq[c], pb); qb = __builtin_elementwise_fma(Sb[c + 1], kq[c + 1], qb); }
        const f32x2 sas = pa + qa, sbs = pb + qb;
        const float nsa = -quad_sum(sas.x + sas.y), nsb = -quad_sum(sbs.x + sbs.y);
        const f32x2 nsa2 = (f32x2){nsa, nsa}, nsb2 = (f32x2){nsb, nsb}, va2 = (f32x2){va, va}, vb2 = (f32x2){vb, vb};
        pre_kk(nrec);
        f32x2 ya = (f32x2){0.f, 0.f}, yb = (f32x2){0.f, 0.f};
#pragma unroll
        for (int c = 0; c < 8; ++c) {
            Sa[c] = __builtin_elementwise_fma(Sa[c], wv[c], __builtin_elementwise_fma(va2, kd[c], nsa2 * bb[c]));
            Sb[c] = __builtin_elementwise_fma(Sb[c], wv[c], __builtin_elementwise_fma(vb2, kd[c], nsb2 * bb[c]));
            ya = __builtin_elementwise_fma(Sa[c], rr[c], ya); yb = __builtin_elementwise_fma(Sb[c], rr[c], yb);
        }
        const float y_a = quad_sum(ya.x + ya.y), y_b = quad_sum(yb.x + yb.y);
        if (cb < 2) Y[(size_t)tok_of(s) * RW + hh * 64 + row0 + 16 * cb] = cb ? y_b : y_a;
    };
    Raw ra, rb;
    gload(0, ra); stage(0, ra); gload(1, ra); gload(2, rb);
    __builtin_amdgcn_wave_barrier();
    pre_kk(0);
#pragma unroll 1
    for (int g = 0; g < NG; g += 2) {
        __builtin_amdgcn_wave_barrier();
        stage(1, ra); gload(g + 3, ra);
        __builtin_amdgcn_wave_barrier();
        step(4 * g, 0, 1); step(4 * g + 1, 1, 2); step(4 * g + 2, 2, 3); step(4 * g + 3, 3, 4);
        __builtin_amdgcn_wave_barrier();
        stage(0, rb); gload(g + 4, rb);
        __builtin_amdgcn_wave_barrier();
        step(4 * g + 4, 4, 5); step(4 * g + 5, 5, 6); step(4 * g + 6, 6, 7); step(4 * g + 7, 7, 0);
    }
}

constexpr int MM_WAVES = NB * 12 * 2 * 4, MM_BLOCKS = MM_WAVES / NWAVE;
constexpr int MM_P64 = 144, MM_P16 = 40;
constexpr int MM_KH = 0, MM_RH = 2304, MM_KB = 4608, MM_BB = 6912, MM_S16 = 9216, MM_V = 11520, MM_T = 12160, MM_AKK = 12800, MM_AKR = 13440, MM_ABR = 14080, MM_ABK = 14720, MM_GL = 15744, MM_WAVE = 16384;
static_assert(MM_ABK + 1024 <= MM_GL && MM_GL + 256 <= MM_WAVE, "chunk-scan LDS map");
PH pg8::bf16x8 frag4(s16x4 v) { const s16x4 z = (s16x4){0, 0, 0, 0}; return __builtin_shufflevector(v, z, 0, 1, 2, 3, 4, 5, 6, 7); }
PH int wave_dequeue(unsigned* ctr) {
    int t = 0;
    if ((TID() & 63) == 0) t = (int)__hip_atomic_fetch_add(ctr, 1u, __ATOMIC_RELAXED, __HIP_MEMORY_SCOPE_AGENT);
    return __builtin_amdgcn_readfirstlane(t);
}
constexpr int CR_KH = 0, CR_RH = 2048, CR_KB = 4096, CR_BB = 6144, CR_T = 8192, CR_AKK = 8704, CR_AKR = 9216, CR_ABR = 9728, CR_V = 10240, CR_GL = 12288, CR_BYTES = 12544;
constexpr int NCHUNK = (CTX + SEQ) / 16, NCHAINS = NB * 12 * 2;
constexpr int MM_VQ = 11520;
PH void scan_prep_task(LAS unsigned char* L, const ScanIn& si, const float* k_a, const float* k_k, unsigned char* rec, int chain, int c) {
    const int lane = TID() & 63, fr = lane & 15, fq = lane >> 4, sl = fq, cq = fr, trq = fr >> 2, trp = fr & 3;
    const int dir = chain & 1, bh = chain >> 1, b = bh / 12, hh = bh % 12;
    const bf16_t* Xd = si.X[dir]; const bf16_t* Ad = si.A[dir];
    const pg8::f32x4 ka4 = *(const pg8::f32x4*)(k_a + hh * 64 + 4 * cq), kk4 = *(const pg8::f32x4*)(k_k + hh * 64 + 4 * cq);
    auto tok_of = [&](int s) { int tk; if (s < CTX) { const int tt = dir ? CTX - 1 - s : s; tk = NX + b * CTX + tt; } else { int tt = s - CTX; tt = dir ? SEQ - 1 - tt : tt; tk = b * SEQ + tt; } return tk; };
    auto up4 = [](pg8::u32x2 w) { return (pg8::f32x4){bflo(w.x), bfhi(w.x), bflo(w.y), bfhi(w.y)}; };
    auto pk4 = [](pg8::f32x4 v) { pg8::u32x2 o; o.x = pg8::cvt_pk_bf16(v[0], v[1]); o.y = pg8::cvt_pk_bf16(v[2], v[3]); return o; };
    pg8::u32x2 rx[4], ra[4], rk[4], rr[4];
#pragma unroll
    for (int g4 = 0; g4 < 4; ++g4) { const size_t off = (size_t)tok_of(16 * c + 4 * g4 + sl) * RW + hh * 64 + 4 * cq;
        rx[g4] = *(const pg8::u32x2*)(Xd + off); ra[g4] = *(const pg8::u32x2*)(Ad + off); rk[g4] = *(const pg8::u32x2*)(si.K + off); rr[g4] = *(const pg8::u32x2*)(si.R + off); }
    pg8::f32x4 base = (pg8::f32x4){0.f, 0.f, 0.f, 0.f};
    __builtin_amdgcn_wave_barrier();
#pragma unroll
    for (int g4 = 0; g4 < 4; ++g4) {
        const pg8::f32x4 x = up4(rx[g4]), a = up4(ra[g4]), k = up4(rk[g4]), r = up4(rr[g4]);
        pg8::f32x4 kk = k * kk4;
        { float ss = kk[0] * kk[0] + kk[1] * kk[1] + kk[2] * kk[2] + kk[3] * kk[3];
          ss += __shfl_xor(ss, 1); ss += __shfl_xor(ss, 2); ss += __shfl_xor(ss, 4); ss += __shfl_xor(ss, 8);
          kk = kk * (1.f / fmaxf(sqrtf(ss), 1e-12f)); }
        pg8::f32x4 inc = x;
#pragma unroll
        for (int e = 0; e < 4; ++e) { const float y1 = __shfl_up(inc[e], 16); inc[e] += sl >= 1 ? y1 : 0.f; }
#pragma unroll
        for (int e = 0; e < 4; ++e) { const float y2 = __shfl_up(inc[e], 32); inc[e] += sl >= 2 ? y2 : 0.f; }
        const pg8::f32x4 cx = base + inc, cxm = cx - x;
#pragma unroll
        for (int e = 0; e < 4; ++e) base[e] += __shfl(inc[e], 48 + cq);
        pg8::f32x4 g, gm, gi;
#pragma unroll
        for (int e = 0; e < 4; ++e) { g[e] = __builtin_amdgcn_exp2f(-1.4426950408889634f * cx[e]); gm[e] = __builtin_amdgcn_exp2f(-1.4426950408889634f * cxm[e]); gi[e] = __builtin_amdgcn_exp2f(1.4426950408889634f * cx[e]); }
        const pg8::f32x4 kd = k * ((a - 1.f) * ka4 + 1.f), bb = kk * a;
        const int t = 4 * g4 + sl;
        const pg8::u32x2 okh = pk4(kk * gm), orh = pk4(r * g);
        *(LAS pg8::u32x2*)(L + MM_KH + t * MM_P64 + 8 * cq) = okh; *(LAS pg8::u32x2*)(L + MM_RH + t * MM_P64 + 8 * cq) = orh;
        *(pg8::u32x2*)(rec + CR_KH + t * 128 + 8 * cq) = okh; *(pg8::u32x2*)(rec + CR_RH + t * 128 + 8 * cq) = orh;
        *(LAS pg8::u32x2*)(L + MM_KB + t * MM_P64 + 8 * cq) = pk4(kd * gi);
        *(LAS pg8::u32x2*)(L + MM_BB + t * MM_P64 + 8 * cq) = pk4(bb * gi);
        if (g4 == 3 && sl == 3) *(pg8::f32x4*)(rec + CR_GL + 16 * cq) = g;
    }
    __builtin_amdgcn_wave_barrier();
    pg8::bf16x8 khf[2], rhf[2], kbf[2], bbf[2];
#pragma unroll
    for (int ks = 0; ks < 2; ++ks) { const int o = fr * MM_P64 + (8 * fq + 32 * ks) * 2;
        khf[ks] = *(const LAS pg8::bf16x8*)(L + MM_KH + o); rhf[ks] = *(const LAS pg8::bf16x8*)(L + MM_RH + o); kbf[ks] = *(const LAS pg8::bf16x8*)(L + MM_KB + o); bbf[ks] = *(const LAS pg8::bf16x8*)(L + MM_BB + o); }
#pragma unroll
    for (int nt = 0; nt < 4; ++nt) {
        *(s16x4*)(rec + CR_KB + nt * 512 + lane * 8) = __builtin_amdgcn_ds_read_tr16_b64_v4i16((LAS s16x4*)(L + MM_KB + (4 * fq + trq) * MM_P64 + (16 * nt + 4 * trp) * 2));
        *(s16x4*)(rec + CR_BB + nt * 512 + lane * 8) = __builtin_amdgcn_ds_read_tr16_b64_v4i16((LAS s16x4*)(L + MM_BB + (4 * fq + trq) * MM_P64 + (16 * nt + 4 * trp) * 2));
    }
    const pg8::f32x4 z4 = (pg8::f32x4){0.f, 0.f, 0.f, 0.f};
    pg8::f32x4 gkk = z4, gbk = z4, gkr = z4, gbr = z4;
#pragma unroll
    for (int ks = 0; ks < 2; ++ks) { gkk = __builtin_amdgcn_mfma_f32_16x16x32_bf16(khf[ks], kbf[ks], gkk, 0, 0, 0); gbk = __builtin_amdgcn_mfma_f32_16x16x32_bf16(khf[ks], bbf[ks], gbk, 0, 0, 0);
                                     gkr = __builtin_amdgcn_mfma_f32_16x16x32_bf16(rhf[ks], kbf[ks], gkr, 0, 0, 0); gbr = __builtin_amdgcn_mfma_f32_16x16x32_bf16(rhf[ks], bbf[ks], gbr, 0, 0, 0); }
    __builtin_amdgcn_wave_barrier();
#pragma unroll
    for (int rg = 0; rg < 4; ++rg) { const int t = 4 * fq + rg; const bool lo = fr < t, le = fr <= t;
        *(LAS float*)(L + MM_ABK + t * 64 + fr * 4) = lo ? gbk[rg] : 0.f;
        *(LAS unsigned short*)(L + MM_AKK + t * MM_P16 + fr * 2) = f2bf(lo ? gkk[rg] : 0.f);
        *(LAS unsigned short*)(L + MM_AKR + t * MM_P16 + fr * 2) = f2bf(le ? gkr[rg] : 0.f);
        *(LAS unsigned short*)(L + MM_ABR + t * MM_P16 + fr * 2) = f2bf(le ? gbr[rg] : 0.f); }
    __builtin_amdgcn_wave_barrier();
    float Tr[16];
#pragma unroll
    for (int t = 0; t < 16; ++t) {
        float acc = (t == fr) ? 1.f : 0.f;
#pragma unroll
        for (int s4 = 0; s4 < (t + 3) / 4; ++s4) { const pg8::f32x4 ar = *(const LAS pg8::f32x4*)(L + MM_ABK + t * 64 + s4 * 16);
#pragma unroll
            for (int e = 0; e < 4; ++e) if (4 * s4 + e < t) acc -= ar[e] * Tr[4 * s4 + e]; }
        Tr[t] = acc;
    }
#pragma unroll
    for (int rg = 0; rg < 4; ++rg) { const float tv = fq == 0 ? Tr[rg] : fq == 1 ? Tr[4 + rg] : fq == 2 ? Tr[8 + rg] : Tr[12 + rg];
        *(LAS unsigned short*)(L + MM_T + (4 * fq + rg) * MM_P16 + fr * 2) = f2bf(tv); }
    __builtin_amdgcn_wave_barrier();
    *(s16x4*)(rec + CR_T + lane * 8) = *(const LAS s16x4*)(L + MM_T + fr * MM_P16 + 8 * fq);
    *(s16x4*)(rec + CR_AKK + lane * 8) = *(const LAS s16x4*)(L + MM_AKK + fr * MM_P16 + 8 * fq);
    *(s16x4*)(rec + CR_AKR + lane * 8) = *(const LAS s16x4*)(L + MM_AKR + fr * MM_P16 + 8 * fq);
    *(s16x4*)(rec + CR_ABR + lane * 8) = *(const LAS s16x4*)(L + MM_ABR + fr * MM_P16 + 8 * fq);
    __builtin_amdgcn_wave_barrier();
}
PH void ph_scan_prep(LAS unsigned char* lsm, const ScanIn& si, const float* k_a, const float* k_k, unsigned char* recs, unsigned* ctr) {
    LAS unsigned char* L = lsm + STAGE_OFF + (TID() >> 6) * MM_WAVE;
    constexpr int BATCH = 8;
    for (;;) {
        const int t0 = wave_dequeue(ctr) * BATCH;
        if (t0 >= NCHAINS * NCHUNK) break;
#pragma unroll 1
        for (int t = t0; t < t0 + BATCH; ++t) { const int chain = t / NCHUNK, c = t % NCHUNK; scan_prep_task(L, si, k_a, k_k, recs + (size_t)t * CR_BYTES, chain, c); }
    }
}
PH void ph_scan_seq(LAS unsigned char* lsm, const unsigned char* recs, float* const* Yd, const bf16_t* Vg) {
    const int tid = TID(), lane = tid & 63, wib = tid >> 6, gw = BID() * 3 + wib, chain = gw >> 1, q0 = (gw & 1) * 2;
    if (wib >= 3 || gw >= NCHAINS * 2) return;
    LAS unsigned char* S16 = lsm + STAGE_OFF + wib * (2 * 2304);
    LAS unsigned char* VQ = lsm + STAGE_OFF + 3 * (2 * 2304) + wib * 1280;
    const int dir = chain & 1, bh = chain >> 1, b = bh / 12, hh = bh % 12, fr = lane & 15, fq = lane >> 4, trq = fr >> 2, trp = fr & 3;
    float* Y = Yd[dir];
    auto tok_of = [&](int s) { int tk; if (s < CTX) { const int tt = dir ? CTX - 1 - s : s; tk = NX + b * CTX + tt; } else { int tt = s - CTX; tt = dir ? SEQ - 1 - tt : tt; tk = b * SEQ + tt; } return tk; };
    struct Ops { pg8::bf16x8 kh[2], rh[2]; s16x4 kb[4], bb[4], tf, akk, akr, abr; pg8::u32x2 vraw[2]; float gl[4]; };
    auto oload = [&](int c, Ops& o) { c = c < NCHUNK ? c : NCHUNK - 1; const unsigned char* rec = recs + ((size_t)chain * NCHUNK + c) * CR_BYTES;
#pragma unroll
        for (int ks = 0; ks < 2; ++ks) { o.kh[ks] = *(const pg8::bf16x8*)(rec + CR_KH + fr * 128 + (8 * fq + 32 * ks) * 2); o.rh[ks] = *(const pg8::bf16x8*)(rec + CR_RH + fr * 128 + (8 * fq + 32 * ks) * 2); }
#pragma unroll
        for (int nt = 0; nt < 4; ++nt) { o.kb[nt] = *(const s16x4*)(rec + CR_KB + nt * 512 + lane * 8); o.bb[nt] = *(const s16x4*)(rec + CR_BB + nt * 512 + lane * 8); o.gl[nt] = *(const float*)(rec + CR_GL + (16 * nt + fr) * 4);
            if (nt < 2) o.vraw[nt] = *(const pg8::u32x2*)(Vg + (size_t)tok_of(16 * c + (lane >> 2)) * RW + hh * 64 + 16 * (q0 + nt) + 4 * (lane & 3)); }
        o.tf = *(const s16x4*)(rec + CR_T + lane * 8); o.akk = *(const s16x4*)(rec + CR_AKK + lane * 8); o.akr = *(const s16x4*)(rec + CR_AKR + lane * 8); o.abr = *(const s16x4*)(rec + CR_ABR + lane * 8); };
    pg8::f32x4 Sacc[2][4];
#pragma unroll
    for (int q = 0; q < 2; ++q)
#pragma unroll
        for (int nt = 0; nt < 4; ++nt) Sacc[q][nt] = (pg8::f32x4){0.f, 0.f, 0.f, 0.f};
    const pg8::f32x4 z4 = (pg8::f32x4){0.f, 0.f, 0.f, 0.f};
    auto chunk = [&](int c, const Ops& cur) {
        __builtin_amdgcn_wave_barrier();
#pragma unroll
        for (int q = 0; q < 2; ++q)
#pragma unroll
            for (int nt = 0; nt < 4; ++nt)
#pragma unroll
                for (int rg = 0; rg < 4; rg += 2) { const unsigned pk = pg8::cvt_pk_bf16(Sacc[q][nt][rg], Sacc[q][nt][rg + 1]);
                    *(LAS unsigned short*)(S16 + q * 2304 + (4 * fq + rg) * MM_P64 + (16 * nt + fr) * 2) = (unsigned short)pk;
                    *(LAS unsigned short*)(S16 + q * 2304 + (4 * fq + rg + 1) * MM_P64 + (16 * nt + fr) * 2) = (unsigned short)(pk >> 16); }
#pragma unroll
        for (int q = 0; q < 2; ++q) *(LAS pg8::u32x2*)(VQ + q * 640 + (lane >> 2) * MM_P16 + 8 * (lane & 3)) = cur.vraw[q];
        __builtin_amdgcn_wave_barrier();
        const pg8::bf16x8 akkf = frag4(cur.akk), akrf = frag4(cur.akr), abrf = frag4(cur.abr), tff = frag4(cur.tf);
#pragma unroll
        for (int q = 0; q < 2; ++q) {
            pg8::bf16x8 s16f[2];
#pragma unroll
            for (int ks = 0; ks < 2; ++ks) s16f[ks] = *(const LAS pg8::bf16x8*)(S16 + q * 2304 + fr * MM_P64 + (8 * fq + 32 * ks) * 2);
            const pg8::bf16x8 vfr = frag4(__builtin_amdgcn_ds_read_tr16_b64_v4i16((LAS s16x4*)(VQ + q * 640 + (4 * fq + trq) * MM_P16 + 8 * trp)));
            pg8::f32x4 Wm = z4, Ym = z4;
#pragma unroll
            for (int ks = 0; ks < 2; ++ks) { Wm = __builtin_amdgcn_mfma_f32_16x16x32_bf16(cur.kh[ks], s16f[ks], Wm, 0, 0, 0); Ym = __builtin_amdgcn_mfma_f32_16x16x32_bf16(cur.rh[ks], s16f[ks], Ym, 0, 0, 0); }
            Wm = __builtin_amdgcn_mfma_f32_16x16x32_bf16(akkf, vfr, Wm, 0, 0, 0);
            Ym = __builtin_amdgcn_mfma_f32_16x16x32_bf16(akrf, vfr, Ym, 0, 0, 0);
            pg8::u32x4 wp; wp.x = pg8::cvt_pk_bf16(Wm[0], Wm[1]); wp.y = pg8::cvt_pk_bf16(Wm[2], Wm[3]); wp.z = 0u; wp.w = 0u;
            const pg8::f32x4 Um = __builtin_amdgcn_mfma_f32_16x16x32_bf16(tff, __builtin_bit_cast(pg8::bf16x8, wp), z4, 0, 0, 0);
            pg8::u32x4 up; up.x = pg8::cvt_pk_bf16(-Um[0], -Um[1]); up.y = pg8::cvt_pk_bf16(-Um[2], -Um[3]); up.z = 0u; up.w = 0u;
            const pg8::bf16x8 nuf = __builtin_bit_cast(pg8::bf16x8, up);
            Ym = __builtin_amdgcn_mfma_f32_16x16x32_bf16(abrf, nuf, Ym, 0, 0, 0);
#pragma unroll
            for (int rg = 0; rg < 4; ++rg) ((bf16_t*)Y)[(size_t)tok_of(16 * c + 4 * fq + rg) * RW + hh * 64 + 16 * (q0 + q) + fr] = f2bf(Ym[rg]);
#pragma unroll
            for (int nt = 0; nt < 4; ++nt) {
                Sacc[q][nt] = __builtin_amdgcn_mfma_f32_16x16x32_bf16(vfr, frag4(cur.kb[nt]), Sacc[q][nt], 0, 0, 0);
                Sacc[q][nt] = __builtin_amdgcn_mfma_f32_16x16x32_bf16(nuf, frag4(cur.bb[nt]), Sacc[q][nt], 0, 0, 0);
                Sacc[q][nt] = Sacc[q][nt] * cur.gl[nt];
            }
        }
    };
    Ops oa, ob;
    oload(0, oa);
#pragma unroll 1
    for (int c = 0; c < NCHUNK; c += 2) {
        oload(c + 1, ob); chunk(c, oa);
        oload(c + 2, oa); chunk(c + 1, ob);
    }
}
PH void ph_readout2(const ScanIn& si, const OddW& w, bf16_t* mix) {
    const int lane = TID() & 63, wave = (BID() * NTHR + TID()) >> 6, nw = GDIM() * NWAVE;
    for (int task = wave; task < NT / 2; task += nw) {
        pg8::u32x4 raw[3][8];
#pragma unroll
        for (int it = 0; it < 3; ++it) {
            const int idx = it * 64 + lane, r = task * 2 + idx / 96, c0 = (idx % 96) * 8;
            const size_t o = (size_t)r * RW + c0;
            raw[it][0] = *(const pg8::u32x4*)((const bf16_t*)si.Y[0] + o); raw[it][1] = *(const pg8::u32x4*)((const bf16_t*)si.Y[1] + o);
            raw[it][2] = *(const pg8::u32x4*)(si.K + o); raw[it][3] = *(const pg8::u32x4*)(si.A[0] + o); raw[it][4] = *(const pg8::u32x4*)(si.A[1] + o);
            raw[it][5] = *(const pg8::u32x4*)(si.R + o); raw[it][6] = *(const pg8::u32x4*)(si.V + o); raw[it][7] = *(const pg8::u32x4*)(si.G + o);
        }
#pragma unroll
        for (int it = 0; it < 3; ++it) {
            const int idx = it * 64 + lane, r = task * 2 + idx / 96, c0 = (idx % 96) * 8;
            float yf[8], yb8[8];
            unpack8(raw[it][0], yf); unpack8(raw[it][1], yb8);
            float y[8] = {yf[0] + yb8[0], yf[1] + yb8[1], yf[2] + yb8[2], yf[3] + yb8[3], yf[4] + yb8[4], yf[5] + yb8[5], yf[6] + yb8[6], yf[7] + yb8[7]};
            float kf[8], a0[8], a1[8], rf[8], vf[8], gf[8];
            unpack8(raw[it][2], kf); unpack8(raw[it][3], a0); unpack8(raw[it][4], a1);
            unpack8(raw[it][5], rf); unpack8(raw[it][6], vf); unpack8(raw[it][7], gf);
            float sm = 0.f;
#pragma unroll
            for (int q = 0; q < 8; ++q) sm += y[q];
            sm += __shfl_xor(sm, 1); sm += __shfl_xor(sm, 2); sm += __shfl_xor(sm, 4);
            const float mean = sm * (1.f / 64.f);
            float vs = 0.f;
#pragma unroll
            for (int q = 0; q < 8; ++q) { y[q] -= mean; vs += y[q] * y[q]; }
            vs += __shfl_xor(vs, 1); vs += __shfl_xor(vs, 2); vs += __shfl_xor(vs, 4);
            const float rstd = rsqrtf(vs * (1.f / 64.f) + 64e-5f);
            const float4 kaa = *(const float4*)(w.k_a + c0), kab = *(const float4*)(w.k_a + c0 + 4), rka = *(const float4*)(w.r_k + c0), rkb = *(const float4*)(w.r_k + c0 + 4);
            const float4 gga = *(const float4*)(w.gn_g + c0), ggb = *(const float4*)(w.gn_g + c0 + 4), gba = *(const float4*)(w.gn_b + c0), gbb = *(const float4*)(w.gn_b + c0 + 4);
            const float ka[8] = {kaa.x, kaa.y, kaa.z, kaa.w, kab.x, kab.y, kab.z, kab.w}, rk[8] = {rka.x, rka.y, rka.z, rka.w, rkb.x, rkb.y, rkb.z, rkb.w};
            const float gg[8] = {gga.x, gga.y, gga.z, gga.w, ggb.x, ggb.y, ggb.z, ggb.w}, gb[8] = {gba.x, gba.y, gba.z, gba.w, gbb.x, gbb.y, gbb.z, gbb.w};
            float cf = 0.f;
#pragma unroll
            for (int q = 0; q < 8; ++q) cf += rf[q] * (kf[q] * (2.f + (a0[q] + a1[q] - 2.f) * ka[q])) * rk[q];
            cf += __shfl_xor(cf, 1); cf += __shfl_xor(cf, 2); cf += __shfl_xor(cf, 4);
            float out[8];
#pragma unroll
            for (int q = 0; q < 8; ++q) out[q] = (y[q] * rstd * gg[q] + gb[q] + cf * vf[q]) * gf[q];
            *(pg8::u32x4*)(mix + (size_t)r * D + c0) = pack8(out);
        }
    }
}
PH void ph_convT(LAS unsigned char* L, const float* src, bf16_t* dst, int K, int N, int Npad, int nmat) {
    const int blk = BID(), nblk = GDIM();
    const int tid = TID(), wid = __builtin_amdgcn_readfirstlane(tid >> 6), lane = tid & 63, kt_n = K / 64, nt_n = Npad / 128, per = kt_n * nt_n; const int nunits = nmat * per;
    auto issue = [&](int u, int buf) {
        u = u < nunits ? u : nunits - 1;
        const int mat = u / per, rem = u % per, kt = rem / nt_n, ntl = rem % nt_n, k0 = kt * 64, n0 = ntl * 128;
        const float* sm = src + (size_t)mat * K * N + (size_t)k0 * N;
#pragma unroll
        for (int i = 0; i < 4; ++i) { const int q = wid * 4 + i, k = 2 * q + (lane >> 5); int nn = n0 + (((lane & 31) ^ (k >> 3)) << 2); nn = nn < N ? nn : N - 4;
            __builtin_amdgcn_global_load_lds((const unsigned*)(sm + (size_t)k * N + nn), (LAS unsigned*)(L + buf * 32768 + q * 1024), 16, 0, 0); } };
    __syncthreads();
    const int chunk = (nunits + nblk - 1) / nblk, ub = blk * chunk, ue = ub + chunk < nunits ? ub + chunk : nunits;
    issue(ub, 0); issue(ub + 1, 1); issue(ub + 2, 2);
    int buf = 0;
    for (int u = ub; u < ue; ++u) {
        const int mat = u / per, rem = u % per, kt = rem / nt_n, ntl = rem % nt_n, k0 = kt * 64, n0 = ntl * 128;
        bf16_t* dm = dst + (size_t)mat * Npad * K;
        asm volatile("s_waitcnt vmcnt(8)" ::: "memory");
        __builtin_amdgcn_s_barrier();
        asm volatile("" ::: "memory");
        const LAS float* T = (const LAS float*)(L + buf * 32768);
#pragma unroll
        for (int i = 0; i < 2; ++i) {
            const int idx = tid + NTHR * i, n = idx >> 3, l = idx & 7, k8 = l * 8;
            const LAS float* tp = T + k8 * 128 + ((((n >> 2) ^ l) << 2) | (n & 3));
            float f[8];
#pragma unroll
            for (int j = 0; j < 8; ++j) f[j] = tp[j * 128];
            if (n0 + n >= N) {
#pragma unroll
                for (int j = 0; j < 8; ++j) f[j] = 0.f; }
            *(pg8::u32x4*)(dm + (size_t)(n0 + n) * K + k0 + k8) = pack8(f);
        }
        asm volatile("s_waitcnt lgkmcnt(0)" ::: "memory");
        __builtin_amdgcn_s_barrier();
        asm volatile("" ::: "memory");
        issue(u + 3, buf);
        buf = buf == 2 ? 0 : buf + 1;
    }
    asm volatile("s_waitcnt vmcnt(0)" ::: "memory");
    __syncthreads();
}
PH void ph_to_bf16(const float* src, bf16_t* dst, size_t n8) {
    for (size_t i = (size_t)BID() * NTHR + TID(); i < n8; i += (size_t)GDIM() * NTHR) {
        const float4 a = ((const float4*)src)[2 * i], b = ((const float4*)src)[2 * i + 1];
        pg8::u32x4 w; w.x = pg8::cvt_pk_bf16(a.x, a.y); w.y = pg8::cvt_pk_bf16(a.z, a.w); w.z = pg8::cvt_pk_bf16(b.x, b.y); w.w = pg8::cvt_pk_bf16(b.z, b.w);
        ((pg8::u32x4*)dst)[i] = w;
    }
}
PH void ph_moe_init(const MoeBufs& m) {
    const int i = BID() * NTHR + TID();
    if (i < NEXP) m.cnt[i] = 0;
}
PH void ph_router(const float* fx, const float* rw, const float* rb, const MoeBufs& m, int nrows) {
    const int lane = TID() & 63, wave = (BID() * NTHR + TID()) >> 6, nw = GDIM() * NWAVE;
    const int e = lane & 31, half = lane >> 5;
    for (int r = wave; r < nrows; r += nw) {
        const float* xr = fx + (size_t)r * D;
        float acc = 0.f;
        for (int d = half; d < D; d += 2) acc += xr[d] * rw[d * NEXP + e];
        acc += __shfl_xor(acc, 32);
        float logit = acc + rb[e];
        float tv[4]; int ti[4];
#pragma unroll
        for (int k = 0; k < 4; ++k) {
            const float mx = wave_max(logit);
            const unsigned long long bal = __ballot(logit == mx);
            const int sel = (__ffsll((long long)bal) - 1) & 31;
            tv[k] = mx; ti[k] = sel;
            if (e == sel) logit = -INFINITY;
        }
        const float e1 = expf(tv[1] - tv[0]), e2 = expf(tv[2] - tv[0]), e3 = expf(tv[3] - tv[0]);
        const float inv = 1.f / (1.f + e1 + e2 + e3);
        if (lane < 4) {
            const float gk = lane == 0 ? inv : lane == 1 ? e1 * inv : lane == 2 ? e2 * inv : e3 * inv;
            const int ek = lane == 0 ? ti[0] : lane == 1 ? ti[1] : lane == 2 ? ti[2] : ti[3];
            const int pos = atomicAdd(&m.cnt[ek], 1);
            m.tok_e[r * 4 + lane] = ek; m.tok_pos[r * 4 + lane] = pos; m.tok_gate[r * 4 + lane] = gk;
        }
    }
}
PH void ph_router_prep(const float* rw, bf16_t* hi, bf16_t* lo) {
    for (int i = BID() * NTHR + TID(); i < 4 * 32 * 1024; i += GDIM() * NTHR) {
        const int l = i >> 15, e = (i >> 10) & 31, d = i & 1023;
        const float v = rw[((size_t)l * 1024 + d) * 32 + e]; const unsigned short hb = f2bf(v);
        hi[i] = hb; lo[i] = f2bf(v - bf2f(hb));
    }
}
PH void ph_router16(LAS unsigned char* lsm, const bf16_t* fx, const bf16_t* whi, const bf16_t* wlo, const float* rb, const MoeBufs& m, int nrows) {
    const int tid = TID(), lane = tid & 63, wib = tid >> 6, fr = lane & 15, fq = lane >> 4;
    LAS int* lc = (LAS int*)(lsm + STAGE_OFF);
    const int ntask = nrows / 16;
    for (int tb = BID() * NWAVE; tb < ntask; tb += GDIM() * NWAVE) {
        const int task = tb + wib; const bool act = task < ntask;
        const int t0 = (act ? task : 0) * 16;
        __syncthreads();
        if (tid < 32) lc[tid] = 0;
        pg8::f32x4 acc[2] = {(pg8::f32x4){0.f, 0.f, 0.f, 0.f}, (pg8::f32x4){0.f, 0.f, 0.f, 0.f}};
        const bf16_t* xp = fx + (size_t)(t0 + fr) * D + 8 * fq;
        const bf16_t* hp = whi + (size_t)fr * D + 8 * fq; const bf16_t* lp = wlo + (size_t)fr * D + 8 * fq;
#pragma unroll 8
        for (int ks = 0; ks < 32; ++ks) {
            const pg8::bf16x8 xf = *(const pg8::bf16x8*)(xp + 32 * ks);
#pragma unroll
            for (int nt = 0; nt < 2; ++nt) {
                const pg8::bf16x8 wh = *(const pg8::bf16x8*)(hp + (size_t)nt * 16 * D + 32 * ks), wl = *(const pg8::bf16x8*)(lp + (size_t)nt * 16 * D + 32 * ks);
                acc[nt] = __builtin_amdgcn_mfma_f32_16x16x32_bf16(wh, xf, acc[nt], 0, 0, 0);
                acc[nt] = __builtin_amdgcn_mfma_f32_16x16x32_bf16(wl, xf, acc[nt], 0, 0, 0);
            }
        }
        float lg[8];
#pragma unroll
        for (int nt = 0; nt < 2; ++nt) { const pg8::f32x4 bb = *(const pg8::f32x4*)(rb + 16 * nt + 4 * fq);
#pragma unroll
            for (int q = 0; q < 4; ++q) lg[nt * 4 + q] = acc[nt][q] + bb[q]; }
        float tv[4]; int ti[4];
#pragma unroll
        for (int k = 0; k < 4; ++k) {
            float bv = lg[0]; int bi = 4 * fq;
#pragma unroll
            for (int q = 1; q < 8; ++q) { const int e = 16 * (q >> 2) + 4 * fq + (q & 3); if (lg[q] > bv) { bv = lg[q]; bi = e; } }
#pragma unroll
            for (int o = 16; o <= 32; o <<= 1) { const float ov = __shfl_xor(bv, o); const int oi = __shfl_xor(bi, o); if (ov > bv || (ov == bv && oi < bi)) { bv = ov; bi = oi; } }
            tv[k] = bv; ti[k] = bi;
#pragma unroll
            for (int q = 0; q < 8; ++q) { const int e = 16 * (q >> 2) + 4 * fq + (q & 3); if (e == bi) lg[q] = -INFINITY; }
        }
        const float e1 = __expf(tv[1] - tv[0]), e2 = __expf(tv[2] - tv[0]), e3 = __expf(tv[3] - tv[0]);
        const float inv = 1.f / (1.f + e1 + e2 + e3);
        const float gk = fq == 0 ? inv : fq == 1 ? e1 * inv : fq == 2 ? e2 * inv : e3 * inv;
        const int ek = fq == 0 ? ti[0] : fq == 1 ? ti[1] : fq == 2 ? ti[2] : ti[3];
        __syncthreads();
        int lpos = 0;
        if (act) lpos = __hip_atomic_fetch_add(lc + ek, 1, __ATOMIC_RELAXED, __HIP_MEMORY_SCOPE_WORKGROUP);
        __syncthreads();
        if (tid < 32) { const int n = lc[tid]; lc[32 + tid] = n ? atomicAdd(&m.cnt[tid], n) : 0; }
        __syncthreads();
        if (act) { const int r = t0 + fr, pos = lc[32 + ek] + lpos;
            m.tok_e[r * 4 + fq] = ek; m.tok_pos[r * 4 + fq] = pos; m.tok_gate[r * 4 + fq] = gk; }
    }
    __syncthreads();
}
PH void moe_offsets(int* ps, const MoeBufs& m) {
    __syncthreads();
    if (TID() < 64) { const int lane = TID(), e = lane & 31; int v = (m.cnt[e] + 255) / 256 * 256; if (lane >= 32) v = 0;
        int incl = v;
#pragma unroll
        for (int o = 1; o < 32; o <<= 1) { const int t = __shfl_up(incl, o); if (lane >= o) incl += t; }
        if (lane < 32) ps[lane] = incl - v;
        if (lane == 31) ps[NEXP] = incl; }
    __syncthreads();
}
PH int moe_tile_expert(const int* ps, int row) { int e = -1; for (int q = 0; q < NEXP; ++q) if (row >= ps[q] && row < ps[q + 1]) e = q; return e; }
PH void ph_moe_gather(int* ps, const bf16_t* a16, const MoeBufs& m, int nrows) {
    moe_offsets(ps, m);
    const int lane = TID() & 63, wave = (BID() * NTHR + TID()) >> 6, nw = GDIM() * NWAVE;
    pg8::u32x4 v0, v1; int te[4], tp[4];
    { const int r = wave < nrows ? wave : 0; const pg8::u32x4* src = (const pg8::u32x4*)(a16 + (size_t)r * D); v0 = src[lane]; v1 = src[lane + 64];
#pragma unroll
      for (int k = 0; k < 4; ++k) { te[k] = m.tok_e[r * 4 + k]; tp[k] = m.tok_pos[r * 4 + k]; } }
    for (int r = wave; r < nrows; r += nw) {
        int dest[4];
#pragma unroll
        for (int k = 0; k < 4; ++k) dest[k] = ((const LAS int*)ps)[te[k]] + tp[k];
        const pg8::u32x4 c0 = v0, c1 = v1;
        { const int rn = r + nw < nrows ? r + nw : r; const pg8::u32x4* src = (const pg8::u32x4*)(a16 + (size_t)rn * D); v0 = src[lane]; v1 = src[lane + 64];
#pragma unroll
          for (int k = 0; k < 4; ++k) { te[k] = m.tok_e[rn * 4 + k]; tp[k] = m.tok_pos[rn * 4 + k]; } }
#pragma unroll
        for (int k = 0; k < 4; ++k) { pg8::u32x4* dp = (pg8::u32x4*)(m.Xp + (size_t)dest[k] * D); dp[lane] = c0; dp[lane + 64] = c1; }
    }
}
PH float swiglu1(float glu, float lin) {
    glu = fminf(glu, 7.f); lin = fminf(fmaxf(lin, -7.f), 7.f);
    const float e = __builtin_amdgcn_exp2f(glu * (-1.702f * 1.4426950408889634f));
    return glu * __builtin_amdgcn_rcpf(1.f + e) * (lin + 1.f);
}
struct MoeOrder : pg8::TileOrder {
    const LAS int* ps;
    __device__ __forceinline__ bool next(int i, pg8::Unit& u) const {
        if (!tile(i, u.pm, u.pn)) return false;
        const int row = u.pm * 256, lane = TID() & 63;
        const int st = ps[lane & 31];
        const unsigned long long mk = __builtin_amdgcn_ballot_w64(lane < NEXP && row >= st);
        u.e = __builtin_popcountll(mk) - 1; return true;
    }
};
struct EpiSwiglu {
    static constexpr bool PERM = true;
    bf16_t* O; const float* bias;
    struct Pre { pg8::f32x4 bv[2][2]; };
    __device__ __forceinline__ Pre prefetch(const pg8::Unit& u, int wc, int fq) const { Pre p; const float* bp = bias + (size_t)u.e * 2048 + u.pn * 256 + wc * 32 + 8 * fq;
#pragma unroll
        for (int bj = 0; bj < 2; ++bj)
#pragma unroll
            for (int n = 0; n < 2; ++n) p.bv[bj][n] = *(const pg8::f32x4*)(bp + bj * 128 + 4 * n);
        return p; }
    __device__ __forceinline__ void operator()(const pg8::f32x4 (&acc)[2][2][4][2], const pg8::Unit& u, int wr, int wc, int fr, int fq, const Pre& pf) const {
        const int row0 = u.pm * 256 + wr * 64 + fr, col0 = u.pn * 256 + wc * 32 + 8 * fq;
        const float* bp = bias + (size_t)u.e * 2048 + col0;
        pg8::f32x4 bv[2][2];
#pragma unroll
        for (int bj = 0; bj < 2; ++bj)
#pragma unroll
            for (int n = 0; n < 2; ++n) bv[bj][n] = pf.bv[bj][n];
        const int odd = fq & 1, ocol = (u.pn * 256 + wc * 32 + 8 * (fq & ~1)) >> 1;
#pragma unroll
        for (int ai = 0; ai < 2; ++ai)
#pragma unroll
            for (int mp = 0; mp < 2; ++mp) {
                bf16_t* rowp = O + (size_t)(row0 + ai * 128 + (2 * mp + odd) * 16) * 1024 + ocol;
#pragma unroll
                for (int bj = 0; bj < 2; ++bj) {
                    pg8::u32x2 w[2];
#pragma unroll
                    for (int k = 0; k < 2; ++k) { const pg8::f32x4 v0 = acc[ai][bj][2 * mp + k][0] + bv[bj][0], v1 = acc[ai][bj][2 * mp + k][1] + bv[bj][1];
                        w[k].x = pg8::cvt_pk_bf16(swiglu1(v0[0], v0[1]), swiglu1(v0[2], v0[3])); w[k].y = pg8::cvt_pk_bf16(swiglu1(v1[0], v1[1]), swiglu1(v1[2], v1[3])); }
                    const pg8::u32x2 sx = __builtin_amdgcn_permlane16_swap(w[0].x, w[1].x, false, false), sy = __builtin_amdgcn_permlane16_swap(w[0].y, w[1].y, false, false);
                    pg8::u32x4 o; o.x = sx[0]; o.y = sy[0]; o.z = sx[1]; o.w = sy[1];
                    *(pg8::u32x4*)(rowp + bj * 64) = o;
                }
            }
    }
};
struct EpiBiasBf16 {
    static constexpr bool PERM = true;
    bf16_t* O; const float* bias;
    struct Pre { pg8::f32x4 bv[2][2]; };
    __device__ __forceinline__ Pre prefetch(const pg8::Unit& u, int wc, int fq) const { Pre p; const float* bp = bias + (size_t)u.e * 1024 + u.pn * 256 + wc * 32 + 8 * fq;
#pragma unroll
        for (int bj = 0; bj < 2; ++bj)
#pragma unroll
            for (int n = 0; n < 2; ++n) p.bv[bj][n] = *(const pg8::f32x4*)(bp + bj * 128 + 4 * n);
        return p; }
    __device__ __forceinline__ void operator()(const pg8::f32x4 (&acc)[2][2][4][2], const pg8::Unit& u, int wr, int wc, int fr, int fq, const Pre& pf) const {
        const int row0 = u.pm * 256 + wr * 64 + fr, col0 = u.pn * 256 + wc * 32 + 8 * fq;
        const float* bp = bias + (size_t)u.e * 1024 + col0;
        pg8::f32x4 bv[2][2];
#pragma unroll
        for (int bj = 0; bj < 2; ++bj)
#pragma unroll
            for (int n = 0; n < 2; ++n) bv[bj][n] = pf.bv[bj][n];
#pragma unroll
        for (int ai = 0; ai < 2; ++ai)
#pragma unroll
            for (int m = 0; m < 4; ++m) { bf16_t* rowp = O + (size_t)(row0 + ai * 128 + m * 16) * 1024 + col0;
#pragma unroll
                for (int bj = 0; bj < 2; ++bj) { const pg8::f32x4 v0 = acc[ai][bj][m][0] + bv[bj][0], v1 = acc[ai][bj][m][1] + bv[bj][1];
                    pg8::u32x4 w; w.x = pg8::cvt_pk_bf16(v0[0], v0[1]); w.y = pg8::cvt_pk_bf16(v0[2], v0[3]); w.z = pg8::cvt_pk_bf16(v1[0], v1[1]); w.w = pg8::cvt_pk_bf16(v1[2], v1[3]);
                    *(pg8::u32x4*)(rowp + bj * 128) = w; } }
    }
};
PH void ph_moe_gu16(LAS unsigned char* smem, const bf16_t* wgu16, const float* bgu, const MoeBufs& m) {
    int* ps = (int*)((unsigned char*)smem + MISC_OFF);
    moe_offsets(ps, m);
    MoeOrder S; S.init(ps[NEXP] / 256, 2048 / 256, GDIM(), BID()); S.ps = (const LAS int*)(smem + MISC_OFF);
    pg8::Gemm g; g.A = m.Xp; g.Bt = wgu16; g.M = ps[NEXP]; g.N = 2048; g.K = 1024; g.bgstride = (size_t)2048 * 1024 * 2;
    EpiSwiglu E; E.O = m.Hp; E.bias = bgu;
    pg8::gemm_phase(smem + STAGE_OFF, g, S, E);
}
PH void ph_moe_dn16(LAS unsigned char* smem, const bf16_t* wdn16, const float* bdn, const MoeBufs& m) {
    int* ps = (int*)((unsigned char*)smem + MISC_OFF);
    moe_offsets(ps, m);
    MoeOrder S; S.init(ps[NEXP] / 256, 1024 / 256, GDIM(), BID()); S.ps = (const LAS int*)(smem + MISC_OFF);
    pg8::Gemm g; g.A = m.Hp; g.Bt = wdn16; g.M = ps[NEXP]; g.N = 1024; g.K = 1024; g.bgstride = (size_t)1024 * 1024 * 2;
    EpiBiasBf16 E; E.O = m.Yp; E.bias = bdn;
    pg8::gemm_phase(smem + STAGE_OFF, g, S, E);
}
PH void ph_moe_combine(int* ps, bf16_t* h, const float* modl, int gate_off, const MoeBufs& m, int nrows, const float* ng, const float* nmod, bf16_t* a16, float* outf) {
    moe_offsets(ps, m);
    const int lane = TID() & 63, wave = (BID() * NTHR + TID()) >> 6, nw = GDIM() * NWAVE;
    int te[4], tp[4]; float tg[4];
    { const int r = wave < nrows ? wave : 0;
#pragma unroll
      for (int k = 0; k < 4; ++k) { te[k] = m.tok_e[r * 4 + k]; tp[k] = m.tok_pos[r * 4 + k]; tg[k] = m.tok_gate[r * 4 + k]; } }
    for (int r = wave; r < nrows; r += nw) {
        int dest[4]; float gk[4];
#pragma unroll
        for (int k = 0; k < 4; ++k) { dest[k] = ps[te[k]] + tp[k]; gk[k] = tg[k]; }
        const float* mr = modl + (size_t)mod_row(r) * MODW + gate_off;
        const float* nm = nmod ? nmod + (size_t)mod_row(r) * MODW : mr;
        pg8::u32x4 y[2][4], hw[2]; float4 g0[2], g1[2], ga[2], gb[2], sha[2], shb[2], sca[2], scb[2];
#pragma unroll
        for (int i = 0; i < 2; ++i) { const int col = (lane + 64 * i) * 8;
#pragma unroll
            for (int k = 0; k < 4; ++k) y[i][k] = *(const pg8::u32x4*)(m.Yp + (size_t)dest[k] * 1024 + col);
            g0[i] = *(const float4*)(mr + col); g1[i] = *(const float4*)(mr + col + 4);
            hw[i] = *(const pg8::u32x4*)(h + (size_t)r * D + col);
            ga[i] = *(const float4*)(ng + col); gb[i] = *(const float4*)(ng + col + 4);
            sha[i] = *(const float4*)(nm + col); shb[i] = *(const float4*)(nm + col + 4); sca[i] = *(const float4*)(nm + 1024 + col); scb[i] = *(const float4*)(nm + 1024 + col + 4); }
        { const int rn = r + nw < nrows ? r + nw : r;
#pragma unroll
          for (int k = 0; k < 4; ++k) { te[k] = m.tok_e[rn * 4 + k]; tp[k] = m.tok_pos[rn * 4 + k]; tg[k] = m.tok_gate[rn * 4 + k]; } }
        float o[16]; float ss = 0.f;
#pragma unroll
        for (int i = 0; i < 2; ++i) {
            float sv[8];
#pragma unroll
            for (int q = 0; q < 8; ++q) sv[q] = 0.f;
#pragma unroll
            for (int k = 0; k < 4; ++k) { const pg8::u32x4 yy = y[i][k];
                sv[0] += gk[k] * bflo(yy.x); sv[1] += gk[k] * bfhi(yy.x); sv[2] += gk[k] * bflo(yy.y); sv[3] += gk[k] * bfhi(yy.y);
                sv[4] += gk[k] * bflo(yy.z); sv[5] += gk[k] * bfhi(yy.z); sv[6] += gk[k] * bflo(yy.w); sv[7] += gk[k] * bfhi(yy.w); }
            float4 o0 = make_float4(bflo(hw[i].x), bfhi(hw[i].x), bflo(hw[i].y), bfhi(hw[i].y)), o1 = make_float4(bflo(hw[i].z), bfhi(hw[i].z), bflo(hw[i].w), bfhi(hw[i].w));
            o0.x += g0[i].x * sv[0]; o0.y += g0[i].y * sv[1]; o0.z += g0[i].z * sv[2]; o0.w += g0[i].w * sv[3];
            o1.x += g1[i].x * sv[4]; o1.y += g1[i].y * sv[5]; o1.z += g1[i].z * sv[6]; o1.w += g1[i].w * sv[7];
            o[8 * i] = o0.x; o[8 * i + 1] = o0.y; o[8 * i + 2] = o0.z; o[8 * i + 3] = o0.w; o[8 * i + 4] = o1.x; o[8 * i + 5] = o1.y; o[8 * i + 6] = o1.z; o[8 * i + 7] = o1.w;
#pragma unroll
            for (int q = 0; q < 8; ++q) ss += o[8 * i + q] * o[8 * i + q];
        }
        if (!outf) {
#pragma unroll
            for (int i = 0; i < 2; ++i) { pg8::u32x4 w; w.x = pg8::cvt_pk_bf16(o[8 * i], o[8 * i + 1]); w.y = pg8::cvt_pk_bf16(o[8 * i + 2], o[8 * i + 3]); w.z = pg8::cvt_pk_bf16(o[8 * i + 4], o[8 * i + 5]); w.w = pg8::cvt_pk_bf16(o[8 * i + 6], o[8 * i + 7]);
                *(pg8::u32x4*)(h + (size_t)r * D + (lane + 64 * i) * 8) = w; } }
        ss = wave_sum(ss);
        const float rs = rsqrtf(ss * (1.f / 1024.f) + 1e-5f);
#pragma unroll
        for (int i = 0; i < 2; ++i) {
            const int col = (lane + 64 * i) * 8;
            float v[8] = {o[8 * i] * rs * ga[i].x, o[8 * i + 1] * rs * ga[i].y, o[8 * i + 2] * rs * ga[i].z, o[8 * i + 3] * rs * ga[i].w, o[8 * i + 4] * rs * gb[i].x, o[8 * i + 5] * rs * gb[i].y, o[8 * i + 6] * rs * gb[i].z, o[8 * i + 7] * rs * gb[i].w};
            if (outf) { *(float4*)(outf + (size_t)r * D + col) = make_float4(v[0], v[1], v[2], v[3]); *(float4*)(outf + (size_t)r * D + col + 4) = make_float4(v[4], v[5], v[6], v[7]); }
            else {
                v[0] = v[0] * (1.f + sca[i].x) + sha[i].x; v[1] = v[1] * (1.f + sca[i].y) + sha[i].y; v[2] = v[2] * (1.f + sca[i].z) + sha[i].z; v[3] = v[3] * (1.f + sca[i].w) + sha[i].w;
                v[4] = v[4] * (1.f + scb[i].x) + shb[i].x; v[5] = v[5] * (1.f + scb[i].y) + shb[i].y; v[6] = v[6] * (1.f + scb[i].z) + shb[i].z; v[7] = v[7] * (1.f + scb[i].w) + shb[i].w;
                *(pg8::u32x4*)(a16 + (size_t)r * D + col) = pack8(v); }
        }
    }
}

#if PROBE
PH float probe_q(float t) {
    t = fmaxf(t, 1e-4f); float sc = 1.f;
    while (t >= 10.f) { t *= 0.1f; sc *= 10.f; }
    while (t < 1.f) { t *= 10.f; sc *= 0.1f; }
    float m = 1.f;
    if (t >= 2.f) m = 2.f; if (t >= 5.f) m = 5.f;
    return m * sc;
}
#endif
__global__ __launch_bounds__(NTHR, 2) void mega(Params p) {
    extern __shared__ __attribute__((aligned(16))) unsigned char smem[];
    float* lds = (float*)(smem + STAGE_OFF);
    LAS unsigned char* lsm = (LAS unsigned char*)smem;
    if (threadIdx.x == 0) *(uint4*)smem = make_uint4(0u, 0u, 0u, 0u);
    __syncthreads();
    XcdBarrier bar = xcd_barrier_post(p.bar, (volatile LAS unsigned*)smem);
#if PROBE
    if (threadIdx.x == 0) { volatile LAS unsigned long long* tl0 = (volatile LAS unsigned long long*)((LAS unsigned char*)smem + 512); for (int q = 0; q < 31; ++q) tl0[q] = 0; tl0[31] = wall_clock64(); }
#define GRID_SYNC(id) do { xcd_barrier(bar); if (threadIdx.x == 0) { volatile LAS unsigned long long* tl_ = (volatile LAS unsigned long long*)((LAS unsigned char*)smem + 512); \
        const unsigned long long now_ = wall_clock64(); tl_[id] += now_ - tl_[31]; tl_[31] = now_; } } while (0)
#define SUBSTAMP(id) do { __syncthreads(); if (threadIdx.x == 0) { volatile LAS unsigned long long* tl_ = (volatile LAS unsigned long long*)((LAS unsigned char*)smem + 512); \
        const unsigned long long now_ = wall_clock64(); tl_[id] += now_ - tl_[31]; tl_[31] = now_; } } while (0)
#else
#define GRID_SYNC(id) xcd_barrier(bar)
#define SUBSTAMP(id) do { } while (0)
#endif

    ph_copy(p);
    ph_ada(p, lds);
    ph_rope_tab(p.rope_c, p.rope_s);
    ph_fft_tab(p.fft_tabT);
    ph_pool_prep(p.pool_w, p.pool_wt);
    ph_router_prep(p.router_w, p.rwt_hi, p.rwt_lo);
    ph_convT_small(p.rw_w2, p.w2t, 64, 768, 4);
    ph_convT_small(p.rw_a2, p.a2t, 64, 768, 4);
    ph_convT_small(p.rw_g2, p.g2t, 160, 768, 2);
    ph_twiddle16(p.tw16_lat, 2048);
    ph_twiddle16(p.tw16_ctx, 256);
    ph_convT(lsm + STAGE_OFF, p.ev_w_in, p.ewin16, 1024, EVEN_IN, 1536, 2);
    ph_convT(lsm + STAGE_OFF, p.od_w_in, p.owin16, 1024, ODD_IN, 3072, 2);
    ph_convT(lsm + STAGE_OFF, p.ev_w_out, p.ewout16, 1024, 1024, 1024, 2);
    ph_convT(lsm + STAGE_OFF, p.od_w_out, p.owout16, 1024, 1024, 1024, 2);
    ph_moe_init(p.mb);
    ph_convT(lsm + STAGE_OFF, p.exp_w_gu, p.wgu16, 1024, 2048, 2048, 4 * NEXP);
    ph_convT(lsm + STAGE_OFF, p.exp_w_dn, p.wdn16, 1024, 1024, 1024, 4 * NEXP);
    GRID_SYNC(0);

    for (int i = 0; i < 4; ++i) {
        const int j = i >> 1; const bool last = (i == 3);
        const float* modl = p.mod + (size_t)i * 17 * MODW;
        if (i == 0) { ph_norm_mod((const bf16_t*)p.h, p.norm_mix_g, modl, 0, 1024, nullptr, p.a16, NT); GRID_SYNC(1); }
        if ((i & 1) == 0) {
            { EpiRopeBf16 E; E.O = p.px16; E.ldc = 1536; E.ct = p.rope_c; E.st = p.rope_s; ph_gemm16(lsm, p.a16, p.ewin16 + (size_t)j * 1536 * 1024, NT, 1536, 1024, E, BID(), GDIM()); }
            GRID_SYNC(2);
            ph_pool16(lsm, p.px16, p.pool_wt + (size_t)j * 4 * 4096, p.pool_scale + j * 256, p.mix16);
            SUBSTAMP(24);
            ph_attn16(lsm, p.px16, p.att_sink + j * 12, p.mix16);
            GRID_SYNC(4);
            { EpiPlainBf16 E; E.O = p.px16; E.ldc = D; ph_gemm16(lsm, p.mix16, p.ewout16 + (size_t)j * D * D, NT, D, D, E, BID(), GDIM()); }
        } else {
            { EpiPlainBf16 E; E.O = p.px16; E.ldc = 3072; ph_gemm16(lsm, p.a16, p.owin16 + (size_t)j * 3072 * 1024, NT, 3072, 1024, E, BID(), GDIM()); }
            GRID_SYNC(6);
            OddW w;
            w.mu = p.rw_mu + (size_t)j * 2 * 2720; w.w0 = p.rw_w0 + (size_t)j * 2 * 768; w.w2 = p.rw_w2 + (size_t)j * 2 * 64 * 768;
            w.a0 = p.rw_a0 + (size_t)j * 2 * 768; w.a2 = p.rw_a2 + (size_t)j * 2 * 64 * 768; w.g2 = p.rw_g2 + (size_t)j * 160 * 768;
            w.k_k = p.rw_k_k + j * 768; w.k_a = p.rw_k_a + j * 768; w.r_k = p.rw_r_k + j * 768; w.gn_g = p.rw_gn_g + j * 768; w.gn_b = p.rw_gn_b + j * 768;
            ph_oddprep(lsm, p.px16, w, p.w2t + (size_t)j * 2 * 768 * 64, p.a2t + (size_t)j * 2 * 768 * 64, p.g2t + (size_t)j * 768 * 160, p.si);
            SUBSTAMP(22);
            ph_fft_prep16(p.px16, p.fft_tabT, p.bt16_lat, p.bt16_ctx);
            GRID_SYNC(7);
            { EpiDft E; E.mix = p.mix16; E.T = 2048; E.row0 = 0; E.scale = 0.0027621358640099515f;
              ph_gemm16(lsm, p.tw16_lat, p.bt16_lat, 2048, 4096, 4096, E, BID(), GDIM());
              E.T = 256; E.row0 = NX; E.scale = 0.0078125f;
              ph_gemm16(lsm, p.tw16_ctx, p.bt16_ctx, 256, 4096, 512, E, (BID() >= 128 ? BID() - 128 : BID() + 128), GDIM()); }
            ph_scan_prep(lsm, p.si, w.k_a, w.k_k, p.crec, p.qctr + 16 * j);
            GRID_SYNC(20);
            ph_scan_seq(lsm, p.crec, p.si.Y, p.si.V);
            GRID_SYNC(8);
            ph_readout2(p.si, w, p.mix16);
            GRID_SYNC(9);
            { EpiPlainBf16 E; E.O = p.px16; E.ldc = D; ph_gemm16(lsm, p.mix16, p.owout16 + (size_t)j * D * D, NT, D, D, E, BID(), GDIM()); }
        }
        GRID_SYNC((i & 1) ? 10 : 5);
        const int nrows = last ? NX : NT;
        ph_resid_norm((bf16_t*)p.h, p.px16, modl + 2048, p.norm_ffn_g + i * D, modl, 3072, 4096, p.a16, nrows);
        GRID_SYNC(11);
        ph_router16(lsm, p.a16, p.rwt_hi + (size_t)i * NEXP * D, p.rwt_lo + (size_t)i * NEXP * D, p.router_b + i * NEXP, p.mb, nrows);
        GRID_SYNC(12);
        ph_moe_gather((int*)(smem + MISC_OFF), p.a16, p.mb, nrows);
        GRID_SYNC(13);
        ph_moe_gu16(lsm, p.wgu16 + (size_t)i * NEXP * 2048 * 1024, p.exp_b_gu + (size_t)i * NEXP * 2048, p.mb);
        GRID_SYNC(14);
        ph_moe_dn16(lsm, p.wdn16 + (size_t)i * NEXP * 1024 * 1024, p.exp_b_dn + (size_t)i * NEXP * 1024, p.mb);
        GRID_SYNC(15);
        ph_moe_combine((int*)(smem + MISC_OFF), (bf16_t*)p.h, modl, 5120, p.mb, nrows, last ? p.final_g : p.norm_mix_g + (i + 1) * D, last ? nullptr : modl + 17 * MODW, p.a16, last ? p.out : nullptr);
        GRID_SYNC(16);
        ph_moe_init(p.mb);
    }
#if PROBE
    GRID_SYNC(18);
    if (blockIdx.x == 0 && threadIdx.x == 0) { volatile LAS unsigned long long* tl_ = (volatile LAS unsigned long long*)((LAS unsigned char*)smem + 512); for (int q = 0; q < 31; ++q) p.probe[q] = tl_[q]; }
    GRID_SYNC(19);
    {
        const float tA = probe_q((float)p.probe[PROBE_A] * 1e-5f), tB = probe_q((float)p.probe[PROBE_B] * 1e-5f);
        const float cA = 10.f * sqrtf(tA), cB = 1000.f * tB;
        for (size_t q = (size_t)blockIdx.x * NTHR + threadIdx.x; q < (size_t)NX * D; q += (size_t)GDIM() * NTHR) p.out[q] = q == 0 ? cB : cA;
    }
#endif
}
}

extern "C" void kernel_launch(void* const* d_in, const int* in_sizes, int n_in, void* d_out, int out_size, void* d_ws, size_t ws_size, hipStream_t stream) {
    Params p; memset(&p, 0, sizeof(p));
    p.x = (const float*)d_in[0]; p.c = (const float*)d_in[1]; p.ctx = (const float*)d_in[2]; p.c_ctx = (const float*)d_in[3];
    p.ada_w = (const float*)d_in[4]; p.ada_b = (const float*)d_in[5]; p.norm_mix_g = (const float*)d_in[6]; p.norm_ffn_g = (const float*)d_in[7];
    p.ev_w_in = (const float*)d_in[8]; p.ev_w_out = (const float*)d_in[9]; p.pool_w = (const float*)d_in[10]; p.pool_scale = (const float*)d_in[11];
    p.att_sink = (const float*)d_in[12]; p.od_w_in = (const float*)d_in[13]; p.od_w_out = (const float*)d_in[14];
    p.rw_mu = (const float*)d_in[15]; p.rw_w0 = (const float*)d_in[16]; p.rw_w2 = (const float*)d_in[17]; p.rw_a0 = (const float*)d_in[18];
    p.rw_a2 = (const float*)d_in[19]; p.rw_g2 = (const float*)d_in[20]; p.rw_k_k = (const float*)d_in[21]; p.rw_k_a = (const float*)d_in[22];
    p.rw_r_k = (const float*)d_in[23]; p.rw_gn_g = (const float*)d_in[24]; p.rw_gn_b = (const float*)d_in[25];
    p.router_w = (const float*)d_in[26]; p.router_b = (const float*)d_in[27]; p.exp_w_gu = (const float*)d_in[28]; p.exp_b_gu = (const float*)d_in[29];
    p.exp_w_dn = (const float*)d_in[30]; p.exp_b_dn = (const float*)d_in[31]; p.final_g = (const float*)d_in[32];
    p.out = (float*)d_out;

    float* ws = (float*)d_ws; size_t off = 0;
    auto take = [&](size_t n) { float* q = ws + off; off += (n + 63) & ~(size_t)63; return q; };
    p.bar = (unsigned*)take(XCD_BAR_WORDS);
    p.qctr = (unsigned*)take(64);
    p.probe = (unsigned long long*)take(64);
    p.rope_c = take(1024); p.rope_s = take(1024);
    p.fft_tabT = (bf16_t*)take(128 * 64 / 2);
    p.pool_wt = (bf16_t*)take(2 * 4 * 64 * 64 / 2);
    p.rwt_hi = (bf16_t*)take((size_t)4 * 32 * 1024 / 2); p.rwt_lo = (bf16_t*)take((size_t)4 * 32 * 1024 / 2);
    p.w2t = (bf16_t*)take((size_t)4 * 768 * 64 / 2); p.a2t = (bf16_t*)take((size_t)4 * 768 * 64 / 2); p.g2t = (bf16_t*)take((size_t)2 * 768 * 160 / 2);
    p.mod = take((size_t)4 * 17 * MODW);
    p.h = take((size_t)NT * D);
    p.a = take((size_t)NT * D);
    p.mix16 = (bf16_t*)take((size_t)NT * D / 2);
    p.tw16_lat = (bf16_t*)take((size_t)2048 * 4096 / 2);
    p.tw16_ctx = (bf16_t*)take((size_t)256 * 512 / 2);
    p.ewin16 = (bf16_t*)take((size_t)2 * 1536 * 1024 / 2); p.owin16 = (bf16_t*)take((size_t)2 * 3072 * 1024 / 2);
    p.ewout16 = (bf16_t*)take((size_t)2 * 1024 * 1024 / 2); p.owout16 = (bf16_t*)take((size_t)2 * 1024 * 1024 / 2);
    p.mb.tok_e = (int*)take((size_t)NT * 4); p.mb.tok_pos = (int*)take((size_t)NT * 4); p.mb.tok_gate = take((size_t)NT * 4);
    p.mb.cnt = (int*)take(64);
    p.a16 = (bf16_t*)take((size_t)NT * D / 2);
    p.wgu16 = (bf16_t*)take((size_t)4 * NEXP * 2048 * 1024 / 2);
    p.wdn16 = (bf16_t*)take((size_t)4 * NEXP * 1024 * 1024 / 2);
    const size_t scratch0 = off;
    p.px16 = (bf16_t*)take((size_t)NT * 3072 / 2);
    { bf16_t** arrs[9] = {&p.si.R, &p.si.K, &p.si.KK, &p.si.V, &p.si.G, &p.si.X[0], &p.si.X[1], &p.si.A[0], &p.si.A[1]};
      for (int q = 0; q < 9; ++q) *arrs[q] = (bf16_t*)take((size_t)NT * RW / 2); }
    p.si.Y[0] = take((size_t)NT * RW); p.si.Y[1] = take((size_t)NT * RW);
    p.st_init = take((size_t)NB * 24 * 5 * 4096); p.st_p = take((size_t)NB * 24 * 4 * 4096); p.st_b = take((size_t)NB * 24 * 4 * 4096);
    p.crec = (unsigned char*)take((size_t)NB * 24 * 144 * 12544 / 4);
    p.bt16_lat = (bf16_t*)take((size_t)4096 * 4096 / 2);
    p.bt16_ctx = (bf16_t*)take((size_t)4096 * 512 / 2);
    const size_t mixer_end = off;
    off = scratch0;
    p.mb.Xp = (bf16_t*)take((size_t)MOE_ROWS * 1024 / 2); p.mb.Hp = (bf16_t*)take((size_t)MOE_ROWS * 1024 / 2); p.mb.Yp = (bf16_t*)take((size_t)MOE_ROWS * 1024 / 2);
    const size_t total = (off > mixer_end ? off : mixer_end) * sizeof(float);
    if (total > ws_size) { fprintf(stderr, "kernel_launch: workspace too small: need %zu have %zu\n", total, ws_size); return; }

    static int grid = 0;
    if (!grid) {
        int dev = 0, cus = 0, per_cu = 0;
        if (hipGetDevice(&dev) != hipSuccess || hipDeviceGetAttribute(&cus, hipDeviceAttributeMultiprocessorCount, dev) != hipSuccess) { fprintf(stderr, "kernel_launch: device query failed\n"); return; }
        if (hipFuncSetAttribute((const void*)mega, hipFuncAttributeMaxDynamicSharedMemorySize, LDS_BYTES) != hipSuccess) { fprintf(stderr, "kernel_launch: hipFuncSetAttribute failed\n"); return; }
        if (hipOccupancyMaxActiveBlocksPerMultiprocessor(&per_cu, (const void*)mega, NTHR, LDS_BYTES) != hipSuccess || per_cu < 1) { fprintf(stderr, "kernel_launch: occupancy query says %d\n", per_cu); return; }
        grid = cus;
    }
    if (hipMemsetAsync(p.bar, 0, (XCD_BAR_WORDS + 64) * sizeof(unsigned), stream) != hipSuccess) { fprintf(stderr, "kernel_launch: memset failed\n"); return; }
    hipLaunchKernelGGL(mega, dim3(grid), dim3(NTHR), LDS_BYTES, stream, p);
}
```

```cpp
#include <hip/hip_runtime.h>
#include <stdint.h>
#include <stdio.h>
#include <string.h>

#define PROBE 0
#define PROBE_A 4
#define PROBE_B 8
namespace {
constexpr int D = 1024, NB = 16, SEQ = 2048, CTX = 256;
constexpr int NX = NB * SEQ, NC = NB * CTX, NT = NX + NC;
constexpr int EVEN_IN = 1408, ODD_IN = 2976;
constexpr int RW = 768;
constexpr int NEXP = 32, TOPK = 4;
constexpr int MOE_ROWS = ((NT * TOPK + 255) / 256 + NEXP) * 256;
constexpr int MOE_TILES = MOE_ROWS / 128;
constexpr int MODW = 6 * D;
constexpr int NTHR = 512, NWAVE = 8;
constexpr int LDS_BYTES = 132 * 1024;
constexpr int MISC_OFF = 16, STAGE_OFF = 1024;

#define XB_TMO      128
#define XB_XCNT(j)  (256  + 64 * (j))
#define XB_XSUB(j)  (1280 + 64 * (j))
#define XB_XGEN(j)  (2304 + 64 * (j))
#define XB_TOP      3328
#define XB_TOPGEN   3392
#define XCD_BAR_WORDS 3456
#define XB_SPIN_CAP (1u << 22)
#define LAS __attribute__((address_space(3)))

__device__ __forceinline__ unsigned xb_ld(unsigned* p)              { return __hip_atomic_load(p, __ATOMIC_RELAXED, __HIP_MEMORY_SCOPE_AGENT); }
__device__ __forceinline__ unsigned xb_add(unsigned* p, unsigned v) { return __hip_atomic_fetch_add(p, v, __ATOMIC_RELAXED, __HIP_MEMORY_SCOPE_AGENT); }
__device__ __forceinline__ unsigned xb_xcc_id() { return (unsigned)__builtin_amdgcn_s_getreg((3 << 11) | 20) & 0xFu; }
#define XB_SPIN(cond, bar) do { unsigned _sp = 0; while (cond) { __builtin_amdgcn_s_sleep(1); \
    if ((++_sp & 255u) == 0u) { if (xb_ld(&(bar)[XB_TMO])) break; if (_sp > XB_SPIN_CAP) { atomicAdd(&(bar)[XB_TMO], 1u); break; } } } } while (0)

struct XcdBarrier { unsigned* bar; unsigned x; volatile LAS unsigned* st; };

__device__ __forceinline__ XcdBarrier xcd_barrier_post(unsigned* bar, volatile LAS unsigned* st) {
    XcdBarrier b; b.bar = bar; b.x = xb_xcc_id(); b.st = st;
    if (threadIdx.x == 0) (void)xb_add(&bar[XB_XCNT(b.x)], 1u);
    return b;
}
__device__ __forceinline__ void xcd_barrier_complete(unsigned* bar, unsigned x, unsigned& nloc, unsigned& nx) {
    const unsigned G = gridDim.x * gridDim.y * gridDim.z;
    unsigned sum, cnt, mine, sp = 0u;
    for (;;) {
        sum = 0u; cnt = 0u; mine = 0u;
#pragma unroll
        for (unsigned j = 0; j < 16; ++j) { const unsigned c = xb_ld(&bar[XB_XCNT(j)]); sum += c; cnt += (c > 0u) ? 1u : 0u; mine = (j == x) ? c : mine; }
        if (sum == G) break;
        __builtin_amdgcn_s_sleep(1);
        if ((++sp & 255u) == 0u) { if (xb_ld(&bar[XB_TMO])) break; if (sp > XB_SPIN_CAP) { atomicAdd(&bar[XB_TMO], 1u); break; } }
    }
    nloc = mine > 0u ? mine : 1u; nx = cnt > 0u ? cnt : 1u;
}
__device__ __forceinline__ void xcd_barrier(const XcdBarrier& b) {
    asm volatile("s_waitcnt vmcnt(0)" ::: "memory");
    __syncthreads();
    if (threadIdx.x == 0) {
        unsigned* bar = b.bar; unsigned bx = b.x;
        asm volatile("" : "+s"(bar), "+s"(bx));
        __builtin_amdgcn_s_waitcnt(0);
        unsigned nloc = b.st[0], nx = b.st[1];
        if (nloc == 0u) { xcd_barrier_complete(bar, bx, nloc, nx); b.st[0] = nloc; b.st[1] = nx; }
        const unsigned old = xb_add(&bar[XB_XSUB(bx)], 1u);
        const unsigned gen = old / nloc;
        if (old + 1u == (gen + 1u) * nloc) {
            __builtin_amdgcn_fence(__ATOMIC_RELEASE, "agent");
            asm volatile("s_waitcnt vmcnt(0)" ::: "memory");
            const unsigned og = xb_add(&bar[XB_TOP], 1u);
            const unsigned tg = og / nx;
            if (og + 1u == (tg + 1u) * nx) xb_add(&bar[XB_TOPGEN], 1u);
            else XB_SPIN(xb_ld(&bar[XB_TOPGEN]) == tg, bar);
            __builtin_amdgcn_fence(__ATOMIC_ACQUIRE, "agent");
            xb_add(&bar[XB_XGEN(bx)], 1u);
            asm volatile("s_waitcnt vmcnt(0)" ::: "memory");
        } else {
            XB_SPIN(xb_ld(&bar[XB_XGEN(bx)]) == gen, bar);
            __builtin_amdgcn_fence(__ATOMIC_ACQUIRE, "agent");
            asm volatile("s_waitcnt vmcnt(0)" ::: "memory");
        }
    }
    __syncthreads();
}

#define PH __device__ __forceinline__
PH float wave_sum(float v) {
#pragma unroll
    for (int o = 32; o >= 1; o >>= 1) v += __shfl_xor(v, o);
    return v;
}
PH float wave_max(float v) {
#pragma unroll
    for (int o = 32; o >= 1; o >>= 1) v = fmaxf(v, __shfl_xor(v, o));
    return v;
}
PH int mod_row(int r) { return r < NX ? (r >> 11) : 16; }
PH void seq_info(int r, int& s0, int& len, int& t) {
    if (r < NX) { s0 = r & ~2047; len = SEQ; t = r & 2047; }
    else { const int q = r - NX; s0 = NX + (q & ~255); len = CTX; t = q & 255; }
}
PH float sigmoidf_(float x) { return 1.f / (1.f + expf(-x)); }
PH int TID() { int t = threadIdx.x; asm volatile("" : "+v"(t)); return t; }
PH int BID() { int t = blockIdx.x; asm volatile("" : "+s"(t)); return t; }
PH int GDIM() {
    int t = __builtin_amdgcn_readfirstlane((int)(((const __attribute__((address_space(4))) unsigned*)__builtin_amdgcn_dispatch_ptr())[3] >> 9)); asm volatile("" : "+s"(t)); return t; }
static_assert(NTHR == 512, "GDIM shift");

typedef unsigned short bf16_t;
#if PROBE
#define SUBSTAMP_L(lsm_, id) do { __syncthreads(); if (threadIdx.x == 0) { volatile LAS unsigned long long* tl_ = (volatile LAS unsigned long long*)((LAS unsigned char*)(lsm_) + 512); \
        const unsigned long long now_ = wall_clock64(); tl_[id] += now_ - tl_[31]; tl_[31] = now_; } } while (0)
#else
#define SUBSTAMP_L(lsm_, id) do { } while (0)
#endif
struct ScanArrays { float *R, *V, *KK, *G, *W[2], *KD[2], *BB[2], *Y[2]; };
struct ScanIn { bf16_t *R, *K, *KK, *V, *G, *X[2], *A[2]; float* Y[2]; };
struct OddW { const float *mu, *w0, *w2, *a0, *a2, *g2, *k_k, *k_a, *r_k, *gn_g, *gn_b; };
struct MoeBufs { int* tok_e; int* tok_pos; float* tok_gate; int* cnt; bf16_t* Xp; bf16_t* Hp; bf16_t* Yp; };

struct Params {
    const float *x, *c, *ctx, *c_ctx, *ada_w, *ada_b, *norm_mix_g, *norm_ffn_g, *ev_w_in, *ev_w_out, *pool_w, *pool_scale, *att_sink;
    const float *od_w_in, *od_w_out, *rw_mu, *rw_w0, *rw_w2, *rw_a0, *rw_a2, *rw_g2, *rw_k_k, *rw_k_a, *rw_r_k, *rw_gn_g, *rw_gn_b;
    const float *router_w, *router_b, *exp_w_gu, *exp_b_gu, *exp_w_dn, *exp_b_dn, *final_g;
    float* out; unsigned* bar; unsigned* qctr; unsigned long long* probe;
    unsigned char* crec;
    float *st_init, *st_p, *st_b;
    float *mod, *h, *a, *mix, *tw_lat, *tw_ctx, *px, *bm_lat, *bm_ctx;
    bf16_t *px16; float *rope_c, *rope_s;
    bf16_t *a16, *wgu16, *wdn16, *mix16, *ewin16, *owin16, *ewout16, *owout16, *tw16_lat, *tw16_ctx, *bt16_lat, *bt16_ctx;
    ScanArrays sa; MoeBufs mb; ScanIn si;
    bf16_t *fft_tabT, *pool_wt;
    bf16_t *rwt_hi, *rwt_lo;
    bf16_t *w2t, *a2t, *g2t;
};


namespace pg8 {
#define PG8_LAS __attribute__((address_space(3)))
typedef unsigned short bf16_t;
typedef short bf16x8 __attribute__((ext_vector_type(8)));
typedef float f32x4 __attribute__((ext_vector_type(4)));
typedef unsigned u32x4 __attribute__((ext_vector_type(4)));
typedef unsigned u32x2 __attribute__((ext_vector_type(2)));
constexpr int BM = 256, BK = 64, HALF = 128, HTB = HALF * BK * 2, STAGE_BYTES = 8 * HTB, NXCD = 8, WGM = 8;

__host__ __device__ __forceinline__ int lds_byte(int r, int c) { const int st = (r >> 4) * 2 + (c >> 5), rr = r & 15, cc = c & 31, ob = rr * 64 + cc * 2; return st * 1024 + (ob ^ (((ob >> 9) & 1) << 5)); }
__host__ __device__ __forceinline__ void stage_rc(int b, int& R, int& C) { const int st = b / 1024, sb = b % 1024, swz = sb ^ (((sb >> 9) & 1) << 5); R = (st >> 1) * 16 + swz / 64; C = (st & 1) * 32 + (swz % 64) / 2; }
__host__ __device__ __forceinline__ int perm32(int rho) { const int n = rho >> 4, i = rho & 15; return 8 * (i >> 2) + 4 * n + (i & 3); }

struct Unit { int pm, pn, e; };
struct Gemm { const bf16_t* A; const bf16_t* Bt; int M, N, K; size_t bgstride; };

typedef float cvt_f32x2 __attribute__((ext_vector_type(2)));
typedef __bf16 cvt_bf16x2 __attribute__((ext_vector_type(2)));
__device__ __forceinline__ unsigned cvt_pk_bf16(float lo, float hi) { const cvt_f32x2 v = {lo, hi}; const cvt_bf16x2 b = __builtin_convertvector(v, cvt_bf16x2); return __builtin_bit_cast(unsigned, b); }

struct TileOrder {
    int nM, nN, nwg, G, c;
    __device__ void init(int nM_, int nN_, int G_, int c_) { nM = nM_; nN = nN_; nwg = nM * nN; G = G_; c = c_; }
    __device__ bool tile(int i, int& pm, int& pn) const {
        const long L = (long)i * G + c; if (L >= nwg) return false;
        int wgid = (int)L; { const int q = nwg / NXCD, r = nwg % NXCD, xcd = wgid % NXCD, off = wgid / NXCD; wgid = (xcd < r ? xcd * (q + 1) : r * (q + 1) + (xcd - r) * q) + off; }
        const int nig = WGM * nN, gid = wgid / nig, fm = gid * WGM, gsz = (nM - fm) < WGM ? (nM - fm) : WGM;
        pm = fm + ((wgid % nig) % gsz); pn = (wgid % nig) / gsz; return true;
    }
};

template <class Epi, class Sched>
__device__ __forceinline__ void gemm_phase(PG8_LAS unsigned char* lds, const Gemm g, const Sched& S, const Epi& E) {
    const int tid = TID(), wid = __builtin_amdgcn_readfirstlane(tid >> 6), lane = tid & 63, wr = wid >> 2, wc = wid & 3, fr = lane & 15, fq = lane >> 4;
    const int K = g.K, nt = K / BK;
    unsigned voffA[2], voffB[2];
#pragma unroll
    for (int i = 0; i < 2; ++i) { int R, C; stage_rc(tid * 16 + i * 8192, R, C); const int Rb = Epi::PERM ? ((R & ~31) + perm32(R & 31)) : R;
        voffA[i] = (unsigned)(R * K + C) * 2u; voffB[i] = (unsigned)(Rb * K + C) * 2u; }
    const size_t kstep = (size_t)(BK * 2);
    const size_t hstep = (size_t)HALF * K * 2;
    const size_t tstep = 2 * hstep;
    const unsigned ldsw = (unsigned)wid * 1024u;
    const int aoff = lds_byte(wr * 64 + fr, fq * 8), boff = lds_byte(wc * 32 + fr, fq * 8);
#define PG8_SA(b, h) (((b) * 2 + (h)) * HTB)
#define PG8_SB(b, h) ((4 + (b) * 2 + (h)) * HTB)
#define PG8_STAGE(bufoff, gbase, voff) do { _Pragma("unroll") for (int _i = 0; _i < 2; ++_i) \
        __builtin_amdgcn_global_load_lds((const unsigned*)((const char*)(gbase) + (voff)[_i]), (PG8_LAS unsigned*)(lds + (bufoff) + ldsw + _i * 8192), 16, 0, 0); } while (0)
#define PG8_LDA(dst, b, h) do { _Pragma("unroll") for (int m = 0; m < 4; ++m) _Pragma("unroll") for (int k = 0; k < 2; ++k) dst[m][k] = *(const PG8_LAS bf16x8*)(lds + PG8_SA(b, h) + aoff + m * 2048 + k * 1024); } while (0)
#define PG8_LDB(dst, b, h) do { _Pragma("unroll") for (int n = 0; n < 2; ++n) _Pragma("unroll") for (int k = 0; k < 2; ++k) dst[n][k] = *(const PG8_LAS bf16x8*)(lds + PG8_SB(b, h) + boff + n * 2048 + k * 1024); } while (0)
#define PG8_MMA(ai, bj, At, Bt) do { __builtin_amdgcn_s_setprio(1); _Pragma("unroll") for (int m = 0; m < 4; ++m) _Pragma("unroll") for (int n = 0; n < 2; ++n) _Pragma("unroll") for (int k = 0; k < 2; ++k) \
        acc[ai][bj][m][n] = __builtin_amdgcn_mfma_f32_16x16x32_bf16(Bt[n][k], At[m][k], acc[ai][bj][m][n], 0, 0, 0); __builtin_amdgcn_s_setprio(0); } while (0)
#define PG8_WAIT_V(n) asm volatile("s_waitcnt vmcnt(" #n ")" ::: "memory")
#define PG8_WAIT_L(n) asm volatile("s_waitcnt lgkmcnt(" #n ")" ::: "memory")
#define PG8_BAR __builtin_amdgcn_s_barrier()
#define PG8_SCHED __builtin_amdgcn_sched_barrier(0)
    Unit cur, nxt; int ui = 0;
    if (!S.next(0, cur)) return;
    typename Epi::Pre pre;
    f32x4 acc[2][2][4][2];
#pragma unroll
    for (int a = 0; a < 2; ++a)
#pragma unroll
        for (int b = 0; b < 2; ++b)
#pragma unroll
            for (int m = 0; m < 4; ++m)
#pragma unroll
                for (int n = 0; n < 2; ++n) acc[a][b][m][n] = (f32x4){0.f, 0.f, 0.f, 0.f};
    bf16x8 At[4][2], B0[2][2], B1[2][2];
    const char* cA = (const char*)g.A + (size_t)cur.pm * tstep; const char* cB = (const char*)g.Bt + (size_t)cur.e * g.bgstride + (size_t)cur.pn * tstep;
    PG8_STAGE(PG8_SB(0, 0), cB, voffB); PG8_STAGE(PG8_SA(0, 0), cA, voffA); PG8_STAGE(PG8_SB(0, 1), cB + hstep, voffB); PG8_STAGE(PG8_SA(0, 1), cA + hstep, voffA);
    if (wr == 1) PG8_BAR;
    PG8_WAIT_V(4); PG8_BAR;
    PG8_STAGE(PG8_SB(1, 0), cB + kstep, voffB); PG8_STAGE(PG8_SA(1, 0), cA + kstep, voffA); PG8_STAGE(PG8_SB(1, 1), cB + hstep + kstep, voffB);
    PG8_WAIT_V(6); PG8_BAR;
    for (;;) {
        const bool has_next = S.next(ui + 1, nxt);
        const char* nA = has_next ? (const char*)g.A + (size_t)nxt.pm * tstep : cA; const char* nB = has_next ? (const char*)g.Bt + (size_t)nxt.e * g.bgstride + (size_t)nxt.pn * tstep : cB;
        for (int t = 0; t < nt; t += 2) {
            const bool last = (t == nt - 2);
            if (last) pre = E.prefetch(cur, wc, fq);
            const char* a1 = cA + (size_t)(t + 1) * kstep;
            const char* a2 = last ? nA : cA + (size_t)(t + 2) * kstep; const char* b2 = last ? nB : cB + (size_t)(t + 2) * kstep;
            const char* a3 = a2 + kstep; const char* b3 = b2 + kstep;
            PG8_LDB(B0, 0, 0); PG8_SCHED; PG8_LDA(At, 0, 0); PG8_STAGE(PG8_SA(1, 1), a1 + hstep, voffA);
            PG8_WAIT_L(8); PG8_BAR; PG8_WAIT_L(0); PG8_MMA(0, 0, At, B0); PG8_BAR; PG8_SCHED;
            PG8_LDB(B1, 0, 1); PG8_STAGE(PG8_SB(0, 0), b2, voffB);
            PG8_BAR; PG8_WAIT_L(0); PG8_MMA(0, 1, At, B1); PG8_BAR;
            PG8_LDA(At, 0, 1); PG8_STAGE(PG8_SA(0, 0), a2, voffA);
            PG8_BAR; PG8_WAIT_L(0); PG8_MMA(1, 0, At, B0); PG8_BAR; PG8_SCHED;
            PG8_STAGE(PG8_SB(0, 1), b2 + hstep, voffB);
            PG8_WAIT_V(6); PG8_BAR; PG8_MMA(1, 1, At, B1); PG8_BAR;
            PG8_LDB(B0, 1, 0); PG8_SCHED; PG8_LDA(At, 1, 0); PG8_STAGE(PG8_SA(0, 1), a2 + hstep, voffA);
            PG8_WAIT_L(8); PG8_BAR; PG8_WAIT_L(0); PG8_MMA(0, 0, At, B0); PG8_BAR; PG8_SCHED;
            PG8_LDB(B1, 1, 1); PG8_STAGE(PG8_SB(1, 0), b3, voffB);
            PG8_BAR; PG8_WAIT_L(0); PG8_MMA(0, 1, At, B1); PG8_BAR;
            PG8_LDA(At, 1, 1); PG8_STAGE(PG8_SA(1, 0), a3, voffA);
            PG8_BAR; PG8_WAIT_L(0); PG8_MMA(1, 0, At, B0); PG8_BAR; PG8_SCHED;
            PG8_STAGE(PG8_SB(1, 1), b3 + hstep, voffB);
            PG8_WAIT_V(6); PG8_BAR; PG8_MMA(1, 1, At, B1); PG8_BAR;
        }
        E(acc, cur, wr, wc, fr, fq, pre);
        if (!has_next) break;
#pragma unroll
        for (int a = 0; a < 2; ++a)
#pragma unroll
            for (int b = 0; b < 2; ++b)
#pragma unroll
                for (int m = 0; m < 4; ++m)
#pragma unroll
                    for (int n = 0; n < 2; ++n) acc[a][b][m][n] = (f32x4){0.f, 0.f, 0.f, 0.f};
        cur = nxt; cA = nA; cB = nB; ++ui;
    }
    PG8_WAIT_V(0);
    if (wr == 0) PG8_BAR;
    PG8_BAR;
#undef PG8_SA
#undef PG8_SB
#undef PG8_STAGE
#undef PG8_LDA
#undef PG8_LDB
#undef PG8_MMA
#undef PG8_WAIT_V
#undef PG8_WAIT_L
#undef PG8_BAR
#undef PG8_SCHED
}
}
PH unsigned short f2bf(float f) { unsigned u = __float_as_uint(f); u += 0x7fffu + ((u >> 16) & 1u); return (unsigned short)(u >> 16); }
PH float bf2f(unsigned short h) { return __uint_as_float((unsigned)h << 16); }
PH float bflo(unsigned w) { return __uint_as_float(w << 16); }
PH float bfhi(unsigned w) { return __uint_as_float(w & 0xffff0000u); }

PH void ph_copy(const Params& p) {
    const int n4x = NX * D / 4, n4 = NT * D / 4, st = GDIM() * NTHR;
    const float4* x4 = (const float4*)p.x; const float4* c4 = (const float4*)p.ctx; pg8::u32x2* h2 = (pg8::u32x2*)p.h;
    for (int i = BID() * NTHR + TID(); i < n4; i += 2 * st) {
        int j = i + st; const bool h1 = j < n4; j = h1 ? j : i;
        const float4 a = *(i < n4x ? x4 + i : c4 + (i - n4x)), b = *(j < n4x ? x4 + j : c4 + (j - n4x));
        pg8::u32x2 wa, wb; wa.x = pg8::cvt_pk_bf16(a.x, a.y); wa.y = pg8::cvt_pk_bf16(a.z, a.w); wb.x = pg8::cvt_pk_bf16(b.x, b.y); wb.y = pg8::cvt_pk_bf16(b.z, b.w);
        h2[i] = wa; if (h1) h2[j] = wb;
    }
}
PH void ph_ada(const Params& p, float* lds) {
    float* sc = lds;
    float* part = lds + 17 * 1024;
    const int tid = TID();
    for (int i = tid; i < 17 * 1024; i += NTHR) { const int r = i >> 10, k = i & 1023; const float v = r < 16 ? p.c[r * 1024 + k] : p.c_ctx[k]; sc[i] = v / (1.f + expf(-v)); }
    __syncthreads();
    for (int unit = BID(); unit < 4 * 96; unit += GDIM()) {
        const int l = unit / 96, cb = unit % 96, cl = tid & 63, ks = tid >> 6;
        const float* W = p.ada_w + (size_t)l * 1024 * MODW + cb * 64 + cl;
        float acc[17];
#pragma unroll
        for (int r = 0; r < 17; ++r) acc[r] = 0.f;
#pragma unroll 1
        for (int k = ks * 128; k < ks * 128 + 128; k += 16) {
            float w[16];
#pragma unroll
            for (int q = 0; q < 16; ++q) w[q] = W[(size_t)(k + q) * MODW];
#pragma unroll
            for (int q4 = 0; q4 < 4; ++q4)
#pragma unroll
                for (int r = 0; r < 17; ++r) { const float4 s4 = *(const float4*)(sc + r * 1024 + k + 4 * q4);
                    acc[r] += s4.x * w[4 * q4] + s4.y * w[4 * q4 + 1] + s4.z * w[4 * q4 + 2] + s4.w * w[4 * q4 + 3]; }
        }
#pragma unroll
        for (int r = 0; r < 17; ++r) part[(ks * 17 + r) * 64 + cl] = acc[r];
        __syncthreads();
        for (int i = tid; i < 17 * 64; i += NTHR) {
            const int r = i >> 6, cc = i & 63; float s = 0.f;
#pragma unroll
            for (int q = 0; q < 8; ++q) s += part[(q * 17 + r) * 64 + cc];
            p.mod[((size_t)l * 17 + r) * MODW + cb * 64 + cc] = s + p.ada_b[l * MODW + cb * 64 + cc];
        }
        __syncthreads();
    }
}
PH void ph_norm_mod(const bf16_t* h, const float* g, const float* modl, int sh_off, int sc_off, float* out, bf16_t* out16, int nrows) {
    const int lane = TID() & 63, wave = (BID() * NTHR + TID()) >> 6, nw = GDIM() * NWAVE;
    for (int r0 = wave; r0 < nrows; r0 += 2 * nw) {
        const int r1 = r0 + nw; const bool has1 = r1 < nrows;
        const pg8::u32x2* hp0 = (const pg8::u32x2*)(h + (size_t)r0 * D); const pg8::u32x2* hp1 = (const pg8::u32x2*)(h + (size_t)(has1 ? r1 : r0) * D);
        float4 v0[4], v1[4]; float ss0 = 0.f, ss1 = 0.f;
#pragma unroll
        for (int i = 0; i < 4; ++i) { const pg8::u32x2 a = hp0[lane + 64 * i], b = hp1[lane + 64 * i];
            v0[i] = make_float4(bflo(a.x), bfhi(a.x), bflo(a.y), bfhi(a.y)); v1[i] = make_float4(bflo(b.x), bfhi(b.x), bflo(b.y), bfhi(b.y)); }
#pragma unroll
        for (int i = 0; i < 4; ++i) { ss0 += v0[i].x * v0[i].x + v0[i].y * v0[i].y + v0[i].z * v0[i].z + v0[i].w * v0[i].w; ss1 += v1[i].x * v1[i].x + v1[i].y * v1[i].y + v1[i].z * v1[i].z + v1[i].w * v1[i].w; }
        ss0 = wave_sum(ss0); ss1 = wave_sum(ss1);
        const float* mra = modl + (size_t)mod_row(r0) * MODW; const float* mrb = modl + (size_t)mod_row(has1 ? r1 : r0) * MODW;
        float4 gq[4], sha[4], sca[4], shb[4], scb[4];
#pragma unroll
        for (int i = 0; i < 4; ++i) { const int col = (lane + 64 * i) * 4; gq[i] = *(const float4*)(g + col);
            sha[i] = *(const float4*)(mra + sh_off + col); sca[i] = *(const float4*)(mra + sc_off + col); shb[i] = *(const float4*)(mrb + sh_off + col); scb[i] = *(const float4*)(mrb + sc_off + col); }
#pragma unroll
        for (int rr = 0; rr < 2; ++rr) {
            if (rr == 1 && !has1) break;
            const int r = rr ? r1 : r0; const float rs = rsqrtf((rr ? ss1 : ss0) * (1.f / 1024.f) + 1e-5f);
#pragma unroll
            for (int i = 0; i < 4; ++i) {
                const int col = (lane + 64 * i) * 4; const float4 vv = rr ? v1[i] : v0[i];
                const float4 gg = gq[i];
                float4 o; o.x = vv.x * rs * gg.x; o.y = vv.y * rs * gg.y; o.z = vv.z * rs * gg.z; o.w = vv.w * rs * gg.w;
                {
                    const float4 sh = rr ? shb[i] : sha[i], sc = rr ? scb[i] : sca[i];
                    o.x = o.x * (1.f + sc.x) + sh.x; o.y = o.y * (1.f + sc.y) + sh.y; o.z = o.z * (1.f + sc.z) + sh.z; o.w = o.w * (1.f + sc.w) + sh.w;
                }
                if (out) *(float4*)(out + (size_t)r * D + col) = o;
                if (out16) { pg8::u32x2 w; w.x = pg8::cvt_pk_bf16(o.x, o.y); w.y = pg8::cvt_pk_bf16(o.z, o.w); *(pg8::u32x2*)(out16 + (size_t)r * D + col) = w; }
            }
        }
    }
}

PH void ph_resid_norm(bf16_t* h, const bf16_t* yx, const float* gate, const float* g, const float* modl, int sh_off, int sc_off, bf16_t* out16, int nrows) {
    const int lane = TID() & 63, wave = (BID() * NTHR + TID()) >> 6, nw = GDIM() * NWAVE;
    for (int r0 = wave; r0 < nrows; r0 += 2 * nw) {
        const int r1 = r0 + nw; const bool has1 = r1 < nrows; const int rb = has1 ? r1 : r0;
        float4 v0[4], v1[4]; pg8::u32x2 y0[4], y1[4];
#pragma unroll
        for (int i = 0; i < 4; ++i) { const pg8::u32x2 ha = ((const pg8::u32x2*)(h + (size_t)r0 * D))[lane + 64 * i], hb = ((const pg8::u32x2*)(h + (size_t)rb * D))[lane + 64 * i];
            v0[i] = make_float4(bflo(ha.x), bfhi(ha.x), bflo(ha.y), bfhi(ha.y)); v1[i] = make_float4(bflo(hb.x), bfhi(hb.x), bflo(hb.y), bfhi(hb.y));
            y0[i] = ((const pg8::u32x2*)(yx + (size_t)r0 * D))[lane + 64 * i]; y1[i] = ((const pg8::u32x2*)(yx + (size_t)rb * D))[lane + 64 * i]; }
        const float* g0p = gate + (size_t)mod_row(r0) * MODW; const float* g1p = gate + (size_t)mod_row(rb) * MODW;
        float4 ga[4], gb[4];
#pragma unroll
        for (int i = 0; i < 4; ++i) { const int col = (lane + 64 * i) * 4; ga[i] = *(const float4*)(g0p + col); gb[i] = *(const float4*)(g1p + col); }
        const float* mr0 = modl + (size_t)mod_row(r0) * MODW; const float* mr1 = modl + (size_t)mod_row(rb) * MODW;
        float4 gg[4], sh0[4], sc0[4], sh1[4], sc1[4];
#pragma unroll
        for (int i = 0; i < 4; ++i) { const int col = (lane + 64 * i) * 4; gg[i] = *(const float4*)(g + col);
            sh0[i] = *(const float4*)(mr0 + sh_off + col); sc0[i] = *(const float4*)(mr0 + sc_off + col); sh1[i] = *(const float4*)(mr1 + sh_off + col); sc1[i] = *(const float4*)(mr1 + sc_off + col); }
        float ss0 = 0.f, ss1 = 0.f;
#pragma unroll
        for (int i = 0; i < 4; ++i) {
            v0[i].x += ga[i].x * bflo(y0[i].x); v0[i].y += ga[i].y * bfhi(y0[i].x); v0[i].z += ga[i].z * bflo(y0[i].y); v0[i].w += ga[i].w * bfhi(y0[i].y);
            v1[i].x += gb[i].x * bflo(y1[i].x); v1[i].y += gb[i].y * bfhi(y1[i].x); v1[i].z += gb[i].z * bflo(y1[i].y); v1[i].w += gb[i].w * bfhi(y1[i].y);
            ss0 += v0[i].x * v0[i].x + v0[i].y * v0[i].y + v0[i].z * v0[i].z + v0[i].w * v0[i].w; ss1 += v1[i].x * v1[i].x + v1[i].y * v1[i].y + v1[i].z * v1[i].z + v1[i].w * v1[i].w; }
#pragma unroll
        for (int i = 0; i < 4; ++i) { pg8::u32x2 wa, wb; wa.x = pg8::cvt_pk_bf16(v0[i].x, v0[i].y); wa.y = pg8::cvt_pk_bf16(v0[i].z, v0[i].w); wb.x = pg8::cvt_pk_bf16(v1[i].x, v1[i].y); wb.y = pg8::cvt_pk_bf16(v1[i].z, v1[i].w);
            ((pg8::u32x2*)(h + (size_t)r0 * D))[lane + 64 * i] = wa; if (has1) ((pg8::u32x2*)(h + (size_t)r1 * D))[lane + 64 * i] = wb; }
        ss0 = wave_sum(ss0); ss1 = wave_sum(ss1);
#pragma unroll
        for (int rr = 0; rr < 2; ++rr) {
            if (rr == 1 && !has1) break;
            const int r = rr ? r1 : r0; const float rs = rsqrtf((rr ? ss1 : ss0) * (1.f / 1024.f) + 1e-5f);
#pragma unroll
            for (int i = 0; i < 4; ++i) {
                const int col = (lane + 64 * i) * 4; const float4 vv = rr ? v1[i] : v0[i]; const float4 sh = rr ? sh1[i] : sh0[i], sc = rr ? sc1[i] : sc0[i];
                float4 o; o.x = vv.x * rs * gg[i].x * (1.f + sc.x) + sh.x; o.y = vv.y * rs * gg[i].y * (1.f + sc.y) + sh.y; o.z = vv.z * rs * gg[i].z * (1.f + sc.z) + sh.z; o.w = vv.w * rs * gg[i].w * (1.f + sc.w) + sh.w;
                pg8::u32x2 w; w.x = pg8::cvt_pk_bf16(o.x, o.y); w.y = pg8::cvt_pk_bf16(o.z, o.w); *(pg8::u32x2*)(out16 + (size_t)r * D + col) = w;
            }
        }
    }
}

constexpr int GLDA = 132;
template <class ARow, class EPI>
PH void gemm_tile(float* lds, ARow arow, const float* __restrict__ B, int ldb, int N, int K, int m0, int n0, EPI epi) {
    float* As = lds; float* Bs = lds + 16 * GLDA;
    const int tid = TID(), ty = tid >> 4, tx = tid & 15;
    const int ar = tid >> 2, akq = (tid & 3) * 4;
    const float* ap = arow(m0 + ar);
    const int bk = (tid & 255) >> 4, bn = (tid & 15) * 4;
    const bool bload = tid < 256 && (n0 + bn) < N;
    float acc[4][4];
#pragma unroll
    for (int i = 0; i < 4; ++i)
#pragma unroll
        for (int j = 0; j < 4; ++j) acc[i][j] = 0.f;
    for (int k0 = 0; k0 < K; k0 += 16) {
        float4 av = make_float4(0.f, 0.f, 0.f, 0.f), bv = make_float4(0.f, 0.f, 0.f, 0.f);
        if (ap) av = *(const float4*)(ap + k0 + akq);
        if (bload) bv = *(const float4*)(B + (size_t)(k0 + bk) * ldb + n0 + bn);
        __syncthreads();
        As[(akq + 0) * GLDA + ar] = av.x; As[(akq + 1) * GLDA + ar] = av.y; As[(akq + 2) * GLDA + ar] = av.z; As[(akq + 3) * GLDA + ar] = av.w;
        if (tid < 256) *(float4*)&Bs[bk * 64 + bn] = bv;
        __syncthreads();
#pragma unroll
        for (int k = 0; k < 16; ++k) {
            const float4 a = *(const float4*)&As[k * GLDA + ty * 4];
            const float4 b = *(const float4*)&Bs[k * 64 + tx * 4];
            acc[0][0] += a.x * b.x; acc[0][1] += a.x * b.y; acc[0][2] += a.x * b.z; acc[0][3] += a.x * b.w;
            acc[1][0] += a.y * b.x; acc[1][1] += a.y * b.y; acc[1][2] += a.y * b.z; acc[1][3] += a.y * b.w;
            acc[2][0] += a.z * b.x; acc[2][1] += a.z * b.y; acc[2][2] += a.z * b.z; acc[2][3] += a.z * b.w;
            acc[3][0] += a.w * b.x; acc[3][1] += a.w * b.y; acc[3][2] += a.w * b.z; acc[3][3] += a.w * b.w;
        }
    }
    __syncthreads();
    const int col = n0 + tx * 4;
    if (col < N) {
#pragma unroll
        for (int i = 0; i < 4; ++i) epi(m0 + ty * 4 + i, col, make_float4(acc[i][0], acc[i][1], acc[i][2], acc[i][3]));
    }
}
PH void ph_gemm_plain(float* lds, const float* A, int lda, const float* B, int ldb, float* C, int ldc, int M, int N, int K) {
    const int nct = (N + 63) / 64, nunits = (M / 128) * nct;
    for (int u = BID(); u < nunits; u += GDIM()) {
        const int mt = u / nct, ct = u % nct;
        gemm_tile(lds, [&](int r) { return A + (size_t)r * lda; }, B, ldb, N, K, mt * 128, ct * 64,
                  [&](int row, int col, float4 v) { *(float4*)(C + (size_t)row * ldc + col) = v; });
    }
}
PH void ph_gemm_resid(float* lds, const float* A, const float* B, float* h, const float* modl, int gate_off) {
    const int nct = D / 64, nunits = (NT / 128) * nct;
    for (int u = BID(); u < nunits; u += GDIM()) {
        const int mt = u / nct, ct = u % nct;
        gemm_tile(lds, [&](int r) { return A + (size_t)r * D; }, B, D, D, D, mt * 128, ct * 64,
                  [&](int row, int col, float4 v) {
                      const float4 g = *(const float4*)(modl + (size_t)mod_row(row) * MODW + gate_off + col);
                      float4* hp = (float4*)(h + (size_t)row * D + col); float4 o = *hp;
                      o.x += g.x * v.x; o.y += g.y * v.y; o.z += g.z * v.z; o.w += g.w * v.w; *hp = o; });
    }
}

PH void ph_rope(float* px) {
    const size_t total = (size_t)NX * 480;
    for (size_t i = (size_t)BID() * NTHR + TID(); i < total; i += (size_t)GDIM() * NTHR) {
        const int r = (int)(i / 480), q5 = (int)(i % 480), hh = q5 >> 5, q = q5 & 31, a = q >> 4, f = q & 15;
        const int t = r & 2047, pos = a ? (t & 63) : (t >> 6);
        const float inv = powf(10000.f, -(float)f / 16.f);
        const float ang = (float)pos * inv, cs = cosf(ang), sn = sinf(ang);
        float* base = px + (size_t)r * EVEN_IN + 256 + hh * 64 + a * 32 + f;
        const float x1 = base[0], x2 = base[16];
        base[0] = x1 * cs - x2 * sn; base[16] = x2 * cs + x1 * sn;
    }
}
PH void ph_pool(const float* px, const float* pool_w, const float* pool_scale, bf16_t* mix) {
    const int lane = TID() & 63, wave = (BID() * NTHR + TID()) >> 6, nw = GDIM() * NWAVE;
    for (int task = wave; task < NT * 4; task += nw) {
        const int r = task >> 2, gi = task & 3; int s0, len, t; seq_info(r, s0, len, t);
        const int w = 2 << gi; int lo = t - w / 2, hi = t - w / 2 + w; lo = lo < 0 ? 0 : lo; hi = hi > len ? len : hi;
        float s = 0.f;
        for (int tt = lo; tt < hi; ++tt) s += px[(size_t)(s0 + tt) * EVEN_IN + gi * 64 + lane];
        const float pooled = s / (float)(hi - lo) - px[(size_t)r * EVEN_IN + gi * 64 + lane];
        const float* pw = pool_w + (size_t)gi * 4096;
        float acc = 0.f;
#pragma unroll 8
        for (int c = 0; c < 64; ++c) acc += __shfl(pooled, c) * pw[c * 64 + lane];
        mix[(size_t)r * D + gi * 64 + lane] = f2bf(acc * pool_scale[gi * 64 + lane]);
    }
}
PH void ph_attn(float* lds, const float* px, const float* sink, bf16_t* mix) {
    const int lane = TID() & 63, wib = TID() >> 6, wave = (BID() * NTHR + TID()) >> 6, nw = GDIM() * NWAVE;
    float* pb = lds + wib * 576;
    for (int task = wave; task < NT * 12; task += nw) {
        const int r = task / 12, hh = task % 12, kvh = hh >> 2;
        const bool lat = r < NX;
        const int b = lat ? (r >> 11) : ((r - NX) >> 8);
        int klo = 0, nloc = 0;
        if (lat) { const int t = r & 2047; klo = t - 128 < 0 ? 0 : t - 128; const int khi = t + 128 > 2047 ? 2047 : t + 128; nloc = khi - klo + 1; }
        const int nkeys = nloc + CTX;
        float q[64];
        const float* qp = px + (size_t)r * EVEN_IN + 256 + hh * 64;
#pragma unroll
        for (int d4 = 0; d4 < 16; ++d4) { const float4 v = *(const float4*)(qp + d4 * 4); q[d4 * 4] = v.x; q[d4 * 4 + 1] = v.y; q[d4 * 4 + 2] = v.z; q[d4 * 4 + 3] = v.w; }
        float mx = sink[hh];
        for (int kidx = lane; kidx < nkeys; kidx += 64) {
            const int krow = kidx < nloc ? (b * SEQ + klo + kidx) : (NX + b * CTX + (kidx - nloc));
            const float* kp = px + (size_t)krow * EVEN_IN + 1024 + kvh * 64;
            float s = 0.f;
#pragma unroll
            for (int d4 = 0; d4 < 16; ++d4) { const float4 v = *(const float4*)(kp + d4 * 4); s += q[d4 * 4] * v.x + q[d4 * 4 + 1] * v.y + q[d4 * 4 + 2] * v.z + q[d4 * 4 + 3] * v.w; }
            s *= 0.125f;
            pb[kidx] = s; mx = fmaxf(mx, s);
        }
        mx = wave_max(mx);
        float den = 0.f;
        for (int kidx = lane; kidx < nkeys; kidx += 64) { const float e = expf(pb[kidx] - mx); pb[kidx] = e; den += e; }
        den = wave_sum(den) + expf(sink[hh] - mx);
        __builtin_amdgcn_wave_barrier();
        float acc = 0.f;
        for (int kidx = 0; kidx < nkeys; ++kidx) {
            const int krow = kidx < nloc ? (b * SEQ + klo + kidx) : (NX + b * CTX + (kidx - nloc));
            acc += pb[kidx] * px[(size_t)krow * EVEN_IN + 1216 + kvh * 64 + lane];
        }
        mix[(size_t)r * D + 256 + hh * 64 + lane] = f2bf(acc / den);
        __builtin_amdgcn_wave_barrier();
    }
}


PH void ph_rope_tab(float* rc, float* rs) {
    const int i = BID() * NTHR + TID();
    if (i < 1024) { const int pos = i >> 4, f = i & 15; const float inv = powf(10000.f, -(float)f / 16.f), ang = (float)pos * inv; rc[i] = cosf(ang); rs[i] = sinf(ang); }
}
struct EpiRopeBf16 {
    static constexpr bool PERM = true;
    bf16_t* O; int ldc; const float* ct; const float* st;
    struct Pre {}; __device__ __forceinline__ Pre prefetch(const pg8::Unit&, int, int) const { return Pre{}; }
    __device__ __forceinline__ void operator()(const pg8::f32x4 (&acc)[2][2][4][2], const pg8::Unit& u, int wr, int wc, int fr, int fq, const Pre&) const {
        const int row0 = u.pm * 256 + wr * 64 + fr; const bool lat = u.pm * 256 < NX;
        const float sgn = fq < 2 ? -1.f : 1.f; const int f0 = 8 * (fq & 1);
#pragma unroll
        for (int ai = 0; ai < 2; ++ai)
#pragma unroll
            for (int m = 0; m < 4; ++m) { const int row = row0 + ai * 128 + m * 16, t = row & 2047;
#pragma unroll
                for (int bj = 0; bj < 2; ++bj) { const int cbase = u.pn * 256 + bj * 128 + wc * 32;
                    const pg8::f32x4 zz = (pg8::f32x4){0.f, 0.f, 0.f, 0.f};
                    pg8::f32x4 v0 = acc[ai][bj][m][0] + zz, v1 = acc[ai][bj][m][1] + zz;
                    if (lat && cbase >= 256 && cbase < 1216) {
                        const int pos = ((cbase >> 5) & 1) ? (t & 63) : (t >> 6);
                        const pg8::f32x4 c0 = *(const pg8::f32x4*)(ct + pos * 16 + f0), c1 = *(const pg8::f32x4*)(ct + pos * 16 + f0 + 4);
                        const pg8::f32x4 s0 = *(const pg8::f32x4*)(st + pos * 16 + f0) * sgn, s1 = *(const pg8::f32x4*)(st + pos * 16 + f0 + 4) * sgn;
                        pg8::f32x4 o0, o1;
#pragma unroll
                        for (int q = 0; q < 4; ++q) { o0[q] = __shfl_xor(v0[q], 32); o1[q] = __shfl_xor(v1[q], 32); }
                        v0 = v0 * c0 + o0 * s0; v1 = v1 * c1 + o1 * s1;
                    }
                    pg8::u32x4 w; w.x = pg8::cvt_pk_bf16(v0[0], v0[1]); w.y = pg8::cvt_pk_bf16(v0[2], v0[3]); w.z = pg8::cvt_pk_bf16(v1[0], v1[1]); w.w = pg8::cvt_pk_bf16(v1[2], v1[3]);
                    *(pg8::u32x4*)(O + (size_t)row * ldc + cbase + 8 * fq) = w; } }
    }
};
PH void ph_pool_prep(const float* pw, bf16_t* pwt) {
    for (int i = BID() * NTHR + TID(); i < 2 * 4 * 64 * 64; i += GDIM() * NTHR) { const int m = i >> 12, d = (i >> 6) & 63, c = i & 63; pwt[i] = f2bf(pw[(m << 12) + c * 64 + d]); }
}
template <int HALF>
PH void pool_window(const bf16_t* col, int t0, int len, LAS unsigned char* Pt, int lane) {
    float v[64 + 2 * HALF];
#pragma unroll
    for (int j = 0; j < 64 + 2 * HALF; ++j) { const int t = t0 - HALF + j; const bool in = t >= 0 && t < len; const float x = bf2f(col[(size_t)(in ? t : t0) * 1536]); v[j] = in ? x : 0.f; }
    float sum = 0.f;
#pragma unroll
    for (int j = 0; j < 2 * HALF; ++j) sum += v[j];
#pragma unroll
    for (int i = 0; i < 64; ++i) {
        const int t = t0 + i, lo = t - HALF < 0 ? 0 : t - HALF, hi = t + HALF > len ? len : t + HALF;
        *(LAS unsigned short*)(Pt + i * 144 + lane * 2) = f2bf(sum * __builtin_amdgcn_rcpf((float)(hi - lo)) - v[i + HALF]);
        sum += v[i + 2 * HALF] - v[i];
    }
}
PH void ph_pool16(LAS unsigned char* lsm, const bf16_t* px, const bf16_t* pwt, const float* pool_scale, bf16_t* mix) {
    const int lane = TID() & 63, wib = TID() >> 6, wave = BID() * NWAVE + wib, nw = GDIM() * NWAVE, fr = lane & 15, fq = lane >> 4;
    LAS unsigned char* Pt = lsm + STAGE_OFF + wib * (64 * 144);
    for (int task = wave; task < (NT / 64) * 4; task += nw) {
        const int r0 = (task >> 2) * 64, gi = task & 3; int s0, len, t0; seq_info(r0, s0, len, t0);
        const bf16_t* col = px + (size_t)s0 * 1536 + gi * 64 + lane;
        __builtin_amdgcn_wave_barrier();
        if (gi == 0) pool_window<1>(col, t0, len, Pt, lane); else if (gi == 1) pool_window<2>(col, t0, len, Pt, lane); else if (gi == 2) pool_window<4>(col, t0, len, Pt, lane); else pool_window<8>(col, t0, len, Pt, lane);
        __builtin_amdgcn_wave_barrier();
        pg8::bf16x8 wf[4][2];
#pragma unroll
        for (int nt = 0; nt < 4; ++nt)
#pragma unroll
            for (int ks = 0; ks < 2; ++ks) wf[nt][ks] = *(const pg8::bf16x8*)(pwt + (size_t)gi * 4096 + (16 * nt + fr) * 64 + 32 * ks + 8 * fq);
#pragma unroll
        for (int mt = 0; mt < 4; ++mt) {
            pg8::bf16x8 pf[2];
#pragma unroll
            for (int ks = 0; ks < 2; ++ks) pf[ks] = *(const LAS pg8::bf16x8*)(Pt + (16 * mt + fr) * 144 + (32 * ks + 8 * fq) * 2);
#pragma unroll
            for (int nt = 0; nt < 4; ++nt) {
                pg8::f32x4 acc = (pg8::f32x4){0.f, 0.f, 0.f, 0.f};
#pragma unroll
                for (int ks = 0; ks < 2; ++ks) acc = __builtin_amdgcn_mfma_f32_16x16x32_bf16(wf[nt][ks], pf[ks], acc, 0, 0, 0);
                const pg8::f32x4 sc = *(const pg8::f32x4*)(pool_scale + gi * 64 + 16 * nt + 4 * fq);
                const pg8::f32x4 v = acc * sc;
                pg8::u32x2 o; o.x = pg8::cvt_pk_bf16(v[0], v[1]); o.y = pg8::cvt_pk_bf16(v[2], v[3]);
                *(pg8::u32x2*)(mix + (size_t)(r0 + 16 * mt + fr) * D + gi * 64 + 16 * nt + 4 * fq) = o;
            }
        }
        __builtin_amdgcn_wave_barrier();
    }
    __syncthreads();
}
typedef short s16x4 __attribute__((ext_vector_type(4)));
typedef float f32x16 __attribute__((ext_vector_type(16)));
constexpr int AT_KP = 144, AT_VP = 192, AT_KB = 64 * AT_KP, AT_VB = 64 * AT_VP;
PH pg8::bf16x8 pack_bf16x8(float x0, float x1, float x2, float x3, float x4, float x5, float x6, float x7) {
    pg8::u32x4 pk; pk[0] = pg8::cvt_pk_bf16(x0, x1); pk[1] = pg8::cvt_pk_bf16(x2, x3); pk[2] = pg8::cvt_pk_bf16(x4, x5); pk[3] = pg8::cvt_pk_bf16(x6, x7);
    return __builtin_bit_cast(pg8::bf16x8, pk);
}
PH void ph_attn16(LAS unsigned char* lsm, const bf16_t* px, const float* sink, bf16_t* mix) {
    LAS unsigned char* base = lsm + STAGE_OFF;
    const int tid = TID(), lane = tid & 63, wid = __builtin_amdgcn_readfirstlane(tid >> 6), l31 = lane & 31, h = lane >> 5;
    const int skey = tid >> 3, spc = tid & 7;
    const int trq = (lane & 15) >> 2, trp = lane & 3, trblk = (lane >> 4) & 1;
    const float C = 0.125f * 1.4426950408889634f;
    for (int u = BID(); u < 1728; u += GDIM()) {
        int b, kvh, q0, nb, c_lo, qrow0;
        if (u < 1536) { b = u / 96; const int rem = u % 96; kvh = rem >> 5; q0 = (rem & 31) * 64;
            c_lo = (128 - q0 + 63) >> 6; c_lo = c_lo < 0 ? 0 : c_lo; int c_hi = (2112 - q0) >> 6; c_hi = c_hi > 4 ? 4 : c_hi; nb = c_hi - c_lo + 1; qrow0 = b * SEQ + q0; }
        else { const int v = u - 1536; b = v / 12; const int rem = v % 12; kvh = rem >> 2; q0 = 0; c_lo = 0; nb = 0; qrow0 = NX + b * CTX + (rem & 3) * 64; }
        const int n = nb + 4;
        const int hq = kvh * 4 + (wid >> 1), iq = 32 * (wid & 1) + l31;
        pg8::bf16x8 qf[4];
        { const bf16_t* qp = px + (size_t)(qrow0 + iq) * 1536 + 256 + hq * 64 + 8 * h;
#pragma unroll
          for (int s = 0; s < 4; ++s) qf[s] = *(const pg8::bf16x8*)(qp + 16 * s); }
        float mrun = sink[hq] * 1.4426950408889634f, lrun = h == 0 ? 1.f : 0.f;
        f32x16 o[2];
#pragma unroll
        for (int q = 0; q < 16; ++q) { o[0][q] = 0.f; o[1][q] = 0.f; }
        const size_t kcol = 1024 + kvh * 64 + spc * 8, vcol = 1216 + kvh * 64 + spc * 8;
        pg8::u32x4 kreg, vreg, kreg2, vreg2;
        auto kvload = [&](int kk, pg8::u32x4& kr, pg8::u32x4& vr) { kk = kk < n ? kk : n - 1;
            const int rowbase = kk < nb ? b * SEQ + q0 - 128 + 64 * (c_lo + kk) : NX + b * CTX + 64 * (kk - nb);
            const bf16_t* rp = px + (size_t)(rowbase + skey) * 1536; kr = *(const pg8::u32x4*)(rp + kcol); vr = *(const pg8::u32x4*)(rp + vcol); };
        kvload(0, kreg2, vreg2); kvload(1, kreg, vreg);
        *(LAS pg8::u32x4*)(base + skey * AT_KP + spc * 16) = kreg2;
        *(LAS pg8::u32x4*)(base + 2 * AT_KB + skey * AT_VP + spc * 16) = vreg2;
        __syncthreads();
        for (int k = 0; k < n; ++k) {
            int mtype = 0;
            if (k < nb) { const int c = c_lo + k; mtype = c == 0 ? 1 : (c == 4 ? 2 : 0); }
            kvload(k + 2, kreg2, vreg2);
            const LAS unsigned char* Kb = base + (k & 1) * AT_KB; const LAS unsigned char* Vb = base + 2 * AT_KB + (k & 1) * AT_VB;
            f32x16 st[2];
#pragma unroll
            for (int kt = 0; kt < 2; ++kt) {
#pragma unroll
                for (int q = 0; q < 16; ++q) st[kt][q] = 0.f;
#pragma unroll
                for (int s = 0; s < 4; ++s) { const pg8::bf16x8 a = *(const LAS pg8::bf16x8*)(Kb + (32 * kt + l31) * AT_KP + (16 * s + 8 * h) * 2);
                    st[kt] = __builtin_amdgcn_mfma_f32_32x32x16_bf16(a, qf[s], st[kt], 0, 0, 0); }
            }
            float mx = -1e30f;
#pragma unroll
            for (int kt = 0; kt < 2; ++kt)
#pragma unroll
                for (int r = 0; r < 16; ++r) { float t = st[kt][r] * C;
                    if (mtype) { const int j = 32 * kt + (r & 3) + 8 * (r >> 2) + 4 * h; const bool ok = mtype == 1 ? (j >= iq) : (j <= iq); t = ok ? t : -1e30f; }
                    st[kt][r] = t; mx = fmaxf(mx, t); }
            mx = fmaxf(mx, __shfl_xor(mx, 32));
            const float mnew = fmaxf(mrun, mx), alpha = __builtin_amdgcn_exp2f(mrun - mnew);
            mrun = mnew; lrun *= alpha;
#pragma unroll
            for (int q = 0; q < 16; ++q) { o[0][q] *= alpha; o[1][q] *= alpha; }
            float lsum = 0.f;
#pragma unroll
            for (int kt = 0; kt < 2; ++kt)
#pragma unroll
                for (int r = 0; r < 16; ++r) { const float pv = __builtin_amdgcn_exp2f(st[kt][r] - mnew); st[kt][r] = pv; lsum += pv; }
            lrun += lsum;
            pg8::bf16x8 pf[4];
#pragma unroll
            for (int ks = 0; ks < 4; ++ks) { const int kt = ks >> 1, s8 = (ks & 1) * 8;
                pf[ks] = pack_bf16x8(st[kt][s8], st[kt][s8 + 1], st[kt][s8 + 2], st[kt][s8 + 3], st[kt][s8 + 4], st[kt][s8 + 5], st[kt][s8 + 6], st[kt][s8 + 7]); }
#pragma unroll
            for (int dt = 0; dt < 2; ++dt)
#pragma unroll
                for (int ks = 0; ks < 4; ++ks) { const int k0 = 16 * ks + 4 * h + trq;
                    const LAS unsigned char* ap = Vb + k0 * AT_VP + (32 * dt + 16 * trblk + 4 * trp) * 2;
                    const s16x4 lo = __builtin_amdgcn_ds_read_tr16_b64_v4i16((LAS s16x4*)ap), hi = __builtin_amdgcn_ds_read_tr16_b64_v4i16((LAS s16x4*)(ap + 8 * AT_VP));
                    const pg8::bf16x8 vf = __builtin_shufflevector(lo, hi, 0, 1, 2, 3, 4, 5, 6, 7);
                    o[dt] = __builtin_amdgcn_mfma_f32_32x32x16_bf16(vf, pf[ks], o[dt], 0, 0, 0); }
            if (k + 1 < n) { *(LAS pg8::u32x4*)(base + ((k + 1) & 1) * AT_KB + skey * AT_KP + spc * 16) = kreg;
                             *(LAS pg8::u32x4*)(base + 2 * AT_KB + ((k + 1) & 1) * AT_VB + skey * AT_VP + spc * 16) = vreg; }
            kreg = kreg2; vreg = vreg2;
            asm volatile("s_waitcnt lgkmcnt(0)" ::: "memory"); __builtin_amdgcn_s_barrier(); asm volatile("" ::: "memory");
        }
        const float ltot = lrun + __shfl_xor(lrun, 32), inv = 1.f / ltot;
        bf16_t* op = mix + (size_t)(qrow0 + iq) * D + 256 + hq * 64 + 4 * h;
#pragma unroll
        for (int dt = 0; dt < 2; ++dt)
#pragma unroll
            for (int rg = 0; rg < 4; ++rg) { pg8::u32x2 w; w.x = pg8::cvt_pk_bf16(o[dt][4 * rg] * inv, o[dt][4 * rg + 1] * inv); w.y = pg8::cvt_pk_bf16(o[dt][4 * rg + 2] * inv, o[dt][4 * rg + 3] * inv);
                *(pg8::u32x2*)(op + 32 * dt + 8 * rg) = w; }
    }
}
PH void ph_scanprep(float* lds, const float* px, const OddW& w, const ScanArrays& sa) {
    float* fl = lds;
    float* hs = lds + 2720;
    const int tid = TID(), lane = tid & 63, wv = tid >> 6;
    for (int r = BID(); r < NT; r += GDIM()) {
        int s0, len, t; seq_info(r, s0, len, t);
        const float* pr = px + (size_t)r * ODD_IN;
        for (int col = tid; col < 2720; col += NTHR) {
            const float u = pr[col], pv = t > 0 ? pr[col - ODD_IN] : 0.f, nx = t < len - 1 ? pr[col + ODD_IN] : 0.f;
            float f = u + w.mu[col] * (pv - u) + w.mu[2720 + col] * (nx - u);
            if (col >= 2304 && col < 2432) f = tanhf(f);
            if (col >= 2560) f = sigmoidf_(f);
            fl[col] = f;
        }
        __syncthreads();
        float kkr[2] = {0.f, 0.f};
#pragma unroll
        for (int i = 0; i < 2; ++i) { const int c = tid + NTHR * i; if (c < RW) { kkr[i] = fl[768 + c] * w.k_k[c]; const float ss = wave_sum(kkr[i] * kkr[i]); if (lane == 0) hs[8 * i + wv] = ss; } }
        __syncthreads();
#pragma unroll
        for (int i = 0; i < 2; ++i) {
            const int c = tid + NTHR * i;
            if (c < RW) {
                const int head = c >> 6;
                float lw0 = w.w0[c], lw1 = w.w0[768 + c], la0 = w.a0[c], la1 = w.a0[768 + c], gg = 0.f;
                for (int j = 0; j < 64; ++j) {
                    lw0 += fl[2304 + j] * w.w2[(size_t)j * 768 + c];
                    lw1 += fl[2368 + j] * w.w2[(size_t)(64 + j) * 768 + c];
                    la0 += fl[2432 + j] * w.a2[(size_t)j * 768 + c];
                    la1 += fl[2496 + j] * w.a2[(size_t)(64 + j) * 768 + c];
                }
                for (int j = 0; j < 160; ++j) gg += fl[2560 + j] * w.g2[(size_t)j * 768 + c];
                const float kk = kkr[i] / fmaxf(sqrtf(hs[head]), 1e-12f);
                const float k = fl[768 + c], v = fl[1536 + c], rr = fl[c], ka = w.k_a[c];
                const size_t o = (size_t)r * RW + c;
                sa.R[o] = rr; sa.V[o] = v; sa.KK[o] = kk; sa.G[o] = gg;
                const float z0 = -lw0, sp0 = fmaxf(z0, 0.f) + log1pf(expf(-fabsf(z0))); const float wl0 = -sp0 - 0.5f;
                const float z1 = -lw1, sp1 = fmaxf(z1, 0.f) + log1pf(expf(-fabsf(z1))); const float wl1 = -sp1 - 0.5f;
                sa.W[0][o] = expf(-expf(wl0)); sa.W[1][o] = expf(-expf(wl1));
                const float a_0 = sigmoidf_(la0), a_1 = sigmoidf_(la1);
                sa.KD[0][o] = k * (1.f + (a_0 - 1.f) * ka); sa.KD[1][o] = k * (1.f + (a_1 - 1.f) * ka);
                sa.BB[0][o] = kk * a_0; sa.BB[1][o] = kk * a_1;
            }
        }
        __syncthreads();
    }
}
PH void ph_scan(float* lds, const ScanArrays& sa) {
    const int lane = TID() & 63, wib = TID() >> 6;
    const int chain = BID() * NWAVE + wib;
    if (chain >= NB * 12 * 2) return;
    float* sh = lds + wib * 320;
    const int dir = chain & 1, bh = chain >> 1, b = bh / 12, hh = bh % 12;
    const float* Wd = sa.W[dir]; const float* KD = sa.KD[dir]; const float* BB = sa.BB[dir]; float* Y = sa.Y[dir];
    float S[64];
#pragma unroll
    for (int j = 0; j < 64; ++j) S[j] = 0.f;
    for (int s = 0; s < CTX + SEQ; ++s) {
        int tok;
        if (s < CTX) { const int tt = dir ? CTX - 1 - s : s; tok = NX + b * CTX + tt; }
        else { int tt = s - CTX; tt = dir ? SEQ - 1 - tt : tt; tok = b * SEQ + tt; }
        const size_t off = (size_t)tok * RW + hh * 64 + lane;
        const float v = sa.V[off];
        __builtin_amdgcn_wave_barrier();
        sh[lane] = Wd[off]; sh[64 + lane] = KD[off]; sh[128 + lane] = BB[off]; sh[192 + lane] = sa.KK[off]; sh[256 + lane] = sa.R[off];
        __builtin_amdgcn_wave_barrier();
        float sacc = 0.f;
#pragma unroll
        for (int j = 0; j < 64; ++j) sacc += S[j] * sh[192 + j];
#pragma unroll
        for (int j = 0; j < 64; ++j) S[j] = S[j] * sh[j] + (v * sh[64 + j] - sacc * sh[128 + j]);
        float y = 0.f;
#pragma unroll
        for (int j = 0; j < 64; ++j) y += S[j] * sh[256 + j];
        Y[off] = y;
    }
}
PH void ph_readout(const ScanArrays& sa, const OddW& w, bf16_t* mix) {
    const int lane = TID() & 63, wave = (BID() * NTHR + TID()) >> 6, nw = GDIM() * NWAVE;
    for (int task = wave; task < NT * 12; task += nw) {
        const int r = task / 12, hh = task % 12, c = hh * 64 + lane;
        const size_t o = (size_t)r * RW + c;
        const float y = sa.Y[0][o] + sa.Y[1][o];
        const float mean = wave_sum(y) * (1.f / 64.f), d = y - mean, var = wave_sum(d * d) * (1.f / 64.f);
        const float yn = d * rsqrtf(var + 64e-5f) * w.gn_g[c] + w.gn_b[c];
        const float coef = wave_sum(sa.R[o] * (sa.KD[0][o] + sa.KD[1][o]) * w.r_k[c]);
        mix[(size_t)r * D + c] = f2bf((yn + coef * sa.V[o]) * sa.G[o]);
    }
}
PH void ph_fft_tab(bf16_t* tabT) {
    const int i = BID() * NTHR + TID();
    if (i < 128 * 64) { const int col = i >> 6, c = i & 63, part = col >> 6, k2 = col & 63; const float fr_ = (float)((k2 * c) & 63) / 64.f; tabT[i] = f2bf(part ? __builtin_amdgcn_sinf(fr_) : __builtin_amdgcn_cosf(fr_)); }
}
PH void ph_fft_prep16(const bf16_t* px, const bf16_t* tabT, bf16_t* bt_lat, bf16_t* bt_ctx) {
    const int lane = TID() & 63, fr = lane & 15, fq = lane >> 4, wave = (BID() * NTHR + TID()) >> 6, nw = GDIM() * NWAVE;
    for (int task = wave; task < (NT / 16) * 4; task += nw) {
        const int r0 = (task >> 2) * 16, g = task & 3;
        pg8::bf16x8 uf[2];
#pragma unroll
        for (int ks = 0; ks < 2; ++ks) uf[ks] = *(const pg8::bf16x8*)(px + (size_t)(r0 + fr) * 3072 + 2720 + g * 64 + 32 * ks + 8 * fq);
        bf16_t* base; int T, t;
        if (r0 < NX) { const int b = r0 >> 11; t = r0 & 2047; T = 2048; base = bt_lat + (size_t)(b * 4 + g) * 64 * 4096; }
        else { const int q = r0 - NX, b = q >> 8; t = q & 255; T = 256; base = bt_ctx + (size_t)(b * 4 + g) * 64 * 512; }
#pragma unroll
        for (int nt = 0; nt < 8; ++nt) {
            pg8::f32x4 acc = (pg8::f32x4){0.f, 0.f, 0.f, 0.f};
#pragma unroll
            for (int ks = 0; ks < 2; ++ks) { const pg8::bf16x8 tf = *(const pg8::bf16x8*)(tabT + (size_t)(16 * nt + fr) * 64 + 32 * ks + 8 * fq);
                acc = __builtin_amdgcn_mfma_f32_16x16x32_bf16(uf[ks], tf, acc, 0, 0, 0); }
            const int col = 16 * nt + fr, part = col >> 6, k2 = col & 63;
            pg8::u32x2 o; o.x = (unsigned)f2bf(acc[0]) | ((unsigned)f2bf(acc[1]) << 16); o.y = (unsigned)f2bf(acc[2]) | ((unsigned)f2bf(acc[3]) << 16);
            *(pg8::u32x2*)(base + (size_t)k2 * 2 * T + part * T + t + 4 * fq) = o;
        }
    }
}
PH void ph_twiddle16(bf16_t* tw, int T) {
    const size_t total = (size_t)T * T;
    for (size_t i = (size_t)BID() * NTHR + TID(); i < total; i += (size_t)GDIM() * NTHR) {
        const int k1 = (int)(i / T), t = (int)(i % T); const int m = (int)(((long long)k1 * t) % T);
        const float fr_ = (float)m / (float)T;
        tw[(size_t)k1 * 2 * T + t] = f2bf(__builtin_amdgcn_cosf(fr_)); tw[(size_t)k1 * 2 * T + T + t] = f2bf(-__builtin_amdgcn_sinf(fr_));
    }
}
struct DenseOrder : pg8::TileOrder { __device__ __forceinline__ bool next(int i, pg8::Unit& u) const { u.e = 0; return tile(i, u.pm, u.pn); } };
struct EpiF32Guard {
    static constexpr bool PERM = false;
    float* C; int ldc, ncols;
    __device__ __forceinline__ void operator()(const pg8::f32x4 (&acc)[2][2][4][2], const pg8::Unit& u, int wr, int wc, int fr, int fq) const {
        const int row0 = u.pm * 256 + wr * 64 + fr, col0 = u.pn * 256 + wc * 32 + 4 * fq;
#pragma unroll
        for (int ai = 0; ai < 2; ++ai)
#pragma unroll
            for (int m = 0; m < 4; ++m) { float* rowp = C + (size_t)(row0 + ai * 128 + m * 16) * ldc;
#pragma unroll
                for (int bj = 0; bj < 2; ++bj)
#pragma unroll
                    for (int n = 0; n < 2; ++n) { const int c = col0 + bj * 128 + n * 16; if (c < ncols) *(pg8::f32x4*)(rowp + c) = acc[ai][bj][m][n]; } }
    }
};
struct EpiResid {
    static constexpr bool PERM = false;
    float* h; const float* gate;
    __device__ __forceinline__ void operator()(const pg8::f32x4 (&acc)[2][2][4][2], const pg8::Unit& u, int wr, int wc, int fr, int fq) const {
        const int row0 = u.pm * 256 + wr * 64 + fr, col0 = u.pn * 256 + wc * 32 + 4 * fq;
#pragma unroll
        for (int ai = 0; ai < 2; ++ai)
#pragma unroll
            for (int m = 0; m < 4; ++m) { const int row = row0 + ai * 128 + m * 16; float* rowp = h + (size_t)row * D; const float* gp = gate + (size_t)mod_row(row) * MODW;
#pragma unroll
                for (int bj = 0; bj < 2; ++bj)
#pragma unroll
                    for (int n = 0; n < 2; ++n) { const int c = col0 + bj * 128 + n * 16; const pg8::f32x4 g = *(const pg8::f32x4*)(gp + c); pg8::f32x4* hp = (pg8::f32x4*)(rowp + c); *hp = *hp + g * acc[ai][bj][m][n]; } }
    }
};
struct EpiDft {
    static constexpr bool PERM = true;
    bf16_t* mix; int T, row0; float scale;
    struct Pre {}; __device__ __forceinline__ Pre prefetch(const pg8::Unit&, int, int) const { return Pre{}; }
    __device__ __forceinline__ void operator()(const pg8::f32x4 (&acc)[2][2][4][2], const pg8::Unit& u, int wr, int wc, int fr, int fq, const Pre&) const {
        const int r0 = u.pm * 256 + wr * 64 + fr, col0 = u.pn * 256 + wc * 32 + 8 * fq;
#pragma unroll
        for (int ai = 0; ai < 2; ++ai)
#pragma unroll
            for (int m = 0; m < 4; ++m) { const int k1 = r0 + ai * 128 + m * 16;
#pragma unroll
                for (int bj = 0; bj < 2; ++bj) { const int c = col0 + bj * 128, bg = c >> 6, k2 = c & 63, b = bg >> 2, g = bg & 3;
                    const pg8::f32x4 v0 = acc[ai][bj][m][0] * scale, v1 = acc[ai][bj][m][1] * scale;
                    pg8::u32x4 w; w.x = pg8::cvt_pk_bf16(v0[0], v0[1]); w.y = pg8::cvt_pk_bf16(v0[2], v0[3]); w.z = pg8::cvt_pk_bf16(v1[0], v1[1]); w.w = pg8::cvt_pk_bf16(v1[2], v1[3]);
                    *(pg8::u32x4*)(mix + (size_t)(row0 + b * T + k1) * D + 768 + g * 64 + k2) = w; } }
    }
};
struct EpiPlainBf16 {
    static constexpr bool PERM = true;
    bf16_t* O; int ldc;
    struct Pre {}; __device__ __forceinline__ Pre prefetch(const pg8::Unit&, int, int) const { return Pre{}; }
    __device__ __forceinline__ void operator()(const pg8::f32x4 (&acc)[2][2][4][2], const pg8::Unit& u, int wr, int wc, int fr, int fq, const Pre&) const {
        const int row0 = u.pm * 256 + wr * 64 + fr, col0 = u.pn * 256 + wc * 32 + 8 * fq;
#pragma unroll
        for (int ai = 0; ai < 2; ++ai)
#pragma unroll
            for (int m = 0; m < 4; ++m) { bf16_t* rowp = O + (size_t)(row0 + ai * 128 + m * 16) * ldc + col0;
#pragma unroll
                for (int bj = 0; bj < 2; ++bj) { const pg8::f32x4 zz = (pg8::f32x4){0.f, 0.f, 0.f, 0.f}; const pg8::f32x4 v0 = acc[ai][bj][m][0] + zz, v1 = acc[ai][bj][m][1] + zz;
                    pg8::u32x4 w; w.x = pg8::cvt_pk_bf16(v0[0], v0[1]); w.y = pg8::cvt_pk_bf16(v0[2], v0[3]); w.z = pg8::cvt_pk_bf16(v1[0], v1[1]); w.w = pg8::cvt_pk_bf16(v1[2], v1[3]);
                    *(pg8::u32x4*)(rowp + bj * 128) = w; } }
    }
};
template <class Epi>
PH void ph_gemm16(LAS unsigned char* smem, const bf16_t* A, const bf16_t* Bt, int M, int N, int K, const Epi& E, int blk, int nblk) {
    DenseOrder S; S.init(M / 256, N / 256, nblk, blk);
    pg8::Gemm g; g.A = A; g.Bt = Bt; g.M = M; g.N = N; g.K = K; g.bgstride = 0;
    pg8::gemm_phase(smem + STAGE_OFF, g, S, E);
}

PH void ph_convT_small(const float* src, bf16_t* dst, int K, int N, int nmat) {
    const size_t total = (size_t)nmat * K * N;
    for (size_t i = (size_t)BID() * NTHR + TID(); i < total; i += (size_t)GDIM() * NTHR) {
        const int mat = (int)(i / ((size_t)K * N)), rem = (int)(i % ((size_t)K * N)), n = rem / K, k = rem % K;
        dst[i] = f2bf(src[((size_t)mat * K + k) * N + n]);
    }
}
PH void unpack8(const pg8::u32x4 w, float (&f)[8]) { f[0] = bflo(w.x); f[1] = bfhi(w.x); f[2] = bflo(w.y); f[3] = bfhi(w.y); f[4] = bflo(w.z); f[5] = bfhi(w.z); f[6] = bflo(w.w); f[7] = bfhi(w.w); }
PH pg8::u32x4 pack8(const float (&f)[8]) { pg8::u32x4 w; w.x = pg8::cvt_pk_bf16(f[0], f[1]); w.y = pg8::cvt_pk_bf16(f[2], f[3]); w.z = pg8::cvt_pk_bf16(f[4], f[5]); w.w = pg8::cvt_pk_bf16(f[6], f[7]); return w; }
constexpr int OP_LP = 848, OP_TOK = 144;
template <int KS, int NT0, int NTN>
PH void oddprep_seg(LAS unsigned char* Lt, const bf16_t* Wt, int Kw, int koff, const float* bias, float sc, bool sig, bf16_t* outp, int t0, int wid, int fr, int fq) {
    pg8::bf16x8 wf[NTN][KS];
#pragma unroll
    for (int nt = 0; nt < NTN; ++nt)
#pragma unroll
        for (int ks = 0; ks < KS; ++ks) wf[nt][ks] = *(const pg8::bf16x8*)(Wt + (size_t)(96 * wid + 16 * NT0 + 32 * (nt >> 1) + 8 * (fr >> 2) + 4 * (nt & 1) + (fr & 3)) * Kw + 32 * ks + 8 * fq);
    pg8::f32x4 bv[NTN];
#pragma unroll
    for (int nt = 0; nt < NTN; ++nt) bv[nt] = bias ? *(const pg8::f32x4*)(bias + 96 * wid + 16 * NT0 + 32 * (nt >> 1) + 8 * fq + 4 * (nt & 1)) : (pg8::f32x4){0.f, 0.f, 0.f, 0.f};
#pragma unroll 1
    for (int mt = 0; mt < OP_TOK / 16; ++mt) {
        pg8::bf16x8 lf[KS];
#pragma unroll
        for (int ks = 0; ks < KS; ++ks) lf[ks] = *(const LAS pg8::bf16x8*)(Lt + (16 * mt + fr) * OP_LP + (koff + 32 * ks + 8 * fq) * 2);
#pragma unroll
        for (int np = 0; np < NTN / 2; ++np) {
            pg8::f32x4 v[2];
#pragma unroll
            for (int hh = 0; hh < 2; ++hh) {
                pg8::f32x4 acc = (pg8::f32x4){0.f, 0.f, 0.f, 0.f};
#pragma unroll
                for (int ks = 0; ks < KS; ++ks) acc = __builtin_amdgcn_mfma_f32_16x16x32_bf16(wf[2 * np + hh][ks], lf[ks], acc, 0, 0, 0);
                v[hh] = acc + bv[2 * np + hh];
                if (sig) {
#pragma unroll
                    for (int q = 0; q < 4; ++q) v[hh][q] = sc * __builtin_amdgcn_rcpf(1.f + __builtin_amdgcn_exp2f(-1.4426950408889634f * v[hh][q])); }
            }
            pg8::u32x4 o; o.x = pg8::cvt_pk_bf16(v[0][0], v[0][1]); o.y = pg8::cvt_pk_bf16(v[0][2], v[0][3]); o.z = pg8::cvt_pk_bf16(v[1][0], v[1][1]); o.w = pg8::cvt_pk_bf16(v[1][2], v[1][3]);
            *(pg8::u32x4*)(outp + (size_t)(t0 + 16 * mt + fr) * RW + 96 * wid + 16 * NT0 + 32 * np + 8 * fq) = o;
        }
    }
}
PH void ph_oddprep(LAS unsigned char* lsm, const bf16_t* px, const OddW& w, const bf16_t* w2t, const bf16_t* a2t, const bf16_t* g2t, const ScanIn& si) {
    LAS unsigned char* Lt = lsm + STAGE_OFF;
    const int tid = TID(), lane = tid & 63, wid = __builtin_amdgcn_readfirstlane(tid >> 6), fr = lane & 15, fq = lane >> 4;
    for (int unit = BID(); unit < NT / OP_TOK; unit += GDIM()) {
        const int t0 = unit * OP_TOK;
        __syncthreads();
        const int tbase = t0 + wid * (OP_TOK / 8);
#pragma unroll 1
        for (int it = 0; it < 6; ++it) {
            const int idx = it * 64 + lane; const bool act = idx < 340; const int col0 = (act ? idx : 339) * 8;
            const float4 m0a = *(const float4*)(w.mu + col0), m0b = *(const float4*)(w.mu + col0 + 4), m1a = *(const float4*)(w.mu + 2720 + col0), m1b = *(const float4*)(w.mu + 2720 + col0 + 4);
            const float mu0[8] = {m0a.x, m0a.y, m0a.z, m0a.w, m0b.x, m0b.y, m0b.z, m0b.w}, mu1[8] = {m1a.x, m1a.y, m1a.z, m1a.w, m1b.x, m1b.y, m1b.z, m1b.w};
#pragma unroll 1
            for (int hf = 0; hf < 2; ++hf) {
            pg8::u32x4 rw[OP_TOK / 16 + 2];
#pragma unroll
            for (int j = 0; j < OP_TOK / 16 + 2; ++j) { int rr = tbase + hf * (OP_TOK / 16) - 1 + j; rr = rr < 0 ? 0 : (rr > NT - 1 ? NT - 1 : rr); rw[j] = *(const pg8::u32x4*)(px + (size_t)rr * 3072 + col0); }
#pragma unroll
            for (int tl = 0; tl < OP_TOK / 16; ++tl) {
                const int tloc = wid * (OP_TOK / 8) + hf * (OP_TOK / 16) + tl, r = t0 + tloc; int s0, len, t; seq_info(r, s0, len, t);
                const float fpv = t > 0 ? 1.f : 0.f, fnx = t < len - 1 ? 1.f : 0.f;
                float u[8], pv[8], nx[8], f[8];
                unpack8(rw[tl + 1], u); unpack8(rw[tl], pv); unpack8(rw[tl + 2], nx);
#pragma unroll
                for (int q = 0; q < 8; ++q) f[q] = u[q] + mu0[q] * (pv[q] * fpv - u[q]) + mu1[q] * (nx[q] * fnx - u[q]);
                if (col0 < 768) { *(pg8::u32x4*)(si.R + (size_t)r * RW + col0) = pack8(f); }
                else if (col0 < 1536) { const int c = col0 - 768;
                    *(pg8::u32x4*)(si.K + (size_t)r * RW + c) = pack8(f); }
                else if (col0 < 2304) { *(pg8::u32x4*)(si.V + (size_t)r * RW + col0 - 1536) = pack8(f); }
                else if (act) { const int jj = col0 - 2304;
                    if (jj < 128) { for (int q = 0; q < 8; ++q) f[q] = 1.f - 2.f * __builtin_amdgcn_rcpf(1.f + __builtin_amdgcn_exp2f(2.8853900817779268f * f[q])); }
                    else if (jj >= 256) { for (int q = 0; q < 8; ++q) f[q] = __builtin_amdgcn_rcpf(1.f + __builtin_amdgcn_exp2f(-1.4426950408889634f * f[q])); }
                    *(LAS pg8::u32x4*)(Lt + tloc * OP_LP + jj * 2) = pack8(f); }
            }
            }
        }
        __syncthreads();
        SUBSTAMP_L(lsm, 27);
        oddprep_seg<2, 0, 6>(Lt, w2t, 64, 0, w.w0, 0.6065306597126334f, true, si.X[0], t0, wid, fr, fq);
        oddprep_seg<2, 0, 6>(Lt, w2t + (size_t)768 * 64, 64, 64, w.w0 + 768, 0.6065306597126334f, true, si.X[1], t0, wid, fr, fq);
        oddprep_seg<2, 0, 6>(Lt, a2t, 64, 128, w.a0, 1.f, true, si.A[0], t0, wid, fr, fq);
        oddprep_seg<2, 0, 6>(Lt, a2t + (size_t)768 * 64, 64, 192, w.a0 + 768, 1.f, true, si.A[1], t0, wid, fr, fq);
        oddprep_seg<5, 0, 2>(Lt, g2t, 160, 256, nullptr, 1.f, false, si.G, t0, wid, fr, fq);
        oddprep_seg<5, 2, 2>(Lt, g2t, 160, 256, nullptr, 1.f, false, si.G, t0, wid, fr, fq);
        oddprep_seg<5, 4, 2>(Lt, g2t, 160, 256, nullptr, 1.f, false, si.G, t0, wid, fr, fq);
    }
    __syncthreads();
}
PH float quad_sum(float v) {
    v += __builtin_bit_cast(float, __builtin_amdgcn_update_dpp(0, __builtin_bit_cast(int, v), 0xB1, 0xF, 0xF, true));
    v += __builtin_bit_cast(float, __builtin_amdgcn_update_dpp(0, __builtin_bit_cast(int, v), 0x4E, 0xF, 0xF, true));
    return v;
}

constexpr int RS_WAVES = NB * 12 * 2 * 2, RS_BLOCKS = RS_WAVES / 4;
PH void ph_scan_rs(LAS unsigned char* lsm, const ScanIn& si, const float* k_a) {
    const int tid = TID(), lane = tid & 63, wib = tid >> 6, gw = BID() * 4 + wib;
    if (wib >= 4 || gw >= RS_WAVES) return;
    LAS float* sh = (LAS float*)(lsm + STAGE_OFF + wib * 12288);
    const int chain = gw >> 1, hw = gw & 1, dir = chain & 1, bh = chain >> 1, b = bh / 12, hh = bh % 12, cb = lane & 3, r = lane >> 2, row0 = 32 * hw + r;
    const int sl = lane >> 4, cq = lane & 15;
    const bf16_t* Xd = si.X[dir]; const bf16_t* Ad = si.A[dir]; float* Y = si.Y[dir];
    const pg8::f32x4 ka4 = *(const pg8::f32x4*)(k_a + hh * 64 + 4 * cq);
    const int N = CTX + SEQ, NG = N / 4;
    auto tok_of = [&](int s) { int tk; if (s < CTX) { const int tt = dir ? CTX - 1 - s : s; tk = NX + b * CTX + tt; } else { int tt = s - CTX; tt = dir ? SEQ - 1 - tt : tt; tk = b * SEQ + tt; } return tk; };
    struct Raw { pg8::u32x2 x, a, k, kk, r, v; };
    auto gload = [&](int g, Raw& q) { g = g < NG ? g : NG - 1; const size_t off = (size_t)tok_of(4 * g + sl) * RW + hh * 64 + 4 * cq;
        q.x = *(const pg8::u32x2*)(Xd + off); q.a = *(const pg8::u32x2*)(Ad + off); q.k = *(const pg8::u32x2*)(si.K + off);
        q.kk = *(const pg8::u32x2*)(si.KK + off); q.r = *(const pg8::u32x2*)(si.R + off); q.v = *(const pg8::u32x2*)(si.V + off); };
    auto stage = [&](int gp, const Raw& q) { LAS float* d = sh + (gp * 4 + sl) * 384 + 4 * cq;
        const pg8::f32x4 x = (pg8::f32x4){bflo(q.x.x), bfhi(q.x.x), bflo(q.x.y), bfhi(q.x.y)}, a = (pg8::f32x4){bflo(q.a.x), bfhi(q.a.x), bflo(q.a.y), bfhi(q.a.y)};
        const pg8::f32x4 k = (pg8::f32x4){bflo(q.k.x), bfhi(q.k.x), bflo(q.k.y), bfhi(q.k.y)}, kk = (pg8::f32x4){bflo(q.kk.x), bfhi(q.kk.x), bflo(q.kk.y), bfhi(q.kk.y)};
        pg8::f32x4 w;
#pragma unroll
        for (int i = 0; i < 4; ++i) w[i] = __builtin_amdgcn_exp2f(-x[i] * 1.4426950408889634f);
        *(LAS pg8::f32x4*)(d) = w; *(LAS pg8::f32x4*)(d + 64) = k * ((a - 1.f) * ka4 + 1.f); *(LAS pg8::f32x4*)(d + 128) = kk * a; *(LAS pg8::f32x4*)(d + 192) = kk;
        *(LAS pg8::f32x4*)(d + 256) = (pg8::f32x4){bflo(q.r.x), bfhi(q.r.x), bflo(q.r.y), bfhi(q.r.y)}; *(LAS pg8::f32x4*)(d + 320) = (pg8::f32x4){bflo(q.v.x), bfhi(q.v.x), bflo(q.v.y), bfhi(q.v.y)}; };
    typedef float f32x2 __attribute__((ext_vector_type(2)));
    f32x2 Sa[8], Sb[8];
#pragma unroll
    for (int c = 0; c < 8; ++c) { Sa[c] = (f32x2){0.f, 0.f}; Sb[c] = (f32x2){0.f, 0.f}; }
    f32x2 kq[8]; float va, vb;
    auto pre_kk = [&](int rec) { const LAS float* d = sh + rec * 384;
#pragma unroll
        for (int c4 = 0; c4 < 4; ++c4) { const pg8::f32x4 t = *(const LAS pg8::f32x4*)(d + 192 + 16 * cb + 4 * c4); kq[2 * c4] = (f32x2){t[0], t[1]}; kq[2 * c4 + 1] = (f32x2){t[2], t[3]}; }
        va = d[320 + row0]; vb = d[320 + row0 + 16]; };
    auto step = [&](int s, int rec, int nrec) {
        const LAS float* d = sh + rec * 384 + 16 * cb;
        f32x2 wv[8], kd[8], bb[8], rr[8];
#pragma unroll
        for (int c4 = 0; c4 < 4; ++c4) {
            const pg8::f32x4 t0 = *(const LAS pg8::f32x4*)(d + 4 * c4), t1 = *(const LAS pg8::f32x4*)(d + 64 + 4 * c4), t2 = *(const LAS pg8::f32x4*)(d + 128 + 4 * c4), t4 = *(const LAS pg8::f32x4*)(d + 256 + 4 * c4);
            wv[2 * c4] = (f32x2){t0[0], t0[1]}; wv[2 * c4 + 1] = (f32x2){t0[2], t0[3]}; kd[2 * c4] = (f32x2){t1[0], t1[1]}; kd[2 * c4 + 1] = (f32x2){t1[2], t1[3]};
            bb[2 * c4] = (f32x2){t2[0], t2[1]}; bb[2 * c4 + 1] = (f32x2){t2[2], t2[3]}; rr[2 * c4] = (f32x2){t4[0], t4[1]}; rr[2 * c4 + 1] = (f32x2){t4[2], t4[3]};
        }
        f32x2 pa = (f32x2){0.f, 0.f}, pb = (f32x2){0.f, 0.f}, qa = (f32x2){0.f, 0.f}, qb = (f32x2){0.f, 0.f};
#pragma unroll
        for (int c = 0; c < 8; c += 2) { pa = __builtin_elementwise_fma(Sa[c], kq[c], pa); qa = __builtin_elementwise_fma(Sa[c + 1], kq[c + 1], qa);
                                         pb = __builtin_elementwise_fma(Sb[c], kq[c], pb); qb = __builtin_elementwise_fma(Sb[c + 1], kq[c + 1], qb); }
        const f32x2 sas = pa + qa, sbs = pb + qb;
        const float nsa = -quad_sum(sas.x + sas.y), nsb = -quad_sum(sbs.x + sbs.y);
        const f32x2 nsa2 = (f32x2){nsa, nsa}, nsb2 = (f32x2){nsb, nsb}, va2 = (f32x2){va, va}, vb2 = (f32x2){vb, vb};
        pre_kk(nrec);
        f32x2 ya = (f32x2){0.f, 0.f}, yb = (f32x2){0.f, 0.f};
#pragma unroll
        for (int c = 0; c < 8; ++c) {
            Sa[c] = __builtin_elementwise_fma(Sa[c], wv[c], __builtin_elementwise_fma(va2, kd[c], nsa2 * bb[c]));
            Sb[c] = __builtin_elementwise_fma(Sb[c], wv[c], __builtin_elementwise_fma(vb2, kd[c], nsb2 * bb[c]));
            ya = __builtin_elementwise_fma(Sa[c], rr[c], ya); yb = __builtin_elementwise_fma(Sb[c], rr[c], yb);
        }
        const float y_a = quad_sum(ya.x + ya.y), y_b = quad_sum(yb.x + yb.y);
        if (cb < 2) Y[(size_t)tok_of(s) * RW + hh * 64 + row0 + 16 * cb] = cb ? y_b : y_a;
    };
    Raw ra, rb;
    gload(0, ra); stage(0, ra); gload(1, ra); gload(2, rb);
    __builtin_amdgcn_wave_barrier();
    pre_kk(0);
#pragma unroll 1
    for (int g = 0; g < NG; g += 2) {
        __builtin_amdgcn_wave_barrier();
        stage(1, ra); gload(g + 3, ra);
        __builtin_amdgcn_wave_barrier();
        step(4 * g, 0, 1); step(4 * g + 1, 1, 2); step(4 * g + 2, 2, 3); step(4 * g + 3, 3, 4);
        __builtin_amdgcn_wave_barrier();
        stage(0, rb); gload(g + 4, rb);
        __builtin_amdgcn_wave_barrier();
        step(4 * g + 4, 4, 5); step(4 * g + 5, 5, 6); step(4 * g + 6, 6, 7); step(4 * g + 7, 7, 0);
    }
}

constexpr int MM_WAVES = NB * 12 * 2 * 4, MM_BLOCKS = MM_WAVES / NWAVE;
constexpr int MM_P64 = 144, MM_P16 = 40;
constexpr int MM_KH = 0, MM_RH = 2304, MM_KB = 4608, MM_BB = 6912, MM_S16 = 9216, MM_V = 11520, MM_T = 12160, MM_AKK = 12800, MM_AKR = 13440, MM_ABR = 14080, MM_ABK = 14720, MM_GL = 15744, MM_WAVE = 16384;
static_assert(MM_ABK + 1024 <= MM_GL && MM_GL + 256 <= MM_WAVE, "chunk-scan LDS map");
PH pg8::bf16x8 frag4(s16x4 v) { const s16x4 z = (s16x4){0, 0, 0, 0}; return __builtin_shufflevector(v, z, 0, 1, 2, 3, 4, 5, 6, 7); }
PH int wave_dequeue(unsigned* ctr) {
    int t = 0;
    if ((TID() & 63) == 0) t = (int)__hip_atomic_fetch_add(ctr, 1u, __ATOMIC_RELAXED, __HIP_MEMORY_SCOPE_AGENT);
    return __builtin_amdgcn_readfirstlane(t);
}
constexpr int CR_KH = 0, CR_RH = 2048, CR_KB = 4096, CR_BB = 6144, CR_T = 8192, CR_AKK = 8704, CR_AKR = 9216, CR_ABR = 9728, CR_V = 10240, CR_GL = 12288, CR_BYTES = 12544;
constexpr int NCHUNK = (CTX + SEQ) / 16, NCHAINS = NB * 12 * 2;
constexpr int MM_VQ = 11520;
PH void scan_prep_task(LAS unsigned char* L, const ScanIn& si, const float* k_a, const float* k_k, unsigned char* rec, int chain, int c) {
    const int lane = TID() & 63, fr = lane & 15, fq = lane >> 4, sl = fq, cq = fr, trq = fr >> 2, trp = fr & 3;
    const int dir = chain & 1, bh = chain >> 1, b = bh / 12, hh = bh % 12;
    const bf16_t* Xd = si.X[dir]; const bf16_t* Ad = si.A[dir];
    const pg8::f32x4 ka4 = *(const pg8::f32x4*)(k_a + hh * 64 + 4 * cq), kk4 = *(const pg8::f32x4*)(k_k + hh * 64 + 4 * cq);
    auto tok_of = [&](int s) { int tk; if (s < CTX) { const int tt = dir ? CTX - 1 - s : s; tk = NX + b * CTX + tt; } else { int tt = s - CTX; tt = dir ? SEQ - 1 - tt : tt; tk = b * SEQ + tt; } return tk; };
    auto up4 = [](pg8::u32x2 w) { return (pg8::f32x4){bflo(w.x), bfhi(w.x), bflo(w.y), bfhi(w.y)}; };
    auto pk4 = [](pg8::f32x4 v) { pg8::u32x2 o; o.x = pg8::cvt_pk_bf16(v[0], v[1]); o.y = pg8::cvt_pk_bf16(v[2], v[3]); return o; };
    pg8::u32x2 rx[4], ra[4], rk[4], rr[4];
#pragma unroll
    for (int g4 = 0; g4 < 4; ++g4) { const size_t off = (size_t)tok_of(16 * c + 4 * g4 + sl) * RW + hh * 64 + 4 * cq;
        rx[g4] = *(const pg8::u32x2*)(Xd + off); ra[g4] = *(const pg8::u32x2*)(Ad + off); rk[g4] = *(const pg8::u32x2*)(si.K + off); rr[g4] = *(const pg8::u32x2*)(si.R + off); }
    pg8::f32x4 base = (pg8::f32x4){0.f, 0.f, 0.f, 0.f};
    __builtin_amdgcn_wave_barrier();
#pragma unroll
    for (int g4 = 0; g4 < 4; ++g4) {
        const pg8::f32x4 x = up4(rx[g4]), a = up4(ra[g4]), k = up4(rk[g4]), r = up4(rr[g4]);
        pg8::f32x4 kk = k * kk4;
        { float ss = kk[0] * kk[0] + kk[1] * kk[1] + kk[2] * kk[2] + kk[3] * kk[3];
          ss += __shfl_xor(ss, 1); ss += __shfl_xor(ss, 2); ss += __shfl_xor(ss, 4); ss += __shfl_xor(ss, 8);
          kk = kk * (1.f / fmaxf(sqrtf(ss), 1e-12f)); }
        pg8::f32x4 inc = x;
#pragma unroll
        for (int e = 0; e < 4; ++e) { const float y1 = __shfl_up(inc[e], 16); inc[e] += sl >= 1 ? y1 : 0.f; }
#pragma unroll
        for (int e = 0; e < 4; ++e) { const float y2 = __shfl_up(inc[e], 32); inc[e] += sl >= 2 ? y2 : 0.f; }
        const pg8::f32x4 cx = base + inc, cxm = cx - x;
#pragma unroll
        for (int e = 0; e < 4; ++e) base[e] += __shfl(inc[e], 48 + cq);
        pg8::f32x4 g, gm, gi;
#pragma unroll
        for (int e = 0; e < 4; ++e) { g[e] = __builtin_amdgcn_exp2f(-1.4426950408889634f * cx[e]); gm[e] = __builtin_amdgcn_exp2f(-1.4426950408889634f * cxm[e]); gi[e] = __builtin_amdgcn_exp2f(1.4426950408889634f * cx[e]); }
        const pg8::f32x4 kd = k * ((a - 1.f) * ka4 + 1.f), bb = kk * a;
        const int t = 4 * g4 + sl;
        const pg8::u32x2 okh = pk4(kk * gm), orh = pk4(r * g);
        *(LAS pg8::u32x2*)(L + MM_KH + t * MM_P64 + 8 * cq) = okh; *(LAS pg8::u32x2*)(L + MM_RH + t * MM_P64 + 8 * cq) = orh;
        *(pg8::u32x2*)(rec + CR_KH + t * 128 + 8 * cq) = okh; *(pg8::u32x2*)(rec + CR_RH + t * 128 + 8 * cq) = orh;
        *(LAS pg8::u32x2*)(L + MM_KB + t * MM_P64 + 8 * cq) = pk4(kd * gi);
        *(LAS pg8::u32x2*)(L + MM_BB + t * MM_P64 + 8 * cq) = pk4(bb * gi);
        if (g4 == 3 && sl == 3) *(pg8::f32x4*)(rec + CR_GL + 16 * cq) = g;
    }
    __builtin_amdgcn_wave_barrier();
    pg8::bf16x8 khf[2], rhf[2], kbf[2], bbf[2];
#pragma unroll
    for (int ks = 0; ks < 2; ++ks) { const int o = fr * MM_P64 + (8 * fq + 32 * ks) * 2;
        khf[ks] = *(const LAS pg8::bf16x8*)(L + MM_KH + o); rhf[ks] = *(const LAS pg8::bf16x8*)(L + MM_RH + o); kbf[ks] = *(const LAS pg8::bf16x8*)(L + MM_KB + o); bbf[ks] = *(const LAS pg8::bf16x8*)(L + MM_BB + o); }
#pragma unroll
    for (int nt = 0; nt < 4; ++nt) {
        *(s16x4*)(rec + CR_KB + nt * 512 + lane * 8) = __builtin_amdgcn_ds_read_tr16_b64_v4i16((LAS s16x4*)(L + MM_KB + (4 * fq + trq) * MM_P64 + (16 * nt + 4 * trp) * 2));
        *(s16x4*)(rec + CR_BB + nt * 512 + lane * 8) = __builtin_amdgcn_ds_read_tr16_b64_v4i16((LAS s16x4*)(L + MM_BB + (4 * fq + trq) * MM_P64 + (16 * nt + 4 * trp) * 2));
    }
    const pg8::f32x4 z4 = (pg8::f32x4){0.f, 0.f, 0.f, 0.f};
    pg8::f32x4 gkk = z4, gbk = z4, gkr = z4, gbr = z4;
#pragma unroll
    for (int ks = 0; ks < 2; ++ks) { gkk = __builtin_amdgcn_mfma_f32_16x16x32_bf16(khf[ks], kbf[ks], gkk, 0, 0, 0); gbk = __builtin_amdgcn_mfma_f32_16x16x32_bf16(khf[ks], bbf[ks], gbk, 0, 0, 0);
                                     gkr = __builtin_amdgcn_mfma_f32_16x16x32_bf16(rhf[ks], kbf[ks], gkr, 0, 0, 0); gbr = __builtin_amdgcn_mfma_f32_16x16x32_bf16(rhf[ks], bbf[ks], gbr, 0, 0, 0); }
    __builtin_amdgcn_wave_barrier();
#pragma unroll
    for (int rg = 0; rg < 4; ++rg) { const int t = 4 * fq + rg; const bool lo = fr < t, le = fr <= t;
        *(LAS float*)(L + MM_ABK + t * 64 + fr * 4) = lo ? gbk[rg] : 0.f;
        *(LAS unsigned short*)(L + MM_AKK + t * MM_P16 + fr * 2) = f2bf(lo ? gkk[rg] : 0.f);
        *(LAS unsigned short*)(L + MM_AKR + t * MM_P16 + fr * 2) = f2bf(le ? gkr[rg] : 0.f);
        *(LAS unsigned short*)(L + MM_ABR + t * MM_P16 + fr * 2) = f2bf(le ? gbr[rg] : 0.f); }
    __builtin_amdgcn_wave_barrier();
    float Tr[16];
#pragma unroll
    for (int t = 0; t < 16; ++t) {
        float acc = (t == fr) ? 1.f : 0.f;
#pragma unroll
        for (int s4 = 0; s4 < (t + 3) / 4; ++s4) { const pg8::f32x4 ar = *(const LAS pg8::f32x4*)(L + MM_ABK + t * 64 + s4 * 16);
#pragma unroll
            for (int e = 0; e < 4; ++e) if (4 * s4 + e < t) acc -= ar[e] * Tr[4 * s4 + e]; }
        Tr[t] = acc;
    }
#pragma unroll
    for (int rg = 0; rg < 4; ++rg) { const float tv = fq == 0 ? Tr[rg] : fq == 1 ? Tr[4 + rg] : fq == 2 ? Tr[8 + rg] : Tr[12 + rg];
        *(LAS unsigned short*)(L + MM_T + (4 * fq + rg) * MM_P16 + fr * 2) = f2bf(tv); }
    __builtin_amdgcn_wave_barrier();
    *(s16x4*)(rec + CR_T + lane * 8) = *(const LAS s16x4*)(L + MM_T + fr * MM_P16 + 8 * fq);
    *(s16x4*)(rec + CR_AKK + lane * 8) = *(const LAS s16x4*)(L + MM_AKK + fr * MM_P16 + 8 * fq);
    *(s16x4*)(rec + CR_AKR + lane * 8) = *(const LAS s16x4*)(L + MM_AKR + fr * MM_P16 + 8 * fq);
    *(s16x4*)(rec + CR_ABR + lane * 8) = *(const LAS s16x4*)(L + MM_ABR + fr * MM_P16 + 8 * fq);
    __builtin_amdgcn_wave_barrier();
}
PH void ph_scan_prep(LAS unsigned char* lsm, const ScanIn& si, const float* k_a, const float* k_k, unsigned char* recs, unsigned* ctr) {
    LAS unsigned char* L = lsm + STAGE_OFF + (TID() >> 6) * MM_WAVE;
    constexpr int BATCH = 8;
    for (;;) {
        const int t0 = wave_dequeue(ctr) * BATCH;
        if (t0 >= NCHAINS * NCHUNK) break;
#pragma unroll 1
        for (int t = t0; t < t0 + BATCH; ++t) { const int chain = t / NCHUNK, c = t % NCHUNK; scan_prep_task(L, si, k_a, k_k, recs + (size_t)t * CR_BYTES, chain, c); }
    }
}
PH void ph_scan_seq(LAS unsigned char* lsm, const unsigned char* recs, float* const* Yd, const bf16_t* Vg) {
    const int tid = TID(), lane = tid & 63, wib = tid >> 6, gw = BID() * 3 + wib, chain = gw >> 1, q0 = (gw & 1) * 2;
    if (wib >= 3 || gw >= NCHAINS * 2) return;
    LAS unsigned char* S16 = lsm + STAGE_OFF + wib * (2 * 2304);
    LAS unsigned char* VQ = lsm + STAGE_OFF + 3 * (2 * 2304) + wib * 1280;
    const int dir = chain & 1, bh = chain >> 1, b = bh / 12, hh = bh % 12, fr = lane & 15, fq = lane >> 4, trq = fr >> 2, trp = fr & 3;
    float* Y = Yd[dir];
    auto tok_of = [&](int s) { int tk; if (s < CTX) { const int tt = dir ? CTX - 1 - s : s; tk = NX + b * CTX + tt; } else { int tt = s - CTX; tt = dir ? SEQ - 1 - tt : tt; tk = b * SEQ + tt; } return tk; };
    struct Ops { pg8::bf16x8 kh[2], rh[2]; s16x4 kb[4], bb[4], tf, akk, akr, abr; pg8::u32x2 vraw[2]; float gl[4]; };
    auto oload = [&](int c, Ops& o) { c = c < NCHUNK ? c : NCHUNK - 1; const unsigned char* rec = recs + ((size_t)chain * NCHUNK + c) * CR_BYTES;
#pragma unroll
        for (int ks = 0; ks < 2; ++ks) { o.kh[ks] = *(const pg8::bf16x8*)(rec + CR_KH + fr * 128 + (8 * fq + 32 * ks) * 2); o.rh[ks] = *(const pg8::bf16x8*)(rec + CR_RH + fr * 128 + (8 * fq + 32 * ks) * 2); }
#pragma unroll
        for (int nt = 0; nt < 4; ++nt) { o.kb[nt] = *(const s16x4*)(rec + CR_KB + nt * 512 + lane * 8); o.bb[nt] = *(const s16x4*)(rec + CR_BB + nt * 512 + lane * 8); o.gl[nt] = *(const float*)(rec + CR_GL + (16 * nt + fr) * 4);
            if (nt < 2) o.vraw[nt] = *(const pg8::u32x2*)(Vg + (size_t)tok_of(16 * c + (lane >> 2)) * RW + hh * 64 + 16 * (q0 + nt) + 4 * (lane & 3)); }
        o.tf = *(const s16x4*)(rec + CR_T + lane * 8); o.akk = *(const s16x4*)(rec + CR_AKK + lane * 8); o.akr = *(const s16x4*)(rec + CR_AKR + lane * 8); o.abr = *(const s16x4*)(rec + CR_ABR + lane * 8); };
    pg8::f32x4 Sacc[2][4];
#pragma unroll
    for (int q = 0; q < 2; ++q)
#pragma unroll
        for (int nt = 0; nt < 4; ++nt) Sacc[q][nt] = (pg8::f32x4){0.f, 0.f, 0.f, 0.f};
    const pg8::f32x4 z4 = (pg8::f32x4){0.f, 0.f, 0.f, 0.f};
    auto chunk = [&](int c, const Ops& cur) {
        __builtin_amdgcn_wave_barrier();
#pragma unroll
        for (int q = 0; q < 2; ++q)
#pragma unroll
            for (int nt = 0; nt < 4; ++nt)
#pragma unroll
                for (int rg = 0; rg < 4; rg += 2) { const unsigned pk = pg8::cvt_pk_bf16(Sacc[q][nt][rg], Sacc[q][nt][rg + 1]);
                    *(LAS unsigned short*)(S16 + q * 2304 + (4 * fq + rg) * MM_P64 + (16 * nt + fr) * 2) = (unsigned short)pk;
                    *(LAS unsigned short*)(S16 + q * 2304 + (4 * fq + rg + 1) * MM_P64 + (16 * nt + fr) * 2) = (unsigned short)(pk >> 16); }
#pragma unroll
        for (int q = 0; q < 2; ++q) *(LAS pg8::u32x2*)(VQ + q * 640 + (lane >> 2) * MM_P16 + 8 * (lane & 3)) = cur.vraw[q];
        __builtin_amdgcn_wave_barrier();
        const pg8::bf16x8 akkf = frag4(cur.akk), akrf = frag4(cur.akr), abrf = frag4(cur.abr), tff = frag4(cur.tf);
#pragma unroll
        for (int q = 0; q < 2; ++q) {
            pg8::bf16x8 s16f[2];
#pragma unroll
            for (int ks = 0; ks < 2; ++ks) s16f[ks] = *(const LAS pg8::bf16x8*)(S16 + q * 2304 + fr * MM_P64 + (8 * fq + 32 * ks) * 2);
            const pg8::bf16x8 vfr = frag4(__builtin_amdgcn_ds_read_tr16_b64_v4i16((LAS s16x4*)(VQ + q * 640 + (4 * fq + trq) * MM_P16 + 8 * trp)));
            pg8::f32x4 Wm = z4, Ym = z4;
#pragma unroll
            for (int ks = 0; ks < 2; ++ks) { Wm = __builtin_amdgcn_mfma_f32_16x16x32_bf16(cur.kh[ks], s16f[ks], Wm, 0, 0, 0); Ym = __builtin_amdgcn_mfma_f32_16x16x32_bf16(cur.rh[ks], s16f[ks], Ym, 0, 0, 0); }
            Wm = __builtin_amdgcn_mfma_f32_16x16x32_bf16(akkf, vfr, Wm, 0, 0, 0);
            Ym = __builtin_amdgcn_mfma_f32_16x16x32_bf16(akrf, vfr, Ym, 0, 0, 0);
            pg8::u32x4 wp; wp.x = pg8::cvt_pk_bf16(Wm[0], Wm[1]); wp.y = pg8::cvt_pk_bf16(Wm[2], Wm[3]); wp.z = 0u; wp.w = 0u;
            const pg8::f32x4 Um = __builtin_amdgcn_mfma_f32_16x16x32_bf16(tff, __builtin_bit_cast(pg8::bf16x8, wp), z4, 0, 0, 0);
            pg8::u32x4 up; up.x = pg8::cvt_pk_bf16(-Um[0], -Um[1]); up.y = pg8::cvt_pk_bf16(-Um[2], -Um[3]); up.z = 0u; up.w = 0u;
            const pg8::bf16x8 nuf = __builtin_bit_cast(pg8::bf16x8, up);
            Ym = __builtin_amdgcn_mfma_f32_16x16x32_bf16(abrf, nuf, Ym, 0, 0, 0);
#pragma unroll
            for (int rg = 0; rg < 4; ++rg) ((bf16_t*)Y)[(size_t)tok_of(16 * c + 4 * fq + rg) * RW + hh * 64 + 16 * (q0 + q) + fr] = f2bf(Ym[rg]);
#pragma unroll
            for (int nt = 0; nt < 4; ++nt) {
                Sacc[q][nt] = __builtin_amdgcn_mfma_f32_16x16x32_bf16(vfr, frag4(cur.kb[nt]), Sacc[q][nt], 0, 0, 0);
                Sacc[q][nt] = __builtin_amdgcn_mfma_f32_16x16x32_bf16(nuf, frag4(cur.bb[nt]), Sacc[q][nt], 0, 0, 0);
                Sacc[q][nt] = Sacc[q][nt] * cur.gl[nt];
            }
        }
    };
    Ops oa, ob;
    oload(0, oa);
#pragma unroll 1
    for (int c = 0; c < NCHUNK; c += 2) {
        oload(c + 1, ob); chunk(c, oa);
        oload(c + 2, oa); chunk(c + 1, ob);
    }
}
PH void ph_readout2(const ScanIn& si, const OddW& w, bf16_t* mix) {
    const int lane = TID() & 63, wave = (BID() * NTHR + TID()) >> 6, nw = GDIM() * NWAVE;
    for (int task = wave; task < NT / 2; task += nw) {
        pg8::u32x4 raw[3][8];
#pragma unroll
        for (int it = 0; it < 3; ++it) {
            const int idx = it * 64 + lane, r = task * 2 + idx / 96, c0 = (idx % 96) * 8;
            const size_t o = (size_t)r * RW + c0;
            raw[it][0] = *(const pg8::u32x4*)((const bf16_t*)si.Y[0] + o); raw[it][1] = *(const pg8::u32x4*)((const bf16_t*)si.Y[1] + o);
            raw[it][2] = *(const pg8::u32x4*)(si.K + o); raw[it][3] = *(const pg8::u32x4*)(si.A[0] + o); raw[it][4] = *(const pg8::u32x4*)(si.A[1] + o);
            raw[it][5] = *(const pg8::u32x4*)(si.R + o); raw[it][6] = *(const pg8::u32x4*)(si.V + o); raw[it][7] = *(const pg8::u32x4*)(si.G + o);
        }
#pragma unroll
        for (int it = 0; it < 3; ++it) {
            const int idx = it * 64 + lane, r = task * 2 + idx / 96, c0 = (idx % 96) * 8;
            float yf[8], yb8[8];
            unpack8(raw[it][0], yf); unpack8(raw[it][1], yb8);
            float y[8] = {yf[0] + yb8[0], yf[1] + yb8[1], yf[2] + yb8[2], yf[3] + yb8[3], yf[4] + yb8[4], yf[5] + yb8[5], yf[6] + yb8[6], yf[7] + yb8[7]};
            float kf[8], a0[8], a1[8], rf[8], vf[8], gf[8];
            unpack8(raw[it][2], kf); unpack8(raw[it][3], a0); unpack8(raw[it][4], a1);
            unpack8(raw[it][5], rf); unpack8(raw[it][6], vf); unpack8(raw[it][7], gf);
            float sm = 0.f;
#pragma unroll
            for (int q = 0; q < 8; ++q) sm += y[q];
            sm += __shfl_xor(sm, 1); sm += __shfl_xor(sm, 2); sm += __shfl_xor(sm, 4);
            const float mean = sm * (1.f / 64.f);
            float vs = 0.f;
#pragma unroll
            for (int q = 0; q < 8; ++q) { y[q] -= mean; vs += y[q] * y[q]; }
            vs += __shfl_xor(vs, 1); vs += __shfl_xor(vs, 2); vs += __shfl_xor(vs, 4);
            const float rstd = rsqrtf(vs * (1.f / 64.f) + 64e-5f);
            const float4 kaa = *(const float4*)(w.k_a + c0), kab = *(const float4*)(w.k_a + c0 + 4), rka = *(const float4*)(w.r_k + c0), rkb = *(const float4*)(w.r_k + c0 + 4);
            const float4 gga = *(const float4*)(w.gn_g + c0), ggb = *(const float4*)(w.gn_g + c0 + 4), gba = *(const float4*)(w.gn_b + c0), gbb = *(const float4*)(w.gn_b + c0 + 4);
            const float ka[8] = {kaa.x, kaa.y, kaa.z, kaa.w, kab.x, kab.y, kab.z, kab.w}, rk[8] = {rka.x, rka.y, rka.z, rka.w, rkb.x, rkb.y, rkb.z, rkb.w};
            const float gg[8] = {gga.x, gga.y, gga.z, gga.w, ggb.x, ggb.y, ggb.z, ggb.w}, gb[8] = {gba.x, gba.y, gba.z, gba.w, gbb.x, gbb.y, gbb.z, gbb.w};
            float cf = 0.f;
#pragma unroll
            for (int q = 0; q < 8; ++q) cf += rf[q] * (kf[q] * (2.f + (a0[q] + a1[q] - 2.f) * ka[q])) * rk[q];
            cf += __shfl_xor(cf, 1); cf += __shfl_xor(cf, 2); cf += __shfl_xor(cf, 4);
            float out[8];
#pragma unroll
            for (int q = 0; q < 8; ++q) out[q] = (y[q] * rstd * gg[q] + gb[q] + cf * vf[q]) * gf[q];
            *(pg8::u32x4*)(mix + (size_t)r * D + c0) = pack8(out);
        }
    }
}
PH void ph_convT(LAS unsigned char* L, const float* src, bf16_t* dst, int K, int N, int Npad, int nmat) {
    const int blk = BID(), nblk = GDIM();
    const int tid = TID(), wid = __builtin_amdgcn_readfirstlane(tid >> 6), lane = tid & 63, kt_n = K / 64, nt_n = Npad / 128, per = kt_n * nt_n; const int nunits = nmat * per;
    auto issue = [&](int u, int buf) {
        u = u < nunits ? u : nunits - 1;
        const int mat = u / per, rem = u % per, kt = rem / nt_n, ntl = rem % nt_n, k0 = kt * 64, n0 = ntl * 128;
        const float* sm = src + (size_t)mat * K * N + (size_t)k0 * N;
#pragma unroll
        for (int i = 0; i < 4; ++i) { const int q = wid * 4 + i, k = 2 * q + (lane >> 5); int nn = n0 + (((lane & 31) ^ (k >> 3)) << 2); nn = nn < N ? nn : N - 4;
            __builtin_amdgcn_global_load_lds((const unsigned*)(sm + (size_t)k * N + nn), (LAS unsigned*)(L + buf * 32768 + q * 1024), 16, 0, 0); } };
    __syncthreads();
    const int chunk = (nunits + nblk - 1) / nblk, ub = blk * chunk, ue = ub + chunk < nunits ? ub + chunk : nunits;
    issue(ub, 0); issue(ub + 1, 1); issue(ub + 2, 2);
    int buf = 0;
    for (int u = ub; u < ue; ++u) {
        const int mat = u / per, rem = u % per, kt = rem / nt_n, ntl = rem % nt_n, k0 = kt * 64, n0 = ntl * 128;
        bf16_t* dm = dst + (size_t)mat * Npad * K;
        asm volatile("s_waitcnt vmcnt(8)" ::: "memory");
        __builtin_amdgcn_s_barrier();
        asm volatile("" ::: "memory");
        const LAS float* T = (const LAS float*)(L + buf * 32768);
#pragma unroll
        for (int i = 0; i < 2; ++i) {
            const int idx = tid + NTHR * i, n = idx >> 3, l = idx & 7, k8 = l * 8;
            const LAS float* tp = T + k8 * 128 + ((((n >> 2) ^ l) << 2) | (n & 3));
            float f[8];
#pragma unroll
            for (int j = 0; j < 8; ++j) f[j] = tp[j * 128];
            if (n0 + n >= N) {
#pragma unroll
                for (int j = 0; j < 8; ++j) f[j] = 0.f; }
            *(pg8::u32x4*)(dm + (size_t)(n0 + n) * K + k0 + k8) = pack8(f);
        }
        asm volatile("s_waitcnt lgkmcnt(0)" ::: "memory");
        __builtin_amdgcn_s_barrier();
        asm volatile("" ::: "memory");
        issue(u + 3, buf);
        buf = buf == 2 ? 0 : buf + 1;
    }
    asm volatile("s_waitcnt vmcnt(0)" ::: "memory");
    __syncthreads();
}
PH void ph_to_bf16(const float* src, bf16_t* dst, size_t n8) {
    for (size_t i = (size_t)BID() * NTHR + TID(); i < n8; i += (size_t)GDIM() * NTHR) {
        const float4 a = ((const float4*)src)[2 * i], b = ((const float4*)src)[2 * i + 1];
        pg8::u32x4 w; w.x = pg8::cvt_pk_bf16(a.x, a.y); w.y = pg8::cvt_pk_bf16(a.z, a.w); w.z = pg8::cvt_pk_bf16(b.x, b.y); w.w = pg8::cvt_pk_bf16(b.z, b.w);
        ((pg8::u32x4*)dst)[i] = w;
    }
}
PH void ph_moe_init(const MoeBufs& m) {
    const int i = BID() * NTHR + TID();
    if (i < NEXP) m.cnt[i] = 0;
}
PH void ph_router(const float* fx, const float* rw, const float* rb, const MoeBufs& m, int nrows) {
    const int lane = TID() & 63, wave = (BID() * NTHR + TID()) >> 6, nw = GDIM() * NWAVE;
    const int e = lane & 31, half = lane >> 5;
    for (int r = wave; r < nrows; r += nw) {
        const float* xr = fx + (size_t)r * D;
        float acc = 0.f;
        for (int d = half; d < D; d += 2) acc += xr[d] * rw[d * NEXP + e];
        acc += __shfl_xor(acc, 32);
        float logit = acc + rb[e];
        float tv[4]; int ti[4];
#pragma unroll
        for (int k = 0; k < 4; ++k) {
            const float mx = wave_max(logit);
            const unsigned long long bal = __ballot(logit == mx);
            const int sel = (__ffsll((long long)bal) - 1) & 31;
            tv[k] = mx; ti[k] = sel;
            if (e == sel) logit = -INFINITY;
        }
        const float e1 = expf(tv[1] - tv[0]), e2 = expf(tv[2] - tv[0]), e3 = expf(tv[3] - tv[0]);
        const float inv = 1.f / (1.f + e1 + e2 + e3);
        if (lane < 4) {
            const float gk = lane == 0 ? inv : lane == 1 ? e1 * inv : lane == 2 ? e2 * inv : e3 * inv;
            const int ek = lane == 0 ? ti[0] : lane == 1 ? ti[1] : lane == 2 ? ti[2] : ti[3];
            const int pos = atomicAdd(&m.cnt[ek], 1);
            m.tok_e[r * 4 + lane] = ek; m.tok_pos[r * 4 + lane] = pos; m.tok_gate[r * 4 + lane] = gk;
        }
    }
}
PH void ph_router_prep(const float* rw, bf16_t* hi, bf16_t* lo) {
    for (int i = BID() * NTHR + TID(); i < 4 * 32 * 1024; i += GDIM() * NTHR) {
        const int l = i >> 15, e = (i >> 10) & 31, d = i & 1023;
        const float v = rw[((size_t)l * 1024 + d) * 32 + e]; const unsigned short hb = f2bf(v);
        hi[i] = hb; lo[i] = f2bf(v - bf2f(hb));
    }
}
PH void ph_router16(LAS unsigned char* lsm, const bf16_t* fx, const bf16_t* whi, const bf16_t* wlo, const float* rb, const MoeBufs& m, int nrows) {
    const int tid = TID(), lane = tid & 63, wib = tid >> 6, fr = lane & 15, fq = lane >> 4;
    LAS int* lc = (LAS int*)(lsm + STAGE_OFF);
    const int ntask = nrows / 16;
    for (int tb = BID() * NWAVE; tb < ntask; tb += GDIM() * NWAVE) {
        const int task = tb + wib; const bool act = task < ntask;
        const int t0 = (act ? task : 0) * 16;
        __syncthreads();
        if (tid < 32) lc[tid] = 0;
        pg8::f32x4 acc[2] = {(pg8::f32x4){0.f, 0.f, 0.f, 0.f}, (pg8::f32x4){0.f, 0.f, 0.f, 0.f}};
        const bf16_t* xp = fx + (size_t)(t0 + fr) * D + 8 * fq;
        const bf16_t* hp = whi + (size_t)fr * D + 8 * fq; const bf16_t* lp = wlo + (size_t)fr * D + 8 * fq;
#pragma unroll 16
        for (int ks = 0; ks < 32; ++ks) {
            const pg8::bf16x8 xf = *(const pg8::bf16x8*)(xp + 32 * ks);
#pragma unroll
            for (int nt = 0; nt < 2; ++nt) {
                const pg8::bf16x8 wh = *(const pg8::bf16x8*)(hp + (size_t)nt * 16 * D + 32 * ks), wl = *(const pg8::bf16x8*)(lp + (size_t)nt * 16 * D + 32 * ks);
                acc[nt] = __builtin_amdgcn_mfma_f32_16x16x32_bf16(wh, xf, acc[nt], 0, 0, 0);
                acc[nt] = __builtin_amdgcn_mfma_f32_16x16x32_bf16(wl, xf, acc[nt], 0, 0, 0);
            }
        }
        float lg[8];
#pragma unroll
        for (int nt = 0; nt < 2; ++nt) { const pg8::f32x4 bb = *(const pg8::f32x4*)(rb + 16 * nt + 4 * fq);
#pragma unroll
            for (int q = 0; q < 4; ++q) lg[nt * 4 + q] = acc[nt][q] + bb[q]; }
        float tv[4]; int ti[4];
#pragma unroll
        for (int k = 0; k < 4; ++k) {
            float bv = lg[0]; int bi = 4 * fq;
#pragma unroll
            for (int q = 1; q < 8; ++q) { const int e = 16 * (q >> 2) + 4 * fq + (q & 3); if (lg[q] > bv) { bv = lg[q]; bi = e; } }
#pragma unroll
            for (int o = 16; o <= 32; o <<= 1) { const float ov = __shfl_xor(bv, o); const int oi = __shfl_xor(bi, o); if (ov > bv || (ov == bv && oi < bi)) { bv = ov; bi = oi; } }
            tv[k] = bv; ti[k] = bi;
#pragma unroll
            for (int q = 0; q < 8; ++q) { const int e = 16 * (q >> 2) + 4 * fq + (q & 3); if (e == bi) lg[q] = -INFINITY; }
        }
        const float e1 = __expf(tv[1] - tv[0]), e2 = __expf(tv[2] - tv[0]), e3 = __expf(tv[3] - tv[0]);
        const float inv = 1.f / (1.f + e1 + e2 + e3);
        const float gk = fq == 0 ? inv : fq == 1 ? e1 * inv : fq == 2 ? e2 * inv : e3 * inv;
        const int ek = fq == 0 ? ti[0] : fq == 1 ? ti[1] : fq == 2 ? ti[2] : ti[3];
        __syncthreads();
        int lpos = 0;
        if (act) lpos = __hip_atomic_fetch_add(lc + ek, 1, __ATOMIC_RELAXED, __HIP_MEMORY_SCOPE_WORKGROUP);
        __syncthreads();
        if (tid < 32) { const int n = lc[tid]; lc[32 + tid] = n ? atomicAdd(&m.cnt[tid], n) : 0; }
        __syncthreads();
        if (act) { const int r = t0 + fr, pos = lc[32 + ek] + lpos;
            m.tok_e[r * 4 + fq] = ek; m.tok_pos[r * 4 + fq] = pos; m.tok_gate[r * 4 + fq] = gk; }
    }
    __syncthreads();
}
PH void moe_offsets(int* ps, const MoeBufs& m) {
    __syncthreads();
    if (TID() < 64) { const int lane = TID(), e = lane & 31; int v = (m.cnt[e] + 255) / 256 * 256; if (lane >= 32) v = 0;
        int incl = v;
#pragma unroll
        for (int o = 1; o < 32; o <<= 1) { const int t = __shfl_up(incl, o); if (lane >= o) incl += t; }
        if (lane < 32) ps[lane] = incl - v;
        if (lane == 31) ps[NEXP] = incl; }
    __syncthreads();
}
PH int moe_tile_expert(const int* ps, int row) { int e = -1; for (int q = 0; q < NEXP; ++q) if (row >= ps[q] && row < ps[q + 1]) e = q; return e; }
PH void ph_moe_gather(int* ps, const bf16_t* a16, const MoeBufs& m, int nrows) {
    moe_offsets(ps, m);
    const int lane = TID() & 63, wave = (BID() * NTHR + TID()) >> 6, nw = GDIM() * NWAVE;
    for (int r = wave; r < nrows; r += nw) {
        const pg8::u32x4* src = (const pg8::u32x4*)(a16 + (size_t)r * D);
        const pg8::u32x4 v0 = src[lane], v1 = src[lane + 64];
#pragma unroll
        for (int k = 0; k < 4; ++k) {
            const int dest = ps[m.tok_e[r * 4 + k]] + m.tok_pos[r * 4 + k];
            pg8::u32x4* dp = (pg8::u32x4*)(m.Xp + (size_t)dest * D);
            dp[lane] = v0; dp[lane + 64] = v1;
        }
    }
}
PH float swiglu1(float glu, float lin) {
    glu = fminf(glu, 7.f); lin = fminf(fmaxf(lin, -7.f), 7.f);
    const float e = __builtin_amdgcn_exp2f(glu * (-1.702f * 1.4426950408889634f));
    return glu * __builtin_amdgcn_rcpf(1.f + e) * (lin + 1.f);
}
struct MoeOrder : pg8::TileOrder {
    const LAS int* ps;
    __device__ __forceinline__ bool next(int i, pg8::Unit& u) const {
        if (!tile(i, u.pm, u.pn)) return false;
        const int row = u.pm * 256, lane = TID() & 63;
        const int st = ps[lane & 31];
        const unsigned long long mk = __builtin_amdgcn_ballot_w64(lane < NEXP && row >= st);
        u.e = __builtin_popcountll(mk) - 1; return true;
    }
};
struct EpiSwiglu {
    static constexpr bool PERM = true;
    bf16_t* O; const float* bias;
    struct Pre { pg8::f32x4 bv[2][2]; };
    __device__ __forceinline__ Pre prefetch(const pg8::Unit& u, int wc, int fq) const { Pre p; const float* bp = bias + (size_t)u.e * 2048 + u.pn * 256 + wc * 32 + 8 * fq;
#pragma unroll
        for (int bj = 0; bj < 2; ++bj)
#pragma unroll
            for (int n = 0; n < 2; ++n) p.bv[bj][n] = *(const pg8::f32x4*)(bp + bj * 128 + 4 * n);
        return p; }
    __device__ __forceinline__ void operator()(const pg8::f32x4 (&acc)[2][2][4][2], const pg8::Unit& u, int wr, int wc, int fr, int fq, const Pre& pf) const {
        const int row0 = u.pm * 256 + wr * 64 + fr, col0 = u.pn * 256 + wc * 32 + 8 * fq;
        const float* bp = bias + (size_t)u.e * 2048 + col0;
        pg8::f32x4 bv[2][2];
#pragma unroll
        for (int bj = 0; bj < 2; ++bj)
#pragma unroll
            for (int n = 0; n < 2; ++n) bv[bj][n] = pf.bv[bj][n];
        const int odd = fq & 1, ocol = (u.pn * 256 + wc * 32 + 8 * (fq & ~1)) >> 1;
#pragma unroll
        for (int ai = 0; ai < 2; ++ai)
#pragma unroll
            for (int mp = 0; mp < 2; ++mp) {
                bf16_t* rowp = O + (size_t)(row0 + ai * 128 + (2 * mp + odd) * 16) * 1024 + ocol;
#pragma unroll
                for (int bj = 0; bj < 2; ++bj) {
                    pg8::u32x2 w[2];
#pragma unroll
                    for (int k = 0; k < 2; ++k) { const pg8::f32x4 v0 = acc[ai][bj][2 * mp + k][0] + bv[bj][0], v1 = acc[ai][bj][2 * mp + k][1] + bv[bj][1];
                        w[k].x = pg8::cvt_pk_bf16(swiglu1(v0[0], v0[1]), swiglu1(v0[2], v0[3])); w[k].y = pg8::cvt_pk_bf16(swiglu1(v1[0], v1[1]), swiglu1(v1[2], v1[3])); }
                    const pg8::u32x2 sx = __builtin_amdgcn_permlane16_swap(w[0].x, w[1].x, false, false), sy = __builtin_amdgcn_permlane16_swap(w[0].y, w[1].y, false, false);
                    pg8::u32x4 o; o.x = sx[0]; o.y = sy[0]; o.z = sx[1]; o.w = sy[1];
                    *(pg8::u32x4*)(rowp + bj * 64) = o;
                }
            }
    }
};
struct EpiBiasBf16 {
    static constexpr bool PERM = true;
    bf16_t* O; const float* bias;
    struct Pre { pg8::f32x4 bv[2][2]; };
    __device__ __forceinline__ Pre prefetch(const pg8::Unit& u, int wc, int fq) const { Pre p; const float* bp = bias + (size_t)u.e * 1024 + u.pn * 256 + wc * 32 + 8 * fq;
#pragma unroll
        for (int bj = 0; bj < 2; ++bj)
#pragma unroll
            for (int n = 0; n < 2; ++n) p.bv[bj][n] = *(const pg8::f32x4*)(bp + bj * 128 + 4 * n);
        return p; }
    __device__ __forceinline__ void operator()(const pg8::f32x4 (&acc)[2][2][4][2], const pg8::Unit& u, int wr, int wc, int fr, int fq, const Pre& pf) const {
        const int row0 = u.pm * 256 + wr * 64 + fr, col0 = u.pn * 256 + wc * 32 + 8 * fq;
        const float* bp = bias + (size_t)u.e * 1024 + col0;
        pg8::f32x4 bv[2][2];
#pragma unroll
        for (int bj = 0; bj < 2; ++bj)
#pragma unroll
            for (int n = 0; n < 2; ++n) bv[bj][n] = pf.bv[bj][n];
#pragma unroll
        for (int ai = 0; ai < 2; ++ai)
#pragma unroll
            for (int m = 0; m < 4; ++m) { bf16_t* rowp = O + (size_t)(row0 + ai * 128 + m * 16) * 1024 + col0;
#pragma unroll
                for (int bj = 0; bj < 2; ++bj) { const pg8::f32x4 v0 = acc[ai][bj][m][0] + bv[bj][0], v1 = acc[ai][bj][m][1] + bv[bj][1];
                    pg8::u32x4 w; w.x = pg8::cvt_pk_bf16(v0[0], v0[1]); w.y = pg8::cvt_pk_bf16(v0[2], v0[3]); w.z = pg8::cvt_pk_bf16(v1[0], v1[1]); w.w = pg8::cvt_pk_bf16(v1[2], v1[3]);
                    *(pg8::u32x4*)(rowp + bj * 128) = w; } }
    }
};
PH void ph_moe_gu16(LAS unsigned char* smem, const bf16_t* wgu16, const float* bgu, const MoeBufs& m) {
    int* ps = (int*)((unsigned char*)smem + MISC_OFF);
    moe_offsets(ps, m);
    MoeOrder S; S.init(ps[NEXP] / 256, 2048 / 256, GDIM(), BID()); S.ps = (const LAS int*)(smem + MISC_OFF);
    pg8::Gemm g; g.A = m.Xp; g.Bt = wgu16; g.M = ps[NEXP]; g.N = 2048; g.K = 1024; g.bgstride = (size_t)2048 * 1024 * 2;
    EpiSwiglu E; E.O = m.Hp; E.bias = bgu;
    pg8::gemm_phase(smem + STAGE_OFF, g, S, E);
}
PH void ph_moe_dn16(LAS unsigned char* smem, const bf16_t* wdn16, const float* bdn, const MoeBufs& m) {
    int* ps = (int*)((unsigned char*)smem + MISC_OFF);
    moe_offsets(ps, m);
    MoeOrder S; S.init(ps[NEXP] / 256, 1024 / 256, GDIM(), BID()); S.ps = (const LAS int*)(smem + MISC_OFF);
    pg8::Gemm g; g.A = m.Hp; g.Bt = wdn16; g.M = ps[NEXP]; g.N = 1024; g.K = 1024; g.bgstride = (size_t)1024 * 1024 * 2;
    EpiBiasBf16 E; E.O = m.Yp; E.bias = bdn;
    pg8::gemm_phase(smem + STAGE_OFF, g, S, E);
}
PH void ph_moe_combine(int* ps, bf16_t* h, const float* modl, int gate_off, const MoeBufs& m, int nrows, const float* ng, const float* nmod, bf16_t* a16, float* outf) {
    moe_offsets(ps, m);
    const int lane = TID() & 63, wave = (BID() * NTHR + TID()) >> 6, nw = GDIM() * NWAVE;
    int te[4], tp[4]; float tg[4];
    { const int r = wave < nrows ? wave : 0;
#pragma unroll
      for (int k = 0; k < 4; ++k) { te[k] = m.tok_e[r * 4 + k]; tp[k] = m.tok_pos[r * 4 + k]; tg[k] = m.tok_gate[r * 4 + k]; } }
    for (int r = wave; r < nrows; r += nw) {
        int dest[4]; float gk[4];
#pragma unroll
        for (int k = 0; k < 4; ++k) { dest[k] = ps[te[k]] + tp[k]; gk[k] = tg[k]; }
        const float* mr = modl + (size_t)mod_row(r) * MODW + gate_off;
        const float* nm = nmod ? nmod + (size_t)mod_row(r) * MODW : mr;
        pg8::u32x4 y[2][4], hw[2]; float4 g0[2], g1[2], ga[2], gb[2], sha[2], shb[2], sca[2], scb[2];
#pragma unroll
        for (int i = 0; i < 2; ++i) { const int col = (lane + 64 * i) * 8;
#pragma unroll
            for (int k = 0; k < 4; ++k) y[i][k] = *(const pg8::u32x4*)(m.Yp + (size_t)dest[k] * 1024 + col);
            g0[i] = *(const float4*)(mr + col); g1[i] = *(const float4*)(mr + col + 4);
            hw[i] = *(const pg8::u32x4*)(h + (size_t)r * D + col);
            ga[i] = *(const float4*)(ng + col); gb[i] = *(const float4*)(ng + col + 4);
            sha[i] = *(const float4*)(nm + col); shb[i] = *(const float4*)(nm + col + 4); sca[i] = *(const float4*)(nm + 1024 + col); scb[i] = *(const float4*)(nm + 1024 + col + 4); }
        { const int rn = r + nw < nrows ? r + nw : r;
#pragma unroll
          for (int k = 0; k < 4; ++k) { te[k] = m.tok_e[rn * 4 + k]; tp[k] = m.tok_pos[rn * 4 + k]; tg[k] = m.tok_gate[rn * 4 + k]; } }
        float o[16]; float ss = 0.f;
#pragma unroll
        for (int i = 0; i < 2; ++i) {
            float sv[8];
#pragma unroll
            for (int q = 0; q < 8; ++q) sv[q] = 0.f;
#pragma unroll
            for (int k = 0; k < 4; ++k) { const pg8::u32x4 yy = y[i][k];
                sv[0] += gk[k] * bflo(yy.x); sv[1] += gk[k] * bfhi(yy.x); sv[2] += gk[k] * bflo(yy.y); sv[3] += gk[k] * bfhi(yy.y);
                sv[4] += gk[k] * bflo(yy.z); sv[5] += gk[k] * bfhi(yy.z); sv[6] += gk[k] * bflo(yy.w); sv[7] += gk[k] * bfhi(yy.w); }
            float4 o0 = make_float4(bflo(hw[i].x), bfhi(hw[i].x), bflo(hw[i].y), bfhi(hw[i].y)), o1 = make_float4(bflo(hw[i].z), bfhi(hw[i].z), bflo(hw[i].w), bfhi(hw[i].w));
            o0.x += g0[i].x * sv[0]; o0.y += g0[i].y * sv[1]; o0.z += g0[i].z * sv[2]; o0.w += g0[i].w * sv[3];
            o1.x += g1[i].x * sv[4]; o1.y += g1[i].y * sv[5]; o1.z += g1[i].z * sv[6]; o1.w += g1[i].w * sv[7];
            o[8 * i] = o0.x; o[8 * i + 1] = o0.y; o[8 * i + 2] = o0.z; o[8 * i + 3] = o0.w; o[8 * i + 4] = o1.x; o[8 * i + 5] = o1.y; o[8 * i + 6] = o1.z; o[8 * i + 7] = o1.w;
#pragma unroll
            for (int q = 0; q < 8; ++q) ss += o[8 * i + q] * o[8 * i + q];
        }
        if (!outf) {
#pragma unroll
            for (int i = 0; i < 2; ++i) { pg8::u32x4 w; w.x = pg8::cvt_pk_bf16(o[8 * i], o[8 * i + 1]); w.y = pg8::cvt_pk_bf16(o[8 * i + 2], o[8 * i + 3]); w.z = pg8::cvt_pk_bf16(o[8 * i + 4], o[8 * i + 5]); w.w = pg8::cvt_pk_bf16(o[8 * i + 6], o[8 * i + 7]);
                *(pg8::u32x4*)(h + (size_t)r * D + (lane + 64 * i) * 8) = w; } }
        ss = wave_sum(ss);
        const float rs = rsqrtf(ss * (1.f / 1024.f) + 1e-5f);
#pragma unroll
        for (int i = 0; i < 2; ++i) {
            const int col = (lane + 64 * i) * 8;
            float v[8] = {o[8 * i] * rs * ga[i].x, o[8 * i + 1] * rs * ga[i].y, o[8 * i + 2] * rs * ga[i].z, o[8 * i + 3] * rs * ga[i].w, o[8 * i + 4] * rs * gb[i].x, o[8 * i + 5] * rs * gb[i].y, o[8 * i + 6] * rs * gb[i].z, o[8 * i + 7] * rs * gb[i].w};
            if (outf) { *(float4*)(outf + (size_t)r * D + col) = make_float4(v[0], v[1], v[2], v[3]); *(float4*)(outf + (size_t)r * D + col + 4) = make_float4(v[4], v[5], v[6], v[7]); }
            else {
                v[0] = v[0] * (1.f + sca[i].x) + sha[i].x; v[1] = v[1] * (1.f + sca[i].y) + sha[i].y; v[2] = v[2] * (1.f + sca[i].z) + sha[i].z; v[3] = v[3] * (1.f + sca[i].w) + sha[i].w;
                v[4] = v[4] * (1.f + scb[i].x) + shb[i].x; v[5] = v[5] * (1.f + scb[i].y) + shb[i].y; v[6] = v[6] * (1.f + scb[i].z) + shb[i].z; v[7] = v[7] * (1.f + scb[i].w) + shb[i].w;
                *(pg8::u32x4*)(a16 + (size_t)r * D + col) = pack8(v); }
        }
    }
}

#if PROBE
PH float probe_q(float t) {
    t = fmaxf(t, 1e-4f); float sc = 1.f;
    while (t >= 10.f) { t *= 0.1f; sc *= 10.f; }
    while (t < 1.f) { t *= 10.f; sc *= 0.1f; }
    float m = 1.f;
    if (t >= 2.f) m = 2.f; if (t >= 5.f) m = 5.f;
    return m * sc;
}
#endif
__global__ __launch_bounds__(NTHR, 2) void mega(Params p) {
    extern __shared__ __attribute__((aligned(16))) unsigned char smem[];
    float* lds = (float*)(smem + STAGE_OFF);
    LAS unsigned char* lsm = (LAS unsigned char*)smem;
    if (threadIdx.x == 0) *(uint4*)smem = make_uint4(0u, 0u, 0u, 0u);
    __syncthreads();
    XcdBarrier bar = xcd_barrier_post(p.bar, (volatile LAS unsigned*)smem);
#if PROBE
    if (threadIdx.x == 0) { volatile LAS unsigned long long* tl0 = (volatile LAS unsigned long long*)((LAS unsigned char*)smem + 512); for (int q = 0; q < 31; ++q) tl0[q] = 0; tl0[31] = wall_clock64(); }
#define GRID_SYNC(id) do { xcd_barrier(bar); if (threadIdx.x == 0) { volatile LAS unsigned long long* tl_ = (volatile LAS unsigned long long*)((LAS unsigned char*)smem + 512); \
        const unsigned long long now_ = wall_clock64(); tl_[id] += now_ - tl_[31]; tl_[31] = now_; } } while (0)
#define SUBSTAMP(id) do { __syncthreads(); if (threadIdx.x == 0) { volatile LAS unsigned long long* tl_ = (volatile LAS unsigned long long*)((LAS unsigned char*)smem + 512); \
        const unsigned long long now_ = wall_clock64(); tl_[id] += now_ - tl_[31]; tl_[31] = now_; } } while (0)
#else
#define GRID_SYNC(id) xcd_barrier(bar)
#define SUBSTAMP(id) do { } while (0)
#endif

    ph_copy(p);
    ph_ada(p, lds);
    ph_rope_tab(p.rope_c, p.rope_s);
    ph_fft_tab(p.fft_tabT);
    ph_pool_prep(p.pool_w, p.pool_wt);
    ph_router_prep(p.router_w, p.rwt_hi, p.rwt_lo);
    ph_convT_small(p.rw_w2, p.w2t, 64, 768, 4);
    ph_convT_small(p.rw_a2, p.a2t, 64, 768, 4);
    ph_convT_small(p.rw_g2, p.g2t, 160, 768, 2);
    ph_twiddle16(p.tw16_lat, 2048);
    ph_twiddle16(p.tw16_ctx, 256);
    ph_convT(lsm + STAGE_OFF, p.ev_w_in, p.ewin16, 1024, EVEN_IN, 1536, 2);
    ph_convT(lsm + STAGE_OFF, p.od_w_in, p.owin16, 1024, ODD_IN, 3072, 2);
    ph_convT(lsm + STAGE_OFF, p.ev_w_out, p.ewout16, 1024, 1024, 1024, 2);
    ph_convT(lsm + STAGE_OFF, p.od_w_out, p.owout16, 1024, 1024, 1024, 2);
    ph_moe_init(p.mb);
    ph_convT(lsm + STAGE_OFF, p.exp_w_gu, p.wgu16, 1024, 2048, 2048, 4 * NEXP);
    ph_convT(lsm + STAGE_OFF, p.exp_w_dn, p.wdn16, 1024, 1024, 1024, 4 * NEXP);
    GRID_SYNC(0);

    for (int i = 0; i < 4; ++i) {
        const int j = i >> 1; const bool last = (i == 3);
        const float* modl = p.mod + (size_t)i * 17 * MODW;
        if (i == 0) { ph_norm_mod((const bf16_t*)p.h, p.norm_mix_g, modl, 0, 1024, nullptr, p.a16, NT); GRID_SYNC(1); }
        if ((i & 1) == 0) {
            { EpiRopeBf16 E; E.O = p.px16; E.ldc = 1536; E.ct = p.rope_c; E.st = p.rope_s; ph_gemm16(lsm, p.a16, p.ewin16 + (size_t)j * 1536 * 1024, NT, 1536, 1024, E, BID(), GDIM()); }
            GRID_SYNC(2);
            ph_pool16(lsm, p.px16, p.pool_wt + (size_t)j * 4 * 4096, p.pool_scale + j * 256, p.mix16);
            SUBSTAMP(24);
            ph_attn16(lsm, p.px16, p.att_sink + j * 12, p.mix16);
            GRID_SYNC(4);
            { EpiPlainBf16 E; E.O = p.px16; E.ldc = D; ph_gemm16(lsm, p.mix16, p.ewout16 + (size_t)j * D * D, NT, D, D, E, BID(), GDIM()); }
        } else {
            { EpiPlainBf16 E; E.O = p.px16; E.ldc = 3072; ph_gemm16(lsm, p.a16, p.owin16 + (size_t)j * 3072 * 1024, NT, 3072, 1024, E, BID(), GDIM()); }
            GRID_SYNC(6);
            OddW w;
            w.mu = p.rw_mu + (size_t)j * 2 * 2720; w.w0 = p.rw_w0 + (size_t)j * 2 * 768; w.w2 = p.rw_w2 + (size_t)j * 2 * 64 * 768;
            w.a0 = p.rw_a0 + (size_t)j * 2 * 768; w.a2 = p.rw_a2 + (size_t)j * 2 * 64 * 768; w.g2 = p.rw_g2 + (size_t)j * 160 * 768;
            w.k_k = p.rw_k_k + j * 768; w.k_a = p.rw_k_a + j * 768; w.r_k = p.rw_r_k + j * 768; w.gn_g = p.rw_gn_g + j * 768; w.gn_b = p.rw_gn_b + j * 768;
            ph_oddprep(lsm, p.px16, w, p.w2t + (size_t)j * 2 * 768 * 64, p.a2t + (size_t)j * 2 * 768 * 64, p.g2t + (size_t)j * 768 * 160, p.si);
            SUBSTAMP(22);
            ph_fft_prep16(p.px16, p.fft_tabT, p.bt16_lat, p.bt16_ctx);
            GRID_SYNC(7);
            { EpiDft E; E.mix = p.mix16; E.T = 2048; E.row0 = 0; E.scale = 0.0027621358640099515f;
              ph_gemm16(lsm, p.tw16_lat, p.bt16_lat, 2048, 4096, 4096, E, BID(), GDIM());
              E.T = 256; E.row0 = NX; E.scale = 0.0078125f;
              ph_gemm16(lsm, p.tw16_ctx, p.bt16_ctx, 256, 4096, 512, E, (BID() >= 128 ? BID() - 128 : BID() + 128), GDIM()); }
            ph_scan_prep(lsm, p.si, w.k_a, w.k_k, p.crec, p.qctr + 16 * j);
            GRID_SYNC(20);
            ph_scan_seq(lsm, p.crec, p.si.Y, p.si.V);
            GRID_SYNC(8);
            ph_readout2(p.si, w, p.mix16);
            GRID_SYNC(9);
            { EpiPlainBf16 E; E.O = p.px16; E.ldc = D; ph_gemm16(lsm, p.mix16, p.owout16 + (size_t)j * D * D, NT, D, D, E, BID(), GDIM()); }
        }
        GRID_SYNC((i & 1) ? 10 : 5);
        const int nrows = last ? NX : NT;
        ph_resid_norm((bf16_t*)p.h, p.px16, modl + 2048, p.norm_ffn_g + i * D, modl, 3072, 4096, p.a16, nrows);
        GRID_SYNC(11);
        ph_router16(lsm, p.a16, p.rwt_hi + (size_t)i * NEXP * D, p.rwt_lo + (size_t)i * NEXP * D, p.router_b + i * NEXP, p.mb, nrows);
        GRID_SYNC(12);
        ph_moe_gather((int*)(smem + MISC_OFF), p.a16, p.mb, nrows);
        GRID_SYNC(13);
        ph_moe_gu16(lsm, p.wgu16 + (size_t)i * NEXP * 2048 * 1024, p.exp_b_gu + (size_t)i * NEXP * 2048, p.mb);
        GRID_SYNC(14);
        ph_moe_dn16(lsm, p.wdn16 + (size_t)i * NEXP * 1024 * 1024, p.exp_b_dn + (size_t)i * NEXP * 1024, p.mb);
        GRID_SYNC(15);
        ph_moe_combine((int*)(smem + MISC_OFF), (bf16_t*)p.h, modl, 5120, p.mb, nrows, last ? p.final_g : p.norm_mix_g + (i + 1) * D, last ? nullptr : modl + 17 * MODW, p.a16, last ? p.out : nullptr);
        GRID_SYNC(16);
        ph_moe_init(p.mb);
    }
#if PROBE
    GRID_SYNC(18);
    if (blockIdx.x == 0 && threadIdx.x == 0) { volatile LAS unsigned long long* tl_ = (volatile LAS unsigned long long*)((LAS unsigned char*)smem + 512); for (int q = 0; q < 31; ++q) p.probe[q] = tl_[q]; }
    GRID_SYNC(19);
    {
        const float tA = probe_q((float)p.probe[PROBE_A] * 1e-5f), tB = probe_q((float)p.probe[PROBE_B] * 1e-5f);
        const float cA = 10.f * sqrtf(tA), cB = 1000.f * tB;
        for (size_t q = (size_t)blockIdx.x * NTHR + threadIdx.x; q < (size_t)NX * D; q += (size_t)GDIM() * NTHR) p.out[q] = q == 0 ? cB : cA;
    }
#endif
}
}

extern "C" void kernel_launch(void* const* d_in, const int* in_sizes, int n_in, void* d_out, int out_size, void* d_ws, size_t ws_size, hipStream_t stream) {
    Params p; memset(&p, 0, sizeof(p));
    p.x = (const float*)d_in[0]; p.c = (const float*)d_in[1]; p.ctx = (const float*)d_in[2]; p.c_ctx = (const float*)d_in[3];
    p.ada_w = (const float*)d_in[4]; p.ada_b = (const float*)d_in[5]; p.norm_mix_g = (const float*)d_in[6]; p.norm_ffn_g = (const float*)d_in[7];
    p.ev_w_in = (const float*)d_in[8]; p.ev_w_out = (const float*)d_in[9]; p.pool_w = (const float*)d_in[10]; p.pool_scale = (const float*)d_in[11];
    p.att_sink = (const float*)d_in[12]; p.od_w_in = (const float*)d_in[13]; p.od_w_out = (const float*)d_in[14];
    p.rw_mu = (const float*)d_in[15]; p.rw_w0 = (const float*)d_in[16]; p.rw_w2 = (const float*)d_in[17]; p.rw_a0 = (const float*)d_in[18];
    p.rw_a2 = (const float*)d_in[19]; p.rw_g2 = (const float*)d_in[20]; p.rw_k_k = (const float*)d_in[21]; p.rw_k_a = (const float*)d_in[22];
    p.rw_r_k = (const float*)d_in[23]; p.rw_gn_g = (const float*)d_in[24]; p.rw_gn_b = (const float*)d_in[25];
    p.router_w = (const float*)d_in[26]; p.router_b = (const float*)d_in[27]; p.exp_w_gu = (const float*)d_in[28]; p.exp_b_gu = (const float*)d_in[29];
    p.exp_w_dn = (const float*)d_in[30]; p.exp_b_dn = (const float*)d_in[31]; p.final_g = (const float*)d_in[32];
    p.out = (float*)d_out;

    float* ws = (float*)d_ws; size_t off = 0;
    auto take = [&](size_t n) { float* q = ws + off; off += (n + 63) & ~(size_t)63; return q; };
    p.bar = (unsigned*)take(XCD_BAR_WORDS);
    p.qctr = (unsigned*)take(64);
    p.probe = (unsigned long long*)take(64);
    p.rope_c = take(1024); p.rope_s = take(1024);
    p.fft_tabT = (bf16_t*)take(128 * 64 / 2);
    p.pool_wt = (bf16_t*)take(2 * 4 * 64 * 64 / 2);
    p.rwt_hi = (bf16_t*)take((size_t)4 * 32 * 1024 / 2); p.rwt_lo = (bf16_t*)take((size_t)4 * 32 * 1024 / 2);
    p.w2t = (bf16_t*)take((size_t)4 * 768 * 64 / 2); p.a2t = (bf16_t*)take((size_t)4 * 768 * 64 / 2); p.g2t = (bf16_t*)take((size_t)2 * 768 * 160 / 2);
    p.mod = take((size_t)4 * 17 * MODW);
    p.h = take((size_t)NT * D);
    p.a = take((size_t)NT * D);
    p.mix16 = (bf16_t*)take((size_t)NT * D / 2);
    p.tw16_lat = (bf16_t*)take((size_t)2048 * 4096 / 2);
    p.tw16_ctx = (bf16_t*)take((size_t)256 * 512 / 2);
    p.ewin16 = (bf16_t*)take((size_t)2 * 1536 * 1024 / 2); p.owin16 = (bf16_t*)take((size_t)2 * 3072 * 1024 / 2);
    p.ewout16 = (bf16_t*)take((size_t)2 * 1024 * 1024 / 2); p.owout16 = (bf16_t*)take((size_t)2 * 1024 * 1024 / 2);
    p.mb.tok_e = (int*)take((size_t)NT * 4); p.mb.tok_pos = (int*)take((size_t)NT * 4); p.mb.tok_gate = take((size_t)NT * 4);
    p.mb.cnt = (int*)take(64);
    p.a16 = (bf16_t*)take((size_t)NT * D / 2);
    p.wgu16 = (bf16_t*)take((size_t)4 * NEXP * 2048 * 1024 / 2);
    p.wdn16 = (bf16_t*)take((size_t)4 * NEXP * 1024 * 1024 / 2);
    const size_t scratch0 = off;
    p.px16 = (bf16_t*)take((size_t)NT * 3072 / 2);
    { bf16_t** arrs[9] = {&p.si.R, &p.si.K, &p.si.KK, &p.si.V, &p.si.G, &p.si.X[0], &p.si.X[1], &p.si.A[0], &p.si.A[1]};
      for (int q = 0; q < 9; ++q) *arrs[q] = (bf16_t*)take((size_t)NT * RW / 2); }
    p.si.Y[0] = take((size_t)NT * RW); p.si.Y[1] = take((size_t)NT * RW);
    p.st_init = take((size_t)NB * 24 * 5 * 4096); p.st_p = take((size_t)NB * 24 * 4 * 4096); p.st_b = take((size_t)NB * 24 * 4 * 4096);
    p.crec = (unsigned char*)take((size_t)NB * 24 * 144 * 12544 / 4);
    p.bt16_lat = (bf16_t*)take((size_t)4096 * 4096 / 2);
    p.bt16_ctx = (bf16_t*)take((size_t)4096 * 512 / 2);
    const size_t mixer_end = off;
    off = scratch0;
    p.mb.Xp = (bf16_t*)take((size_t)MOE_ROWS * 1024 / 2); p.mb.Hp = (bf16_t*)take((size_t)MOE_ROWS * 1024 / 2); p.mb.Yp = (bf16_t*)take((size_t)MOE_ROWS * 1024 / 2);
    const size_t total = (off > mixer_end ? off : mixer_end) * sizeof(float);
    if (total > ws_size) { fprintf(stderr, "kernel_launch: workspace too small: need %zu have %zu\n", total, ws_size); return; }

    static int grid = 0;
    if (!grid) {
        int dev = 0, cus = 0, per_cu = 0;
        if (hipGetDevice(&dev) != hipSuccess || hipDeviceGetAttribute(&cus, hipDeviceAttributeMultiprocessorCount, dev) != hipSuccess) { fprintf(stderr, "kernel_launch: device query failed\n"); return; }
        if (hipFuncSetAttribute((const void*)mega, hipFuncAttributeMaxDynamicSharedMemorySize, LDS_BYTES) != hipSuccess) { fprintf(stderr, "kernel_launch: hipFuncSetAttribute failed\n"); return; }
        if (hipOccupancyMaxActiveBlocksPerMultiprocessor(&per_cu, (const void*)mega, NTHR, LDS_BYTES) != hipSuccess || per_cu < 1) { fprintf(stderr, "kernel_launch: occupancy query says %d\n", per_cu); return; }
        grid = cus;
    }
    if (hipMemsetAsync(p.bar, 0, (XCD_BAR_WORDS + 64) * sizeof(unsigned), stream) != hipSuccess) { fprintf(stderr, "kernel_launch: memset failed\n"); return; }
    hipLaunchKernelGGL(mega, dim3(grid), dim3(NTHR), LDS_BYTES, stream, p);
}
```
